# Optimizing an MI355X kernel written in HIP

```python
import jax, jax.numpy as jnp
from jax import lax
import numpy as np

D_MODEL = 4096
BATCH = 1
SEQ = 16384
DEPTH = 4

CHUNK = 64
N_MIXERS = 2
N_MEM = 256
MIX_WIDTH = D_MODEL
MEM_HEADS = 4
MEM_WIDTH = MIX_WIDTH // 4
MEM_HEAD_DIM = MEM_WIDTH // MEM_HEADS
BRANCH_WIDTH = MIX_WIDTH - MEM_WIDTH
CONV_WIDTH = 3
GMLP_BLOCK = 128
GMLP_GROUPS = 8
GMLP_GROUP_DIM = BRANCH_WIDTH // GMLP_GROUPS
CONV_IN_WIDTH = 3 * BRANCH_WIDTH + MEM_WIDTH + MIX_WIDTH
GMLP_IN_WIDTH = 2 * BRANCH_WIDTH + MEM_WIDTH + MIX_WIDTH
N_CONV_LAYERS = (DEPTH + 1) // 2
N_GMLP_LAYERS = DEPTH // 2
RMS_EPS = 1e-6
LN_EPS = 1e-5

kernel_name = "hybrid_conv_gmlp_memory_trunk"


def rms_norm(x, g):
    xf = x.astype(jnp.float32)
    y = xf * lax.rsqrt(jnp.mean(xf * xf, axis=-1, keepdims=True) + RMS_EPS)
    return (y * g.astype(jnp.float32)).astype(x.dtype)


def layer_norm(x, g, b):
    xf = x.astype(jnp.float32)
    mu = jnp.mean(xf, axis=-1, keepdims=True)
    xc = xf - mu
    y = xc * lax.rsqrt(jnp.mean(xc * xc, axis=-1, keepdims=True) + LN_EPS)
    return (y * g.astype(jnp.float32) + b.astype(jnp.float32)).astype(x.dtype)


def memory_attention(q, mem, mem_g, w_kv):
    b, s, _ = q.shape
    m = mem.shape[1]
    kv = rms_norm(mem, mem_g) @ w_kv
    k, v = jnp.split(kv, 2, axis=-1)
    q = q.reshape(b, s, MEM_HEADS, MEM_HEAD_DIM)
    k = k.reshape(b, m, MEM_HEADS, MEM_HEAD_DIM)
    v = v.reshape(b, m, MEM_HEADS, MEM_HEAD_DIM)
    scores = jnp.einsum('bshd,bmhd->bhsm', q, k).astype(jnp.float32) * (MEM_HEAD_DIM ** -0.5)
    p = jax.nn.softmax(scores, axis=-1).astype(v.dtype)
    o = jnp.einsum('bhsm,bmhd->bshd', p, v)
    return o.reshape(b, s, MEM_WIDTH)


def causal_short_conv(h, w):
    s = h.shape[1]
    hp = jnp.pad(h, ((0, 0), (CONV_WIDTH - 1, 0), (0, 0)))
    out = hp[:, 0:s] * w[0]
    for k in range(1, CONV_WIDTH):
        out = out + hp[:, k:k + s] * w[k]
    return out


def conv_branch(paths, w_conv):
    b_gate, c_gate, h = jnp.split(paths, 3, axis=-1)
    return b_gate * causal_short_conv(c_gate * h, w_conv)


def gmlp_branch(paths, ln_g, ln_b, w_s, b_s):
    z = jax.nn.gelu(paths)
    u, v = jnp.split(z, 2, axis=-1)
    v = layer_norm(v, ln_g, ln_b)
    b, s, _ = v.shape
    n_blocks = s // GMLP_BLOCK
    v = v.reshape(b, n_blocks, GMLP_BLOCK, GMLP_GROUPS, GMLP_GROUP_DIM)
    mask = jnp.tril(jnp.ones((GMLP_BLOCK, GMLP_BLOCK), dtype=bool))
    w = jnp.where(mask[None], w_s, jnp.zeros_like(w_s))
    f = jnp.einsum('gts,bnsgd->bntgd', w, v) + jnp.transpose(b_s)[None, None, :, :, None]
    return u * f.reshape(b, s, BRANCH_WIDTH)


def setup_inputs(seed: int = 0) -> dict:
    key = jax.random.key(seed)
    ks = jax.random.split(key, 16)
    f32 = jnp.float32
    x = jax.random.normal(ks[0], (BATCH, SEQ, D_MODEL), f32)
    mem = jax.random.normal(ks[1], (BATCH, N_MEM, D_MODEL), f32)
    pre_norm_g = 1.0 + 0.1 * jax.random.normal(ks[2], (DEPTH, D_MODEL), f32)
    post_norm_g = 1.0 + 0.1 * jax.random.normal(ks[3], (DEPTH, D_MODEL), f32)
    mem_norm_g = 1.0 + 0.1 * jax.random.normal(ks[4], (DEPTH, D_MODEL), f32)
    w_mem_kv = jax.random.normal(ks[5], (DEPTH, D_MODEL, 2 * MEM_WIDTH), f32) * D_MODEL ** -0.5
    w_out = jax.random.normal(ks[6], (DEPTH, MIX_WIDTH, D_MODEL), f32) * MIX_WIDTH ** -0.5
    conv_w_in = jax.random.normal(ks[7], (N_CONV_LAYERS, D_MODEL, CONV_IN_WIDTH), f32) * D_MODEL ** -0.5
    conv_w = jax.random.normal(ks[8], (N_CONV_LAYERS, CONV_WIDTH, BRANCH_WIDTH), f32) * CONV_WIDTH ** -0.5
    gmlp_w_in = jax.random.normal(ks[9], (N_GMLP_LAYERS, D_MODEL, GMLP_IN_WIDTH), f32) * D_MODEL ** -0.5
    gmlp_ln_g = 1.0 + 0.1 * jax.random.normal(ks[10], (N_GMLP_LAYERS, BRANCH_WIDTH), f32)
    gmlp_ln_b = 0.02 * jax.random.normal(ks[11], (N_GMLP_LAYERS, BRANCH_WIDTH), f32)
    gmlp_w_s = jax.random.normal(ks[12], (N_GMLP_LAYERS, GMLP_GROUPS, GMLP_BLOCK, GMLP_BLOCK), f32) * GMLP_BLOCK ** -0.5
    gmlp_b_s = 1.0 + 0.1 * jax.random.normal(ks[13], (N_GMLP_LAYERS, GMLP_GROUPS, GMLP_BLOCK), f32)
    return {"x": x, "mem": mem, "pre_norm_g": pre_norm_g, "post_norm_g": post_norm_g,
            "mem_norm_g": mem_norm_g, "w_mem_kv": w_mem_kv, "w_out": w_out,
            "conv_w_in": conv_w_in, "conv_w": conv_w, "gmlp_w_in": gmlp_w_in,
            "gmlp_ln_g": gmlp_ln_g, "gmlp_ln_b": gmlp_ln_b, "gmlp_w_s": gmlp_w_s,
            "gmlp_b_s": gmlp_b_s}


def reference(x, mem, pre_norm_g, post_norm_g, mem_norm_g, w_mem_kv, w_out,
              conv_w_in, conv_w, gmlp_w_in, gmlp_ln_g, gmlp_ln_b, gmlp_w_s, gmlp_b_s):
    for i in range(DEPTH):
        h = rms_norm(x, pre_norm_g[i])
        j = i // N_MIXERS
        if i % N_MIXERS == 0:
            proj = h @ conv_w_in[j]
            paths, q, z = jnp.split(proj, [3 * BRANCH_WIDTH, 3 * BRANCH_WIDTH + MEM_WIDTH], axis=-1)
            branch = conv_branch(paths, conv_w[j])
        else:
            proj = h @ gmlp_w_in[j]
            paths, q, z = jnp.split(proj, [2 * BRANCH_WIDTH, 2 * BRANCH_WIDTH + MEM_WIDTH], axis=-1)
            branch = gmlp_branch(paths, gmlp_ln_g[j], gmlp_ln_b[j], gmlp_w_s[j], gmlp_b_s[j])
        mem_out = memory_attention(q, mem, mem_norm_g[i], w_mem_kv[i])
        y = jnp.concatenate([branch, mem_out], axis=-1) * jax.nn.silu(z)
        y = y @ w_out[i]
        x = x + rms_norm(y, post_norm_g[i])
    return x
```

```cpp
#include <hip/hip_runtime.h>
#include <cstdio>
#include <cstdint>
namespace pg8 {
#define PG8_LAS __attribute__((address_space(3)))
typedef unsigned short bf16_t;
typedef short bf16x8 __attribute__((ext_vector_type(8)));
typedef float f32x4 __attribute__((ext_vector_type(4)));
typedef unsigned u32x4 __attribute__((ext_vector_type(4)));
constexpr int BM = 256, BK = 64, HALF = 128, HTB = HALF * BK * 2  , STAGE_BYTES = 8 * HTB, NXCD = 8, WGM = 8;

__host__ __device__ __forceinline__ int lds_byte(int r, int c) { const int st = (r >> 4) * 2 + (c >> 5), rr = r & 15, cc = c & 31, ob = rr * 64 + cc * 2; return st * 1024 + (ob ^ (((ob >> 9) & 1) << 5)); }
__host__ __device__ __forceinline__ void stage_rc(int b, int& R, int& C) { const int st = b / 1024, sb = b % 1024, swz = sb ^ (((sb >> 9) & 1) << 5); R = (st >> 1) * 16 + swz / 64; C = (st & 1) * 32 + (swz % 64) / 2; }
__host__ __device__ __forceinline__ int perm32(int rho) { const int n = rho >> 4, i = rho & 15; return 8 * (i >> 2) + 4 * n + (i & 3); }

struct Unit { int pm, pn; };
struct Gemm { const bf16_t* A; const bf16_t* Bt; int M, N, K; };

struct StaticOrder {
    int nM, nN, nwg, G, c;
    __host__ __device__ void init(int M, int N, int G_, int c_) { nM = M / BM; nN = N / BM; nwg = nM * nN; G = G_; c = c_; }
    __host__ __device__ bool next(int i, Unit& u) const {
        const long L = (long)i * G + c; if (L >= nwg) return false;
        int wgid = (int)L; { const int q = nwg / NXCD, r = nwg % NXCD, xcd = wgid % NXCD, off = wgid / NXCD; wgid = (xcd < r ? xcd * (q + 1) : r * (q + 1) + (xcd - r) * q) + off; }
        const int nig = WGM * nN, gid = wgid / nig, fm = gid * WGM, gsz = (nM - fm) < WGM ? (nM - fm) : WGM;
        u.pm = fm + ((wgid % nig) % gsz); u.pn = (wgid % nig) / gsz; return true;
    }
    __device__ __forceinline__ void a_ready(const Unit&) const {}
    __device__ __forceinline__ void done(const Unit&) const {}
};


__device__ __forceinline__ unsigned cvt_pk_bf16(float lo, float hi) { unsigned r; asm("v_cvt_pk_bf16_f32 %0, %1, %2" : "=v"(r) : "v"(lo), "v"(hi)); return r; }
__device__ __forceinline__ float silu_f(float z) { return z * __builtin_amdgcn_rcpf(1.0f + __builtin_amdgcn_exp2f(-1.44269504f * z)); }
__device__ __forceinline__ float gelu_f(float x) { const float u = x * (0.7978845608f + 0.0356774081f * x * x); return x * __builtin_amdgcn_rcpf(1.0f + __builtin_amdgcn_exp2f(-2.88539008f * u)); }
__device__ __forceinline__ unsigned short f2bf1(float f) { unsigned u = __builtin_bit_cast(unsigned, f); return (unsigned short)((u + 0x7fffu + ((u >> 16) & 1u)) >> 16); }

struct EpiProj {
    static constexpr bool PERM = false, AFTER_DRAIN = false;
    bf16_t* base; const float* rstd; float* vst; int gm;
    static constexpr size_t OFF_A2 = (size_t)48 << 20, OFF_Q = (size_t)96 << 20, OFF_SZ = (size_t)112 << 20;
    __device__ __forceinline__ void operator()(const f32x4 (&acc)[2][2][4][2], const Unit& u, int wr, int wc, int fr, int fq) const {
        asm volatile("" : "+v"(fr), "+v"(fq));
        const int pn = u.pn; int kind, p;
        if (gm == 0) { if (pn < 24) { kind = 0; p = pn; } else if (pn < 48) { kind = 1; p = pn - 24; } else if (pn < 52) { kind = 3; p = pn - 48; } else { kind = 4; p = pn - 52; } }
        else         { if (pn < 24) { kind = 2; p = pn; } else if (pn < 36) { kind = 5; p = pn - 24; } else if (pn < 40) { kind = 3; p = pn - 36; } else { kind = 4; p = pn - 40; } }
        const int row0 = u.pm * BM + wr * 64 + fr;
        if (kind <= 2) {
            bf16_t* O = base + ((kind == 1) ? OFF_A2 : (size_t)0); const int col0 = 128 * p + 32 * wc + 8 * fq;
#pragma unroll
            for (int ai = 0; ai < 2; ++ai)
#pragma unroll
                for (int m = 0; m < 4; ++m) { const int r = row0 + ai * HALF + m * 16; const float rs = rstd[r];
                    f32x4 o[2];
#pragma unroll
                    for (int n = 0; n < 2; ++n) { const f32x4 a = acc[ai][0][m][n] * rs, b = acc[ai][1][m][n] * rs;
#pragma unroll
                        for (int j = 0; j < 4; ++j) o[n][j] = (kind == 0) ? a[j] * silu_f(b[j]) : (kind == 1) ? a[j] * b[j] : gelu_f(a[j]) * silu_f(b[j]); }
                    u32x4 w; w.x = cvt_pk_bf16(o[0][0], o[0][1]); w.y = cvt_pk_bf16(o[0][2], o[0][3]); w.z = cvt_pk_bf16(o[1][0], o[1][1]); w.w = cvt_pk_bf16(o[1][2], o[1][3]);
                    *(u32x4*)(O + (size_t)r * 3072 + col0) = w; }
        } else {
            bf16_t* O = base + ((kind == 3) ? OFF_Q : (kind == 4) ? OFF_SZ : OFF_A2); const int ldo = (kind == 5) ? 3072 : 1024; const int col0 = 256 * p + 32 * wc + 8 * fq;
#pragma unroll
            for (int ai = 0; ai < 2; ++ai)
#pragma unroll
                for (int m = 0; m < 4; ++m) { const int r = row0 + ai * HALF + m * 16; const float rs = rstd[r]; float s1 = 0.f, s2 = 0.f;
#pragma unroll
                    for (int bj = 0; bj < 2; ++bj) { f32x4 o[2];
#pragma unroll
                        for (int n = 0; n < 2; ++n) { const f32x4 a = acc[ai][bj][m][n] * rs;
#pragma unroll
                            for (int j = 0; j < 4; ++j) { const float v = (kind == 3) ? a[j] * 0.0625f : (kind == 4) ? silu_f(a[j]) : gelu_f(a[j]); o[n][j] = v; s1 += v; s2 += v * v; } }
                        u32x4 w; w.x = cvt_pk_bf16(o[0][0], o[0][1]); w.y = cvt_pk_bf16(o[0][2], o[0][3]); w.z = cvt_pk_bf16(o[1][0], o[1][1]); w.w = cvt_pk_bf16(o[1][2], o[1][3]);
                        *(u32x4*)(O + (size_t)r * ldo + col0 + bj * HALF) = w; }
                    if (kind == 5) { s1 += __shfl_xor(s1, 16); s1 += __shfl_xor(s1, 32); s2 += __shfl_xor(s2, 16); s2 += __shfl_xor(s2, 32);
                        if (fq == 0) { float* q = vst + ((size_t)r * 48 + p * 4 + wc) * 2; q[0] = s1; q[1] = s2; } } }
        }
    }
};
struct EpiOut {
    static constexpr bool PERM = false, AFTER_DRAIN = false;
    bf16_t* YO; float* yss;
    __device__ __forceinline__ void operator()(const f32x4 (&acc)[2][2][4][2], const Unit& u, int wr, int wc, int fr, int fq) const {
        asm volatile("" : "+v"(fr), "+v"(fq));
        const int row0 = u.pm * BM + wr * 64 + fr, col0 = 256 * u.pn + 32 * wc + 8 * fq;
#pragma unroll
        for (int ai = 0; ai < 2; ++ai)
#pragma unroll
            for (int m = 0; m < 4; ++m) { const int r = row0 + ai * HALF + m * 16; float ss = 0.f;
#pragma unroll
                for (int bj = 0; bj < 2; ++bj) { const f32x4 a = acc[ai][bj][m][0], b = acc[ai][bj][m][1];
                    ss += (a[0] * a[0] + a[1] * a[1]) + (a[2] * a[2] + a[3] * a[3]) + (b[0] * b[0] + b[1] * b[1]) + (b[2] * b[2] + b[3] * b[3]);
                    u32x4 w; w.x = cvt_pk_bf16(a[0], a[1]); w.y = cvt_pk_bf16(a[2], a[3]); w.z = cvt_pk_bf16(b[0], b[1]); w.w = cvt_pk_bf16(b[2], b[3]);
                    *(u32x4*)(YO + (size_t)r * 4096 + col0 + bj * HALF) = w; }
                ss += __shfl_xor(ss, 16); ss += __shfl_xor(ss, 32);
                if (fq == 0) yss[(size_t)r * 64 + u.pn * 4 + wc] = ss; }
    }
};
struct EpiKV {
    static constexpr bool PERM = false, AFTER_DRAIN = false;
    bf16_t* KV; const float* rstdm;
    __device__ __forceinline__ void operator()(const f32x4 (&acc)[2][2][4][2], const Unit& u, int wr, int wc, int fr, int fq) const {
        asm volatile("" : "+v"(fr), "+v"(fq));
        const int l = u.pn >> 3, t = u.pn & 7; bf16_t* base = KV + (size_t)l * (2 * 256 * 1024); const int row0 = wr * 64 + fr;
#pragma unroll
        for (int ai = 0; ai < 2; ++ai)
#pragma unroll
            for (int m = 0; m < 4; ++m) { const int r = row0 + ai * HALF + m * 16; const float rs = rstdm[r];
#pragma unroll
                for (int bj = 0; bj < 2; ++bj) { const f32x4 a = acc[ai][bj][m][0] * rs, b = acc[ai][bj][m][1] * rs;
                    if (t < 4) { u32x4 w; w.x = cvt_pk_bf16(a[0], a[1]); w.y = cvt_pk_bf16(a[2], a[3]); w.z = cvt_pk_bf16(b[0], b[1]); w.w = cvt_pk_bf16(b[2], b[3]);
                        *(u32x4*)(base + (size_t)r * 1024 + 256 * t + bj * HALF + 32 * wc + 8 * fq) = w; }
                    else { bf16_t* vt = base + 256 * 1024 + (size_t)(256 * (t - 4) + bj * HALF + 32 * wc + 8 * fq) * 256 + r;
#pragma unroll
                        for (int j = 0; j < 4; ++j) { vt[(size_t)j * 256] = f2bf1(a[j]); vt[(size_t)(4 + j) * 256] = f2bf1(b[j]); } } } }
    }
};
template <class Epi, class Sched, bool ALIGN_EPI = false, bool SP2 = false>
__device__ __forceinline__ void gemm_phase(PG8_LAS unsigned char* lds, const Gemm g, const Sched& S, const Epi& E) {
    int tid_ = threadIdx.x; asm volatile("" : "+v"(tid_));
    const int tid = tid_, wid = __builtin_amdgcn_readfirstlane(tid >> 6), lane = tid & 63, wr = wid >> 2, wc = wid & 3, fr = lane & 15, fq = lane >> 4;
    const int K = g.K, nt = K / BK;
    unsigned voffA[2], voffB[2];
#pragma unroll
    for (int i = 0; i < 2; ++i) { int R, C; stage_rc(tid * 16 + i * 8192, R, C); const int Rb = Epi::PERM ? ((R & ~31) + perm32(R & 31)) : R;
        voffA[i] = (unsigned)(R * K + C) * 2u; voffB[i] = (unsigned)(Rb * K + C) * 2u; }
    const size_t kstep = (size_t)(BK * 2);
    const size_t hstep = (size_t)HALF * K * 2;
    const size_t tstep = 2 * hstep;
    const unsigned ldsw = (unsigned)wid * 1024u;
    const int aoff = lds_byte(wr * 64 + fr, fq * 8), boff = lds_byte(wc * 32 + fr, fq * 8);
#define PG8_SA(b, h) (((b) * 2 + (h)) * HTB)
#define PG8_SB(b, h) ((4 + (b) * 2 + (h)) * HTB)
#define PG8_STAGE(bufoff, gbase, voff) do { _Pragma("unroll") for (int _i = 0; _i < 2; ++_i) \
        __builtin_amdgcn_global_load_lds((const unsigned*)((const char*)(gbase) + (voff)[_i]), (PG8_LAS unsigned*)(lds + (bufoff) + ldsw + _i * 8192), 16, 0, 0); } while (0)
#define PG8_LDA(dst, b, h) do { _Pragma("unroll") for (int m = 0; m < 4; ++m) _Pragma("unroll") for (int k = 0; k < 2; ++k) dst[m][k] = *(const PG8_LAS bf16x8*)(lds + PG8_SA(b, h) + aoff + m * 2048 + k * 1024); } while (0)
#define PG8_LDB(dst, b, h) do { _Pragma("unroll") for (int n = 0; n < 2; ++n) _Pragma("unroll") for (int k = 0; k < 2; ++k) dst[n][k] = *(const PG8_LAS bf16x8*)(lds + PG8_SB(b, h) + boff + n * 2048 + k * 1024); } while (0)
#define PG8_MMA(ai, bj, At, Bt) do { __builtin_amdgcn_s_setprio(1); _Pragma("unroll") for (int m = 0; m < 4; ++m) _Pragma("unroll") for (int n = 0; n < 2; ++n) _Pragma("unroll") for (int k = 0; k < 2; ++k) \
        acc[ai][bj][m][n] = __builtin_amdgcn_mfma_f32_16x16x32_bf16(Bt[n][k], At[m][k], acc[ai][bj][m][n], 0, 0, 0); __builtin_amdgcn_s_setprio(0); } while (0)
#define PG8_WAIT_V(n) asm volatile("s_waitcnt vmcnt(" #n ")" ::: "memory")
#define PG8_WAIT_L(n) asm volatile("s_waitcnt lgkmcnt(" #n ")" ::: "memory")
#define PG8_BAR __builtin_amdgcn_s_barrier()
#define PG8_SCHED __builtin_amdgcn_sched_barrier(0)
    Unit cur, nxt; int ui = 0;
    if (!S.next(0, cur)) return;
    f32x4 acc[2][2][4][2];
#pragma unroll
    for (int a = 0; a < 2; ++a)
#pragma unroll
        for (int b = 0; b < 2; ++b)
#pragma unroll
            for (int m = 0; m < 4; ++m)
#pragma unroll
                for (int n = 0; n < 2; ++n) acc[a][b][m][n] = (f32x4){0.f, 0.f, 0.f, 0.f};
    bf16x8 At[4][2], B0[2][2], B1[2][2];
    const char* cA = (const char*)g.A + (size_t)cur.pm * tstep; const char* cB = (const char*)g.Bt + (size_t)cur.pn * tstep;
    S.a_ready(cur);
    if constexpr (SP2) {
        PG8_STAGE(PG8_SB(0, 0), cB, voffB); PG8_STAGE(PG8_SB(0, 1), cB + hstep, voffB); PG8_STAGE(PG8_SA(0, 0), cA, voffA); PG8_STAGE(PG8_SA(0, 1), cA + hstep, voffA);
        if (wr == 1) PG8_BAR;
        PG8_WAIT_V(2); PG8_BAR;
        PG8_STAGE(PG8_SB(1, 0), cB + kstep, voffB); PG8_STAGE(PG8_SA(1, 0), cA + kstep, voffA); PG8_STAGE(PG8_SB(1, 1), cB + hstep + kstep, voffB);
        PG8_WAIT_V(6); PG8_BAR;
    } else {
        PG8_STAGE(PG8_SB(0, 0), cB, voffB); PG8_STAGE(PG8_SA(0, 0), cA, voffA); PG8_STAGE(PG8_SB(0, 1), cB + hstep, voffB); PG8_STAGE(PG8_SA(0, 1), cA + hstep, voffA);
        if (wr == 1) PG8_BAR;
        PG8_WAIT_V(4); PG8_BAR;
        PG8_STAGE(PG8_SB(1, 0), cB + kstep, voffB); PG8_STAGE(PG8_SA(1, 0), cA + kstep, voffA); PG8_STAGE(PG8_SB(1, 1), cB + hstep + kstep, voffB);
        PG8_WAIT_V(6); PG8_BAR;
    }
    for (;;) {
        const bool has_next = S.next(ui + 1, nxt);
        const char* nA = has_next ? (const char*)g.A + (size_t)nxt.pm * tstep : cA; const char* nB = has_next ? (const char*)g.Bt + (size_t)nxt.pn * tstep : cB;
        for (int t = 0; t < nt; t += 2) {
            const bool last = (t == nt - 2);
            const char* a1 = cA + (size_t)(t + 1) * kstep;
            const char* a2 = last ? nA : cA + (size_t)(t + 2) * kstep; const char* b2 = last ? nB : cB + (size_t)(t + 2) * kstep;
            const char* a3 = a2 + kstep; const char* b3 = b2 + kstep;
            if (last && has_next) S.a_ready(nxt);
            if constexpr (SP2) {
            PG8_LDB(B0, 0, 0); PG8_LDB(B1, 0, 1); PG8_SCHED; PG8_LDA(At, 0, 0); PG8_STAGE(PG8_SA(1, 1), a1 + hstep, voffA);
            PG8_WAIT_V(8); PG8_WAIT_L(0); PG8_BAR; PG8_MMA(0, 0, At, B0); PG8_MMA(0, 1, At, B1); PG8_BAR; PG8_SCHED;
            PG8_LDA(At, 0, 1); PG8_STAGE(PG8_SB(0, 0), b2, voffB); PG8_STAGE(PG8_SB(0, 1), b2 + hstep, voffB); PG8_STAGE(PG8_SA(0, 0), a2, voffA);
            PG8_WAIT_V(8); PG8_WAIT_L(0); PG8_BAR; PG8_MMA(1, 0, At, B0); PG8_MMA(1, 1, At, B1); PG8_BAR; PG8_SCHED;
            PG8_LDB(B0, 1, 0); PG8_LDB(B1, 1, 1); PG8_SCHED; PG8_LDA(At, 1, 0); PG8_STAGE(PG8_SA(0, 1), a2 + hstep, voffA);
            PG8_WAIT_V(8); PG8_WAIT_L(0); PG8_BAR; PG8_MMA(0, 0, At, B0); PG8_MMA(0, 1, At, B1); PG8_BAR; PG8_SCHED;
            PG8_LDA(At, 1, 1); PG8_STAGE(PG8_SB(1, 0), b3, voffB); PG8_STAGE(PG8_SB(1, 1), b3 + hstep, voffB); PG8_STAGE(PG8_SA(1, 0), a3, voffA);
            PG8_WAIT_V(8); PG8_WAIT_L(0); PG8_BAR; PG8_MMA(1, 0, At, B0); PG8_MMA(1, 1, At, B1); PG8_BAR; PG8_SCHED;
            } else {
            PG8_LDB(B0, 0, 0); PG8_SCHED; PG8_LDA(At, 0, 0); PG8_STAGE(PG8_SA(1, 1), a1 + hstep, voffA);
            PG8_WAIT_L(8); PG8_BAR; PG8_WAIT_L(0); PG8_MMA(0, 0, At, B0); PG8_BAR; PG8_SCHED;
            PG8_LDB(B1, 0, 1); PG8_STAGE(PG8_SB(0, 0), b2, voffB);
            PG8_BAR; PG8_WAIT_L(0); PG8_MMA(0, 1, At, B1); PG8_BAR;
            PG8_LDA(At, 0, 1); PG8_STAGE(PG8_SA(0, 0), a2, voffA);
            PG8_BAR; PG8_WAIT_L(0); PG8_MMA(1, 0, At, B0); PG8_BAR; PG8_SCHED;
            PG8_STAGE(PG8_SB(0, 1), b2 + hstep, voffB);
            PG8_WAIT_V(6); PG8_BAR; PG8_MMA(1, 1, At, B1); PG8_BAR;
            PG8_LDB(B0, 1, 0); PG8_SCHED; PG8_LDA(At, 1, 0); PG8_STAGE(PG8_SA(0, 1), a2 + hstep, voffA);
            PG8_WAIT_L(8); PG8_BAR; PG8_WAIT_L(0); PG8_MMA(0, 0, At, B0); PG8_BAR; PG8_SCHED;
            PG8_LDB(B1, 1, 1); PG8_STAGE(PG8_SB(1, 0), b3, voffB);
            PG8_BAR; PG8_WAIT_L(0); PG8_MMA(0, 1, At, B1); PG8_BAR;
            PG8_LDA(At, 1, 1); PG8_STAGE(PG8_SA(1, 0), a3, voffA);
            PG8_BAR; PG8_WAIT_L(0); PG8_MMA(1, 0, At, B0); PG8_BAR; PG8_SCHED;
            PG8_STAGE(PG8_SB(1, 1), b3 + hstep, voffB);
            PG8_WAIT_V(6); PG8_BAR; PG8_MMA(1, 1, At, B1); PG8_BAR;
            }
        }
        if constexpr (ALIGN_EPI) { if (wr == 0) PG8_BAR; }
        if constexpr (!Epi::AFTER_DRAIN) { E(acc, cur, wr, wc, fr, fq); S.done(cur); }
        if (!has_next) break;
#pragma unroll
        for (int a = 0; a < 2; ++a)
#pragma unroll
            for (int b = 0; b < 2; ++b)
#pragma unroll
                for (int m = 0; m < 4; ++m)
#pragma unroll
                    for (int n = 0; n < 2; ++n) acc[a][b][m][n] = (f32x4){0.f, 0.f, 0.f, 0.f};
        cur = nxt; cA = nA; cB = nB; ++ui;
        if constexpr (ALIGN_EPI) { if (wr == 1) PG8_BAR; }
    }
    PG8_WAIT_V(0);
    if constexpr (!ALIGN_EPI) { if (wr == 0) PG8_BAR; }
    PG8_BAR;
    if constexpr (Epi::AFTER_DRAIN) { E.fused(acc, cur, wr, wc, fr, fq, lds, wid, lane); S.done(cur); }
#undef PG8_SA
#undef PG8_SB
#undef PG8_STAGE
#undef PG8_LDA
#undef PG8_LDB
#undef PG8_MMA
#undef PG8_WAIT_V
#undef PG8_WAIT_L
#undef PG8_BAR
#undef PG8_SCHED
}
}

constexpr int SEQ = 16384, DM = 4096, DEPTH = 4, NMEM = 256, BRW = 3072, MEMW = 1024, NHEAD = 4, HDIM = 256;
constexpr int NIN_CONV = 14336, NIN_GMLP = 11264, NKV = 2048;
constexpr float RMS_EPS = 1e-6f, LNORM_EPS = 1e-5f;
constexpr int NWAVES = 8;
#ifndef MK_ONE_LAUNCH
#define MK_ONE_LAUNCH 0
#endif
constexpr int NPHASE = 2 + 4 * DEPTH;

constexpr size_t MiB = 1u << 20;
constexpr size_t WS_CTL = 0, CTL_ZERO_BYTES = 1 * MiB;
constexpr size_t WS_WIN = 2 * MiB;
constexpr size_t WIN_OFF0 = 0, WIN_OFF1 = 112 * MiB, WIN_OFF2 = 200 * MiB, WIN_OFF3 = 312 * MiB;
constexpr size_t WS_WOUT = WS_WIN + 400 * MiB;
constexpr size_t WS_WKV = WS_WOUT + 128 * MiB;
constexpr size_t WS_MEMB = WS_WKV + 64 * MiB;
constexpr size_t WS_KV = WS_MEMB + 2 * MiB;
constexpr size_t WS_XB = WS_KV + 4 * MiB;
constexpr size_t WS_A1 = WS_XB + 128 * MiB;
constexpr size_t WS_A2 = WS_A1 + 96 * MiB;
constexpr size_t WS_Q = WS_A2 + 96 * MiB;
constexpr size_t WS_SZ = WS_Q + 32 * MiB;
constexpr size_t WS_Y = WS_SZ + 32 * MiB;
constexpr size_t WS_YO = WS_Y + 128 * MiB;
constexpr size_t WS_RSTD = WS_YO + 128 * MiB;
constexpr size_t WS_RSTDM = WS_RSTD + 1 * MiB;
constexpr size_t WS_VST = WS_RSTDM + 1 * MiB;
constexpr size_t WS_YSS = WS_VST + 6 * MiB;
constexpr size_t WS_END = WS_YSS + 4 * MiB;
static_assert(WS_A2 - WS_A1 == 2 * pg8::EpiProj::OFF_A2 && WS_Q - WS_A1 == 2 * pg8::EpiProj::OFF_Q && WS_SZ - WS_A1 == 2 * pg8::EpiProj::OFF_SZ, "EpiProj output offsets");
constexpr int CW_BAR = 4096;

constexpr int RING_BYTES = 131072;
constexpr int LDS_BYTES = 147456;
constexpr int MISC_OFF = LDS_BYTES - 128;

#define GAS __attribute__((address_space(1)))
#define LAS __attribute__((address_space(3)))
typedef unsigned short bf16;
typedef unsigned v4u __attribute__((ext_vector_type(4)));
typedef unsigned v2u __attribute__((ext_vector_type(2)));
typedef float f32x4 __attribute__((ext_vector_type(4)));
typedef short bf16x8 __attribute__((ext_vector_type(8)));
#define LDS_WAIT() asm volatile("s_waitcnt lgkmcnt(0)" ::: "memory")
__device__ __forceinline__ unsigned f2bf(float f) { unsigned u = __builtin_bit_cast(unsigned, f); return (u + 0x7fffu + ((u >> 16) & 1u)) >> 16; }
__device__ __forceinline__ unsigned pk2(float lo, float hi) { return pg8::cvt_pk_bf16(lo, hi); }
__device__ __forceinline__ float bflo(unsigned w) { return __builtin_bit_cast(float, w << 16); }
__device__ __forceinline__ float bfhi(unsigned w) { return __builtin_bit_cast(float, w & 0xffff0000u); }
__device__ __forceinline__ float wave_sum(float v) {
#pragma unroll
    for (int o = 1; o < 64; o <<= 1) v += __shfl_xor(v, o);
    return v;
}

#define XB_TMO      128
#define XB_XCNT(j)  (256  + 64 * (j))
#define XB_XSUB(j)  (1280 + 64 * (j))
#define XB_XGEN(j)  (2304 + 64 * (j))
#define XB_TOP      3328
#define XB_TOPGEN   3392
#define XCD_BAR_WORDS 3456
#define XB_SPIN_CAP (1u << 18)

__device__ __forceinline__ unsigned xb_ld(unsigned* p)              { return __hip_atomic_load(p, __ATOMIC_RELAXED, __HIP_MEMORY_SCOPE_AGENT); }
__device__ __forceinline__ unsigned xb_add(unsigned* p, unsigned v) { return __hip_atomic_fetch_add(p, v, __ATOMIC_RELAXED, __HIP_MEMORY_SCOPE_AGENT); }
__device__ __forceinline__ unsigned xb_xcc_id() { return (unsigned)__builtin_amdgcn_s_getreg((3 << 11) | 20) & 0xFu; }
#define XB_SPIN(cond, bar) do { unsigned _sp = 0; while (cond) { __builtin_amdgcn_s_sleep(1); \
    if ((++_sp & 255u) == 0u) { if (xb_ld(&(bar)[XB_TMO])) break; if (_sp > XB_SPIN_CAP) { atomicAdd(&(bar)[XB_TMO], 1u); break; } } } } while (0)

struct XcdBarrier {
    unsigned* bar; unsigned x;
    volatile LAS unsigned* st;
};
__device__ __forceinline__ XcdBarrier xcd_barrier_post(unsigned* bar, volatile LAS unsigned* st) {
    XcdBarrier b; b.bar = bar; b.x = xb_xcc_id(); b.st = st;
    if (threadIdx.x == 0) (void)xb_add(&bar[XB_XCNT(b.x)], 1u);
    return b;
}
__device__ __forceinline__ void xcd_barrier_complete(unsigned* bar, unsigned x, unsigned& nloc, unsigned& nx) {
    const unsigned G = gridDim.x * gridDim.y * gridDim.z;
    unsigned sum, cnt, mine, sp = 0u;
    for (;;) {
        sum = 0u; cnt = 0u; mine = 0u;
#pragma unroll
        for (unsigned j = 0; j < 16; ++j) { const unsigned c = xb_ld(&bar[XB_XCNT(j)]); sum += c; cnt += (c > 0u) ? 1u : 0u; mine = (j == x) ? c : mine; }
        if (sum == G) break;
        __builtin_amdgcn_s_sleep(1);
        if ((++sp & 255u) == 0u) { if (xb_ld(&bar[XB_TMO])) break; if (sp > XB_SPIN_CAP) { atomicAdd(&bar[XB_TMO], 1u); break; } }
    }
    nloc = mine > 0u ? mine : 1u; nx = cnt > 0u ? cnt : 1u;
}
__device__ __forceinline__ void xcd_barrier(const XcdBarrier& b) {
    asm volatile("s_waitcnt vmcnt(0)" ::: "memory");
    __syncthreads();
    if (threadIdx.x == 0) {
        unsigned* bar = b.bar;
        __builtin_amdgcn_s_waitcnt(0);
        unsigned nloc = b.st[0], nx = b.st[1];
        if (nloc == 0u) { xcd_barrier_complete(bar, b.x, nloc, nx); b.st[0] = nloc; b.st[1] = nx; }
        const unsigned old = xb_add(&bar[XB_XSUB(b.x)], 1u);
        const unsigned gen = old / nloc;
        if (old + 1u == (gen + 1u) * nloc) {
            __builtin_amdgcn_fence(__ATOMIC_RELEASE, "agent");
            asm volatile("s_waitcnt vmcnt(0)" ::: "memory");
            const unsigned og = xb_add(&bar[XB_TOP], 1u);
            const unsigned tg = og / nx;
            if (og + 1u == (tg + 1u) * nx) xb_add(&bar[XB_TOPGEN], 1u);
            else XB_SPIN(xb_ld(&bar[XB_TOPGEN]) == tg, bar);
            __builtin_amdgcn_fence(__ATOMIC_ACQUIRE, "agent");
            xb_add(&bar[XB_XGEN(b.x)], 1u);
            asm volatile("s_waitcnt vmcnt(0)" ::: "memory");
        } else {
            XB_SPIN(xb_ld(&bar[XB_XGEN(b.x)]) == gen, bar);
            __builtin_amdgcn_fence(__ATOMIC_ACQUIRE, "agent");
            asm volatile("s_waitcnt vmcnt(0)" ::: "memory");
        }
    }
    __syncthreads();
}

__device__ __forceinline__ int src32_conv(int gi) { const int pn = gi >> 3, bj = (gi >> 2) & 1, wc = gi & 3;
    if (pn < 24) return (bj ? 10240 : 0) + 128 * pn + 32 * wc;
    if (pn < 48) return (bj ? 6144 : 3072) + 128 * (pn - 24) + 32 * wc;
    if (pn < 52) return 9216 + 256 * (pn - 48) + 128 * bj + 32 * wc;
    return 13312 + 256 * (pn - 52) + 128 * bj + 32 * wc; }
__device__ __forceinline__ int src32_gmlp(int gi) { const int pn = gi >> 3, bj = (gi >> 2) & 1, wc = gi & 3;
    if (pn < 24) return (bj ? 7168 : 0) + 128 * pn + 32 * wc;
    if (pn < 36) return 3072 + 256 * (pn - 24) + 128 * bj + 32 * wc;
    if (pn < 40) return 6144 + 256 * (pn - 36) + 128 * bj + 32 * wc;
    return 10240 + 256 * (pn - 40) + 128 * bj + 32 * wc; }
__device__ __forceinline__ void cvt_item(const float* W, int N, int src32, const float* gk, bf16* WT, int slot0, int k0, LAS float* scr, int lane) {
#pragma unroll 8
    for (int i = 0; i < 32; ++i) { const int kk = 2 * i + (lane >> 5); scr[kk * 33 + (lane & 31)] = W[(size_t)(k0 + kk) * N + src32 + (lane & 31)]; }
    const int c = lane & 7;
    f32x4 g0 = (f32x4){1.f, 1.f, 1.f, 1.f}, g1 = g0;
    if (gk) { g0 = *(const f32x4*)(gk + k0 + 8 * c); g1 = *(const f32x4*)(gk + k0 + 8 * c + 4); }
    LDS_WAIT(); asm volatile("" ::: "memory");
#pragma unroll
    for (int j = 0; j < 4; ++j) { const int n = (lane >> 3) + 8 * j; const LAS float* s = scr + (8 * c) * 33 + pg8::perm32(n);
        v4u o; o.x = pk2(s[0 * 33] * g0[0], s[1 * 33] * g0[1]); o.y = pk2(s[2 * 33] * g0[2], s[3 * 33] * g0[3]); o.z = pk2(s[4 * 33] * g1[0], s[5 * 33] * g1[1]); o.w = pk2(s[6 * 33] * g1[2], s[7 * 33] * g1[3]);
        *(v4u*)(WT + (size_t)(slot0 + n) * DM + k0 + 8 * c) = o; }
    LDS_WAIT(); asm volatile("" ::: "memory");
}
__device__ __forceinline__ void row_to_bf16(const float* xr, bf16* orow, float* rstd_out, int lane) {
    float ss = 0.f;
#pragma unroll
    for (int i = 0; i < 8; ++i) { const int col = 512 * i + 8 * lane; const f32x4 a = *(const f32x4*)(xr + col), b = *(const f32x4*)(xr + col + 4);
        ss += (a[0] * a[0] + a[1] * a[1]) + (a[2] * a[2] + a[3] * a[3]) + (b[0] * b[0] + b[1] * b[1]) + (b[2] * b[2] + b[3] * b[3]);
        v4u o; o.x = pk2(a[0], a[1]); o.y = pk2(a[2], a[3]); o.z = pk2(b[0], b[1]); o.w = pk2(b[2], b[3]); *(v4u*)(orow + col) = o; }
    ss = wave_sum(ss);
    if (lane == 0) *rstd_out = 1.0f / sqrtf(ss * (1.0f / DM) + RMS_EPS);
}

struct Args { const float* in[14]; float* out; unsigned char* ws; int ph_lo, ph_hi; };

__device__ __forceinline__ void p0_convert(const Args& a, unsigned char* ws, LAS unsigned char* lds, int gw, int NGW, int wave, int lane) {
    LAS float* scr = (LAS float*)(lds + wave * 16384);
    const float* x = a.in[0]; const float* mem = a.in[1]; const float* pre_g = a.in[2]; const float* mem_g = a.in[4];
    const float* w_kv = a.in[5]; const float* w_out = a.in[6]; const float* conv_w_in = a.in[7]; const float* gmlp_w_in = a.in[9];
    constexpr int I_KV = 64 * (NKV / 32), I_OUT = 64 * (DM / 32), I_CONV = 64 * (NIN_CONV / 32), I_GMLP = 64 * (NIN_GMLP / 32);
    constexpr int NITEMS = 4 * I_KV + 4 * I_OUT + 2 * I_CONV + 2 * I_GMLP;
    for (int it = gw; it < NITEMS; it += NGW) {
        int r = it; const float* W; const float* gk; bf16* WT; int N, ng, type;
        if (r < 4 * I_KV) { const int l = r / I_KV; r -= l * I_KV; W = w_kv + (size_t)l * DM * NKV; N = NKV; ng = NKV / 32; type = 2; gk = mem_g + l * DM; WT = (bf16*)(ws + WS_WKV) + (size_t)l * NKV * DM; }
        else { r -= 4 * I_KV;
            if (r < 4 * I_OUT) { const int l = r / I_OUT; r -= l * I_OUT; W = w_out + (size_t)l * DM * DM; N = DM; ng = DM / 32; type = 2; gk = nullptr; WT = (bf16*)(ws + WS_WOUT) + (size_t)l * DM * DM; }
            else { r -= 4 * I_OUT;
                if (r < 2 * I_CONV) { const int j = r / I_CONV; r -= j * I_CONV; W = conv_w_in + (size_t)j * DM * NIN_CONV; N = NIN_CONV; ng = NIN_CONV / 32; type = 0; gk = pre_g + (2 * j) * DM; WT = (bf16*)(ws + WS_WIN + (j ? WIN_OFF2 : WIN_OFF0)); }
                else { r -= 2 * I_CONV; const int j = r / I_GMLP; r -= j * I_GMLP; W = gmlp_w_in + (size_t)j * DM * NIN_GMLP; N = NIN_GMLP; ng = NIN_GMLP / 32; type = 1; gk = pre_g + (2 * j + 1) * DM; WT = (bf16*)(ws + WS_WIN + (j ? WIN_OFF3 : WIN_OFF1)); } } }
        const int kb = r / ng, gi = r - kb * ng;
        const int s32 = (type == 0) ? src32_conv(gi) : (type == 1) ? src32_gmlp(gi) : 32 * gi;
        cvt_item(W, N, s32, gk, WT, 32 * gi, 64 * kb, scr, lane);
    }
    for (int m = gw; m < SEQ; m += NGW) row_to_bf16(x + (size_t)m * DM, (bf16*)(ws + WS_XB) + (size_t)m * DM, (float*)(ws + WS_RSTD) + m, lane);
    for (int m = gw; m < NMEM; m += NGW) row_to_bf16(mem + (size_t)m * DM, (bf16*)(ws + WS_MEMB) + (size_t)m * DM, (float*)(ws + WS_RSTDM) + m, lane);
}

__device__ __forceinline__ void attn_task(const bf16* Q, const bf16* SZ, const bf16* Kl, const bf16* VTl, bf16* Y, int t0, int h, int lane) {
    const int fr = lane & 15, fq = lane >> 4;
    bf16x8 qf[8];
    const bf16* qp = Q + (size_t)(t0 + fr) * MEMW + HDIM * h + 8 * fq;
#pragma unroll
    for (int ks = 0; ks < 8; ++ks) qf[ks] = *(const bf16x8*)(qp + 32 * ks);
    f32x4 s[16];
    const bf16* kp = Kl + (size_t)fr * MEMW + HDIM * h + 8 * fq;
#pragma unroll
    for (int mb = 0; mb < 16; ++mb) { f32x4 acc = (f32x4){0.f, 0.f, 0.f, 0.f};
#pragma unroll
        for (int ks = 0; ks < 8; ++ks) { const bf16x8 kf = *(const bf16x8*)(kp + (size_t)mb * 16 * MEMW + 32 * ks); acc = __builtin_amdgcn_mfma_f32_16x16x32_bf16(kf, qf[ks], acc, 0, 0, 0); }
        s[mb] = acc; }
    float mx = s[0][0];
#pragma unroll
    for (int mb = 0; mb < 16; ++mb)
#pragma unroll
        for (int j = 0; j < 4; ++j) mx = fmaxf(mx, s[mb][j]);
    mx = fmaxf(mx, __shfl_xor(mx, 16)); mx = fmaxf(mx, __shfl_xor(mx, 32));
    float sum = 0.f; const float mxl = mx * 1.44269504f;
#pragma unroll
    for (int mb = 0; mb < 16; ++mb)
#pragma unroll
        for (int j = 0; j < 4; ++j) { const float p = __builtin_amdgcn_exp2f(s[mb][j] * 1.44269504f - mxl); s[mb][j] = p; sum += p; }
    sum += __shfl_xor(sum, 16); sum += __shfl_xor(sum, 32);
    const float inv = 1.0f / sum;
    bf16x8 pf[8];
#pragma unroll
    for (int ks2 = 0; ks2 < 8; ++ks2) { v4u w; w.x = pk2(s[2 * ks2][0], s[2 * ks2][1]); w.y = pk2(s[2 * ks2][2], s[2 * ks2][3]); w.z = pk2(s[2 * ks2 + 1][0], s[2 * ks2 + 1][1]); w.w = pk2(s[2 * ks2 + 1][2], s[2 * ks2 + 1][3]);
        pf[ks2] = __builtin_bit_cast(bf16x8, w); }
    const bf16* vp = VTl + (size_t)(HDIM * h + 8 * (fr >> 2) + (fr & 3)) * NMEM + 4 * fq;
    const bf16* szp = SZ + (size_t)(t0 + fr) * MEMW + HDIM * h + 8 * fq;
    bf16* yp = Y + (size_t)(t0 + fr) * DM + BRW + HDIM * h + 8 * fq;
#pragma unroll
    for (int db2 = 0; db2 < 8; ++db2) { f32x4 o0 = (f32x4){0.f, 0.f, 0.f, 0.f}, o1 = o0;
#pragma unroll
        for (int ks2 = 0; ks2 < 8; ++ks2) { const bf16* v0 = vp + (size_t)(32 * db2) * NMEM + 32 * ks2; const bf16* v1 = v0 + 4 * NMEM;
            v4u a0, a1; const v2u x0 = *(const v2u*)v0, x1 = *(const v2u*)(v0 + 16), y0 = *(const v2u*)v1, y1 = *(const v2u*)(v1 + 16);
            a0.x = x0.x; a0.y = x0.y; a0.z = x1.x; a0.w = x1.y; a1.x = y0.x; a1.y = y0.y; a1.z = y1.x; a1.w = y1.y;
            o0 = __builtin_amdgcn_mfma_f32_16x16x32_bf16(__builtin_bit_cast(bf16x8, a0), pf[ks2], o0, 0, 0, 0);
            o1 = __builtin_amdgcn_mfma_f32_16x16x32_bf16(__builtin_bit_cast(bf16x8, a1), pf[ks2], o1, 0, 0, 0); }
        const v4u z = *(const v4u*)(szp + 32 * db2);
        v4u w; w.x = pk2(o0[0] * inv * bflo(z.x), o0[1] * inv * bfhi(z.x)); w.y = pk2(o0[2] * inv * bflo(z.y), o0[3] * inv * bfhi(z.y));
        w.z = pk2(o1[0] * inv * bflo(z.z), o1[1] * inv * bfhi(z.z)); w.w = pk2(o1[2] * inv * bflo(z.w), o1[3] * inv * bfhi(z.w));
        *(v4u*)(yp + 32 * db2) = w; }
}

__device__ __forceinline__ void conv_task(const bf16* GZ, const bf16* CH, const float* cw  , bf16* Y, int task, int lane) {
    const int rsx = task / 6, cs = task - rsx * 6; const int t0 = 32 * rsx, c = 512 * cs + 8 * lane;
    float w0[8], w1[8], w2[8], p2[8], p1[8];
    { const f32x4 a = *(const f32x4*)(cw + c), b = *(const f32x4*)(cw + c + 4), d = *(const f32x4*)(cw + BRW + c), e = *(const f32x4*)(cw + BRW + c + 4), f = *(const f32x4*)(cw + 2 * BRW + c), g = *(const f32x4*)(cw + 2 * BRW + c + 4);
#pragma unroll
      for (int i = 0; i < 4; ++i) { w0[i] = a[i]; w0[4 + i] = b[i]; w1[i] = d[i]; w1[4 + i] = e[i]; w2[i] = f[i]; w2[4 + i] = g[i]; } }
    if (t0 >= 2) { const v4u u2 = *(const v4u*)(CH + (size_t)(t0 - 2) * BRW + c), u1 = *(const v4u*)(CH + (size_t)(t0 - 1) * BRW + c);
        p2[0] = bflo(u2.x); p2[1] = bfhi(u2.x); p2[2] = bflo(u2.y); p2[3] = bfhi(u2.y); p2[4] = bflo(u2.z); p2[5] = bfhi(u2.z); p2[6] = bflo(u2.w); p2[7] = bfhi(u2.w);
        p1[0] = bflo(u1.x); p1[1] = bfhi(u1.x); p1[2] = bflo(u1.y); p1[3] = bfhi(u1.y); p1[4] = bflo(u1.z); p1[5] = bfhi(u1.z); p1[6] = bflo(u1.w); p1[7] = bfhi(u1.w); }
    else {
#pragma unroll
        for (int i = 0; i < 8; ++i) { p2[i] = 0.f; p1[i] = 0.f; } }
#pragma unroll 4
    for (int t = t0; t < t0 + 32; ++t) {
        const v4u uc = *(const v4u*)(CH + (size_t)t * BRW + c), ug = *(const v4u*)(GZ + (size_t)t * BRW + c);
        float cu[8], gz[8], o[8];
        cu[0] = bflo(uc.x); cu[1] = bfhi(uc.x); cu[2] = bflo(uc.y); cu[3] = bfhi(uc.y); cu[4] = bflo(uc.z); cu[5] = bfhi(uc.z); cu[6] = bflo(uc.w); cu[7] = bfhi(uc.w);
        gz[0] = bflo(ug.x); gz[1] = bfhi(ug.x); gz[2] = bflo(ug.y); gz[3] = bfhi(ug.y); gz[4] = bflo(ug.z); gz[5] = bfhi(ug.z); gz[6] = bflo(ug.w); gz[7] = bfhi(ug.w);
#pragma unroll
        for (int i = 0; i < 8; ++i) { o[i] = gz[i] * (w0[i] * p2[i] + w1[i] * p1[i] + w2[i] * cu[i]); p2[i] = p1[i]; p1[i] = cu[i]; }
        v4u w; w.x = pk2(o[0], o[1]); w.y = pk2(o[2], o[3]); w.z = pk2(o[4], o[5]); w.w = pk2(o[6], o[7]);
        *(v4u*)(Y + (size_t)t * DM + c) = w; }
}

constexpr int SP_LD = 136;
constexpr int SP_WL = 0, SP_VTL = 128 * SP_LD * 2, SP_MU = SP_VTL + 384 * SP_LD * 2, SP_RS = SP_MU + 512, SP_END = SP_RS + 512;
static_assert(SP_END <= MISC_OFF, "spatial LDS map");
__device__ __forceinline__ void spatial_unit(const bf16* VG, const bf16* UZ, const float* vst, const float* Wg, const float* bsg, const float* lng, const float* lnb, bf16* Y, int nb, int g, LAS unsigned char* lds, int tid) {
    LAS bf16* WL = (LAS bf16*)(lds + SP_WL); LAS bf16* VTL = (LAS bf16*)(lds + SP_VTL); LAS float* MU = (LAS float*)(lds + SP_MU); LAS float* RS = (LAS float*)(lds + SP_RS);
    const int lane = tid & 63, wave = __builtin_amdgcn_readfirstlane(tid >> 6), fr = lane & 15, fq = lane >> 4;
    if (tid < 128) { const float* q = vst + (size_t)(128 * nb + tid) * 96; float s1 = 0.f, s2 = 0.f;
#pragma unroll 8
        for (int k = 0; k < 48; ++k) { s1 += q[2 * k]; s2 += q[2 * k + 1]; }
        const float mu = s1 * (1.0f / BRW), var = s2 * (1.0f / BRW) - mu * mu; MU[tid] = mu; RS[tid] = 1.0f / sqrtf(var + LNORM_EPS); }
    { const int t = tid >> 2, s0 = (tid & 3) * 32;
#pragma unroll
        for (int q = 0; q < 4; ++q) { const int sb = s0 + 8 * q; const f32x4 a = *(const f32x4*)(Wg + t * 128 + sb), b = *(const f32x4*)(Wg + t * 128 + sb + 4);
            float v[8] = {a[0], a[1], a[2], a[3], b[0], b[1], b[2], b[3]};
#pragma unroll
            for (int e = 0; e < 8; ++e) v[e] = (sb + e <= t) ? v[e] : 0.f;
            v4u o; o.x = pk2(v[0], v[1]); o.y = pk2(v[2], v[3]); o.z = pk2(v[4], v[5]); o.w = pk2(v[6], v[7]);
            *(LAS v4u*)(WL + t * SP_LD + sb) = o; } }
    __syncthreads();
    { const int s = (lane & 31) + 32 * (wave & 3); const float mu = MU[s], rs = RS[s];
#pragma unroll 4
        for (int it = 0; it < 12; ++it) { const int c = 8 * ((lane >> 5) + 2 * (wave >> 2) + 4 * it);
            const v4u u = *(const v4u*)(VG + (size_t)(128 * nb + s) * BRW + 384 * g + c);
            const f32x4 g0 = *(const f32x4*)(lng + 384 * g + c), g1 = *(const f32x4*)(lng + 384 * g + c + 4), b0 = *(const f32x4*)(lnb + 384 * g + c), b1 = *(const f32x4*)(lnb + 384 * g + c + 4);
            float v[8] = {bflo(u.x), bfhi(u.x), bflo(u.y), bfhi(u.y), bflo(u.z), bfhi(u.z), bflo(u.w), bfhi(u.w)};
#pragma unroll
            for (int e = 0; e < 8; ++e) { const float gg = e < 4 ? g0[e & 3] : g1[e & 3], bb = e < 4 ? b0[e & 3] : b1[e & 3]; VTL[(c + e) * SP_LD + s] = (bf16)f2bf((v[e] - mu) * rs * gg + bb); } } }
    __syncthreads();
    const int th = wave >> 2, d0w = 96 * (wave & 3);
    f32x4 acc[4][3][2];
#pragma unroll
    for (int i = 0; i < 4; ++i)
#pragma unroll
        for (int dp = 0; dp < 3; ++dp) { acc[i][dp][0] = (f32x4){0.f, 0.f, 0.f, 0.f}; acc[i][dp][1] = (f32x4){0.f, 0.f, 0.f, 0.f}; }
#pragma unroll
    for (int i = 0; i < 4; ++i) { const int tb = th ? ((i == 0) ? 1 : (i == 1) ? 2 : (i == 2) ? 5 : 6) : ((i == 0) ? 0 : (i == 1) ? 3 : (i == 2) ? 4 : 7); const int kmax = tb >> 1;
#pragma unroll
        for (int ks = 0; ks < 4; ++ks) if (ks <= kmax) {
            const bf16x8 bw = *(const LAS bf16x8*)(WL + (16 * tb + fr) * SP_LD + 32 * ks + 8 * fq);
#pragma unroll
            for (int dp = 0; dp < 3; ++dp)
#pragma unroll
                for (int e = 0; e < 2; ++e) { const bf16x8 av = *(const LAS bf16x8*)(VTL + (d0w + 32 * dp + 8 * (fr >> 2) + 4 * e + (fr & 3)) * SP_LD + 32 * ks + 8 * fq);
                    acc[i][dp][e] = __builtin_amdgcn_mfma_f32_16x16x32_bf16(av, bw, acc[i][dp][e], 0, 0, 0); } } }
#pragma unroll
    for (int i = 0; i < 4; ++i) { const int tb = th ? ((i == 0) ? 1 : (i == 1) ? 2 : (i == 2) ? 5 : 6) : ((i == 0) ? 0 : (i == 1) ? 3 : (i == 2) ? 4 : 7);
        const int tl = 16 * tb + fr; const float bs = bsg[tl]; const size_t row = (size_t)(128 * nb + tl);
#pragma unroll
        for (int dp = 0; dp < 3; ++dp) { const int d = 384 * g + d0w + 32 * dp + 8 * fq; const v4u u = *(const v4u*)(UZ + row * BRW + d);
            const f32x4 f0 = acc[i][dp][0] + bs, f1 = acc[i][dp][1] + bs;
            v4u w; w.x = pk2(bflo(u.x) * f0[0], bfhi(u.x) * f0[1]); w.y = pk2(bflo(u.y) * f0[2], bfhi(u.y) * f0[3]); w.z = pk2(bflo(u.z) * f1[0], bfhi(u.z) * f1[1]); w.w = pk2(bflo(u.w) * f1[2], bfhi(u.w) * f1[3]);
            *(v4u*)(Y + row * DM + d) = w; } }
    __syncthreads();
}

__device__ __forceinline__ void p4_rows(const bf16* YO, const float* yss, const float* gpost, bf16* XB, float* rstd, float* out, bool last, int gw, int NGW, int lane) {
    for (int m = gw; m < SEQ; m += NGW) {
        const float tot = wave_sum(yss[(size_t)m * 64 + lane]); const float rsy = 1.0f / sqrtf(tot * (1.0f / DM) + RMS_EPS);
        float ss = 0.f;
#pragma unroll 2
        for (int i = 0; i < 8; ++i) { const int col = 512 * i + 8 * lane;
            const v4u yo = *(const v4u*)(YO + (size_t)m * DM + col), xb = *(const v4u*)(XB + (size_t)m * DM + col); const f32x4 g0 = *(const f32x4*)(gpost + col), g1 = *(const f32x4*)(gpost + col + 4);
            float xn[8];
            xn[0] = bflo(xb.x) + bflo(yo.x) * rsy * g0[0]; xn[1] = bfhi(xb.x) + bfhi(yo.x) * rsy * g0[1]; xn[2] = bflo(xb.y) + bflo(yo.y) * rsy * g0[2]; xn[3] = bfhi(xb.y) + bfhi(yo.y) * rsy * g0[3];
            xn[4] = bflo(xb.z) + bflo(yo.z) * rsy * g1[0]; xn[5] = bfhi(xb.z) + bfhi(yo.z) * rsy * g1[1]; xn[6] = bflo(xb.w) + bflo(yo.w) * rsy * g1[2]; xn[7] = bfhi(xb.w) + bfhi(yo.w) * rsy * g1[3];
#pragma unroll
            for (int e = 0; e < 8; ++e) ss += xn[e] * xn[e];
            if (last) { *(f32x4*)(out + (size_t)m * DM + col) = (f32x4){xn[0], xn[1], xn[2], xn[3]}; *(f32x4*)(out + (size_t)m * DM + col + 4) = (f32x4){xn[4], xn[5], xn[6], xn[7]}; }
            else { v4u w; w.x = pk2(xn[0], xn[1]); w.y = pk2(xn[2], xn[3]); w.z = pk2(xn[4], xn[5]); w.w = pk2(xn[6], xn[7]); *(v4u*)(XB + (size_t)m * DM + col) = w; } }
        if (!last) { ss = wave_sum(ss); if (lane == 0) rstd[m] = 1.0f / sqrtf(ss * (1.0f / DM) + RMS_EPS); }
    }
}

__global__ void __launch_bounds__(NWAVES * 64, 2) mk_fwd(Args args) {
    extern __shared__ __attribute__((aligned(16))) unsigned char lds_raw[];
    LAS unsigned char* lds = (LAS unsigned char*)lds_raw;
    const int G = gridDim.x, NGW = G * NWAVES;
    unsigned char* ws = args.ws;
    const int lo = args.ph_lo, hi = args.ph_hi;
    if (threadIdx.x < 32) ((LAS unsigned*)(lds + MISC_OFF))[threadIdx.x] = 0u;
    __syncthreads();
    XcdBarrier bar; bar.bar = (unsigned*)(ws + WS_CTL) + CW_BAR; bar.x = 0; bar.st = (volatile LAS unsigned*)(lds + MISC_OFF);
    if (hi - lo > 1) bar = xcd_barrier_post((unsigned*)(ws + WS_CTL) + CW_BAR, (volatile LAS unsigned*)(lds + MISC_OFF));
#define IN(k) (lo <= (k) && (k) < hi)
#define OPAQUE_IDS() int tid_ = threadIdx.x; asm volatile("" : "+v"(tid_)); const int tid = tid_, lane = tid & 63, wave = __builtin_amdgcn_readfirstlane(tid >> 6); int bx_ = blockIdx.x; asm volatile("" : "+s"(bx_)); const int gw = bx_ * NWAVES + wave; (void)gw; (void)lane
#define SEAM(k) do { if (IN(k) && IN((k) + 1)) xcd_barrier(bar); } while (0)

    bf16* const XB = (bf16*)(ws + WS_XB); bf16* const A1 = (bf16*)(ws + WS_A1); bf16* const A2 = (bf16*)(ws + WS_A2); bf16* const QB = (bf16*)(ws + WS_Q); bf16* const SZ = (bf16*)(ws + WS_SZ);
    bf16* const YB = (bf16*)(ws + WS_Y); bf16* const YO = (bf16*)(ws + WS_YO); bf16* const KVB = (bf16*)(ws + WS_KV);
    float* const RSTD = (float*)(ws + WS_RSTD); float* const RSTDM = (float*)(ws + WS_RSTDM); float* const VST = (float*)(ws + WS_VST); float* const YSS = (float*)(ws + WS_YSS);

    if (IN(0)) { OPAQUE_IDS(); p0_convert(args, ws, lds, gw, NGW, wave, lane); }
    SEAM(0);
    if (IN(1)) {
        pg8::Gemm g{(const bf16*)(ws + WS_MEMB), (const bf16*)(ws + WS_WKV), NMEM, DEPTH * NKV, DM}; pg8::StaticOrder S; S.init(NMEM, DEPTH * NKV, G, (int)blockIdx.x);
        pg8::EpiKV E{KVB, RSTDM};
        pg8::gemm_phase<pg8::EpiKV, pg8::StaticOrder, true, true>(lds, g, S, E);
    }
    SEAM(1);
    for (int L = 0; L < DEPTH; ++L) {
        const int k0 = 2 + 4 * L, gm = L & 1, jj = L >> 1;
        if (IN(k0)) {
            const size_t woff = (L == 0) ? WIN_OFF0 : (L == 1) ? WIN_OFF1 : (L == 2) ? WIN_OFF2 : WIN_OFF3; const int nin = gm ? NIN_GMLP : NIN_CONV;
            pg8::Gemm g{XB, (const bf16*)(ws + WS_WIN + woff), SEQ, nin, DM}; pg8::StaticOrder S; S.init(SEQ, nin, G, (int)blockIdx.x);
            pg8::EpiProj E{A1, RSTD, VST, gm};
            pg8::gemm_phase<pg8::EpiProj, pg8::StaticOrder, true, true>(lds, g, S, E);
        }
        SEAM(k0);
        if (IN(k0 + 1)) { OPAQUE_IDS();
            const bf16* Kl = KVB + (size_t)L * (2 * 256 * 1024); const bf16* VTl = Kl + 256 * 1024;
            if (gm) {
                const float* ws_w = args.in[12] + (size_t)jj * 8 * 128 * 128; const float* bs = args.in[13] + (size_t)jj * 8 * 128; const float* lng = args.in[10] + (size_t)jj * BRW; const float* lnb = args.in[11] + (size_t)jj * BRW;
                for (int un = bx_; un < 1024; un += G) { const int nb = un >> 3, gg = un & 7;
                    spatial_unit(A2, A1, VST, ws_w + (size_t)gg * 128 * 128, bs + gg * 128, lng, lnb, YB, nb, gg, lds, tid); }
            } else {
                const float* cw = args.in[8] + (size_t)jj * 3 * BRW;
                for (int task = gw; task < 512 * 6; task += NGW) conv_task(A1, A2, cw, YB, task, lane);
            }
            for (int task = gw; task < (SEQ / 16) * NHEAD; task += NGW) attn_task(QB, SZ, Kl, VTl, YB, 16 * (task >> 2), task & 3, lane);
        }
        SEAM(k0 + 1);
        if (IN(k0 + 2)) {
            pg8::Gemm g{YB, (const bf16*)(ws + WS_WOUT) + (size_t)L * DM * DM, SEQ, DM, DM}; pg8::StaticOrder S; S.init(SEQ, DM, G, (int)blockIdx.x);
            pg8::EpiOut E{YO, YSS};
            pg8::gemm_phase<pg8::EpiOut, pg8::StaticOrder, true, true>(lds, g, S, E);
        }
        SEAM(k0 + 2);
        if (IN(k0 + 3)) { OPAQUE_IDS(); p4_rows(YO, YSS, args.in[3] + (size_t)L * DM, XB, RSTD, args.out, L == DEPTH - 1, gw, NGW, lane); }
        if (L < DEPTH - 1) SEAM(k0 + 3);
    }
#undef IN
#undef SEAM
}

extern "C" void kernel_launch(void* const* d_in, const int* in_sizes, int n_in, void* d_out, int out_size, void* d_ws, size_t ws_size, hipStream_t stream) {
    static int grid = 0;
    if (grid == 0) {
        if (n_in != 14 || in_sizes[0] != SEQ * DM || out_size != SEQ * DM || ws_size < WS_END) { fprintf(stderr, "kernel_launch: unexpected shapes / workspace (n_in %d, in0 %d, out %d, ws %zu, need %zu); nothing launched\n", n_in, n_in > 0 ? in_sizes[0] : -1, out_size, ws_size, (size_t)WS_END); grid = -1; return; }
        int dev = 0, cus = 0, per_cu = 0;
        if (hipGetDevice(&dev) != hipSuccess || hipDeviceGetAttribute(&cus, hipDeviceAttributeMultiprocessorCount, dev) != hipSuccess) { grid = -1; return; }
        if (hipFuncSetAttribute((const void*)mk_fwd, hipFuncAttributeMaxDynamicSharedMemorySize, LDS_BYTES) != hipSuccess) { fprintf(stderr, "kernel_launch: hipFuncSetAttribute failed\n"); grid = -1; return; }
        if (hipOccupancyMaxActiveBlocksPerMultiprocessor(&per_cu, (const void*)mk_fwd, NWAVES * 64, LDS_BYTES) != hipSuccess || per_cu < 1) { fprintf(stderr, "kernel_launch: occupancy query says %d\n", per_cu); }
        (void)hipGetLastError();
        grid = cus;
    }
    if (grid < 0) return;
    if (hipMemsetAsync((char*)d_ws + WS_CTL, 0, CTL_ZERO_BYTES, stream) != hipSuccess) return;
    Args a{};
    for (int i = 0; i < 14; ++i) a.in[i] = (const float*)d_in[i];
    a.out = (float*)d_out; a.ws = (unsigned char*)d_ws;
#if MK_ONE_LAUNCH
    a.ph_lo = 0; a.ph_hi = NPHASE;
    hipLaunchKernelGGL(mk_fwd, dim3(grid), dim3(NWAVES * 64), LDS_BYTES, stream, a);
#else
    for (int k = 0; k < NPHASE; ++k) { a.ph_lo = k; a.ph_hi = k + 1; hipLaunchKernelGGL(mk_fwd, dim3(grid), dim3(NWAVES * 64), LDS_BYTES, stream, a); }
#endif
}
```

```cpp
#include <hip/hip_runtime.h>
#include <cstdio>
#include <cstdint>
namespace pg8 {
#define PG8_LAS __attribute__((address_space(3)))
typedef unsigned short bf16_t;
typedef short bf16x8 __attribute__((ext_vector_type(8)));
typedef float f32x4 __attribute__((ext_vector_type(4)));
typedef unsigned u32x4 __attribute__((ext_vector_type(4)));
constexpr int BM = 256, BK = 64, HALF = 128, HTB = HALF * BK * 2  , STAGE_BYTES = 8 * HTB, NXCD = 8, WGM = 8;

__host__ __device__ __forceinline__ int lds_byte(int r, int c) { const int st = (r >> 4) * 2 + (c >> 5), rr = r & 15, cc = c & 31, ob = rr * 64 + cc * 2; return st * 1024 + (ob ^ (((ob >> 9) & 1) << 5)); }
__host__ __device__ __forceinline__ void stage_rc(int b, int& R, int& C) { const int st = b / 1024, sb = b % 1024, swz = sb ^ (((sb >> 9) & 1) << 5); R = (st >> 1) * 16 + swz / 64; C = (st & 1) * 32 + (swz % 64) / 2; }
__host__ __device__ __forceinline__ int perm32(int rho) { const int n = rho >> 4, i = rho & 15; return 8 * (i >> 2) + 4 * n + (i & 3); }

struct Unit { int pm, pn; };
struct Gemm { const bf16_t* A; const bf16_t* Bt; int M, N, K; };

struct StaticOrder {
    int nM, nN, nwg, G, c;
    __host__ __device__ void init(int M, int N, int G_, int c_) { nM = M / BM; nN = N / BM; nwg = nM * nN; G = G_; c = c_; }
    __host__ __device__ bool next(int i, Unit& u) const {
        const long L = (long)i * G + c; if (L >= nwg) return false;
        int wgid = (int)L; { const int q = nwg / NXCD, r = nwg % NXCD, xcd = wgid % NXCD, off = wgid / NXCD; wgid = (xcd < r ? xcd * (q + 1) : r * (q + 1) + (xcd - r) * q) + off; }
        const int nig = WGM * nN, gid = wgid / nig, fm = gid * WGM, gsz = (nM - fm) < WGM ? (nM - fm) : WGM;
        u.pm = fm + ((wgid % nig) % gsz); u.pn = (wgid % nig) / gsz; return true;
    }
    __device__ __forceinline__ void a_ready(const Unit&) const {}
    __device__ __forceinline__ void done(const Unit&) const {}
};


__device__ __forceinline__ unsigned cvt_pk_bf16(float lo, float hi) { unsigned r; asm("v_cvt_pk_bf16_f32 %0, %1, %2" : "=v"(r) : "v"(lo), "v"(hi)); return r; }
__device__ __forceinline__ float silu_f(float z) { return z * __builtin_amdgcn_rcpf(1.0f + __builtin_amdgcn_exp2f(-1.44269504f * z)); }
__device__ __forceinline__ float gelu_f(float x) { const float u = x * (0.7978845608f + 0.0356774081f * x * x); return x * __builtin_amdgcn_rcpf(1.0f + __builtin_amdgcn_exp2f(-2.88539008f * u)); }
__device__ __forceinline__ unsigned short f2bf1(float f) { unsigned u = __builtin_bit_cast(unsigned, f); return (unsigned short)((u + 0x7fffu + ((u >> 16) & 1u)) >> 16); }

struct EpiProj {
    static constexpr bool PERM = false, AFTER_DRAIN = false;
    bf16_t* base; const float* rstd; float* vst; int gm;
    static constexpr size_t OFF_A2 = (size_t)48 << 20, OFF_Q = (size_t)96 << 20, OFF_SZ = (size_t)112 << 20;
    __device__ __forceinline__ void operator()(const f32x4 (&acc)[2][2][4][2], const Unit& u, int wr, int wc, int fr, int fq) const {
        asm volatile("" : "+v"(fr), "+v"(fq));
        const int pn = u.pn; int kind, p;
        if (gm == 0) { if (pn < 24) { kind = 0; p = pn; } else if (pn < 48) { kind = 1; p = pn - 24; } else if (pn < 52) { kind = 3; p = pn - 48; } else { kind = 4; p = pn - 52; } }
        else         { if (pn < 24) { kind = 2; p = pn; } else if (pn < 36) { kind = 5; p = pn - 24; } else if (pn < 40) { kind = 3; p = pn - 36; } else { kind = 4; p = pn - 40; } }
        const int row0 = u.pm * BM + wr * 64 + fr;
        if (kind <= 2) {
            bf16_t* O = base + ((kind == 1) ? OFF_A2 : (size_t)0); const int col0 = 128 * p + 32 * wc + 8 * fq;
#pragma unroll
            for (int ai = 0; ai < 2; ++ai)
#pragma unroll
                for (int m = 0; m < 4; ++m) { const int r = row0 + ai * HALF + m * 16; const float rs = rstd[r];
                    f32x4 o[2];
#pragma unroll
                    for (int n = 0; n < 2; ++n) { const f32x4 a = acc[ai][0][m][n] * rs, b = acc[ai][1][m][n] * rs;
#pragma unroll
                        for (int j = 0; j < 4; ++j) o[n][j] = (kind == 0) ? a[j] * silu_f(b[j]) : (kind == 1) ? a[j] * b[j] : gelu_f(a[j]) * silu_f(b[j]); }
                    u32x4 w; w.x = cvt_pk_bf16(o[0][0], o[0][1]); w.y = cvt_pk_bf16(o[0][2], o[0][3]); w.z = cvt_pk_bf16(o[1][0], o[1][1]); w.w = cvt_pk_bf16(o[1][2], o[1][3]);
                    *(u32x4*)(O + (size_t)r * 3072 + col0) = w; }
        } else {
            bf16_t* O = base + ((kind == 3) ? OFF_Q : (kind == 4) ? OFF_SZ : OFF_A2); const int ldo = (kind == 5) ? 3072 : 1024; const int col0 = 256 * p + 32 * wc + 8 * fq;
#pragma unroll
            for (int ai = 0; ai < 2; ++ai)
#pragma unroll
                for (int m = 0; m < 4; ++m) { const int r = row0 + ai * HALF + m * 16; const float rs = rstd[r]; float s1 = 0.f, s2 = 0.f;
#pragma unroll
                    for (int bj = 0; bj < 2; ++bj) { f32x4 o[2];
#pragma unroll
                        for (int n = 0; n < 2; ++n) { const f32x4 a = acc[ai][bj][m][n] * rs;
#pragma unroll
                            for (int j = 0; j < 4; ++j) { const float v = (kind == 3) ? a[j] * 0.0625f : (kind == 4) ? silu_f(a[j]) : gelu_f(a[j]); o[n][j] = v; s1 += v; s2 += v * v; } }
                        u32x4 w; w.x = cvt_pk_bf16(o[0][0], o[0][1]); w.y = cvt_pk_bf16(o[0][2], o[0][3]); w.z = cvt_pk_bf16(o[1][0], o[1][1]); w.w = cvt_pk_bf16(o[1][2], o[1][3]);
                        *(u32x4*)(O + (size_t)r * ldo + col0 + bj * HALF) = w; }
                    if (kind == 5) { s1 += __shfl_xor(s1, 16); s1 += __shfl_xor(s1, 32); s2 += __shfl_xor(s2, 16); s2 += __shfl_xor(s2, 32);
                        if (fq == 0) { float* q = vst + ((size_t)r * 48 + p * 4 + wc) * 2; q[0] = s1; q[1] = s2; } } }
        }
    }
};
struct EpiOut {
    static constexpr bool PERM = false, AFTER_DRAIN = false;
    bf16_t* YO; float* yss;
    __device__ __forceinline__ void operator()(const f32x4 (&acc)[2][2][4][2], const Unit& u, int wr, int wc, int fr, int fq) const {
        asm volatile("" : "+v"(fr), "+v"(fq));
        const int row0 = u.pm * BM + wr * 64 + fr, col0 = 256 * u.pn + 32 * wc + 8 * fq;
#pragma unroll
        for (int ai = 0; ai < 2; ++ai)
#pragma unroll
            for (int m = 0; m < 4; ++m) { const int r = row0 + ai * HALF + m * 16; float ss = 0.f;
#pragma unroll
                for (int bj = 0; bj < 2; ++bj) { const f32x4 a = acc[ai][bj][m][0], b = acc[ai][bj][m][1];
                    ss += (a[0] * a[0] + a[1] * a[1]) + (a[2] * a[2] + a[3] * a[3]) + (b[0] * b[0] + b[1] * b[1]) + (b[2] * b[2] + b[3] * b[3]);
                    u32x4 w; w.x = cvt_pk_bf16(a[0], a[1]); w.y = cvt_pk_bf16(a[2], a[3]); w.z = cvt_pk_bf16(b[0], b[1]); w.w = cvt_pk_bf16(b[2], b[3]);
                    *(u32x4*)(YO + (size_t)r * 4096 + col0 + bj * HALF) = w; }
                ss += __shfl_xor(ss, 16); ss += __shfl_xor(ss, 32);
                if (fq == 0) yss[(size_t)r * 64 + u.pn * 4 + wc] = ss; }
    }
};
struct EpiKV {
    static constexpr bool PERM = false, AFTER_DRAIN = false;
    bf16_t* KV; const float* rstdm;
    __device__ __forceinline__ void operator()(const f32x4 (&acc)[2][2][4][2], const Unit& u, int wr, int wc, int fr, int fq) const {
        asm volatile("" : "+v"(fr), "+v"(fq));
        const int l = u.pn >> 3, t = u.pn & 7; bf16_t* base = KV + (size_t)l * (2 * 256 * 1024); const int row0 = wr * 64 + fr;
#pragma unroll
        for (int ai = 0; ai < 2; ++ai)
#pragma unroll
            for (int m = 0; m < 4; ++m) { const int r = row0 + ai * HALF + m * 16; const float rs = rstdm[r];
#pragma unroll
                for (int bj = 0; bj < 2; ++bj) { const f32x4 a = acc[ai][bj][m][0] * rs, b = acc[ai][bj][m][1] * rs;
                    if (t < 4) { u32x4 w; w.x = cvt_pk_bf16(a[0], a[1]); w.y = cvt_pk_bf16(a[2], a[3]); w.z = cvt_pk_bf16(b[0], b[1]); w.w = cvt_pk_bf16(b[2], b[3]);
                        *(u32x4*)(base + (size_t)r * 1024 + 256 * t + bj * HALF + 32 * wc + 8 * fq) = w; }
                    else { bf16_t* vt = base + 256 * 1024 + (size_t)(256 * (t - 4) + bj * HALF + 32 * wc + 8 * fq) * 256 + r;
#pragma unroll
                        for (int j = 0; j < 4; ++j) { vt[(size_t)j * 256] = f2bf1(a[j]); vt[(size_t)(4 + j) * 256] = f2bf1(b[j]); } } } }
    }
};
template <class Epi, class Sched, bool ALIGN_EPI = false, bool SP2 = false>
__device__ __forceinline__ void gemm_phase(PG8_LAS unsigned char* lds, const Gemm g, const Sched& S, const Epi& E) {
    int tid_ = threadIdx.x; asm volatile("" : "+v"(tid_));
    const int tid = tid_, wid = __builtin_amdgcn_readfirstlane(tid >> 6), lane = tid & 63, wr = wid >> 2, wc = wid & 3, fr = lane & 15, fq = lane >> 4;
    const int K = g.K, nt = K / BK;
    unsigned voffA[2], voffB[2];
#pragma unroll
    for (int i = 0; i < 2; ++i) { int R, C; stage_rc(tid * 16 + i * 8192, R, C); const int Rb = Epi::PERM ? ((R & ~31) + perm32(R & 31)) : R;
        voffA[i] = (unsigned)(R * K + C) * 2u; voffB[i] = (unsigned)(Rb * K + C) * 2u; }
    const size_t kstep = (size_t)(BK * 2);
    const size_t hstep = (size_t)HALF * K * 2;
    const size_t tstep = 2 * hstep;
    const unsigned ldsw = (unsigned)wid * 1024u;
    const int aoff = lds_byte(wr * 64 + fr, fq * 8), boff = lds_byte(wc * 32 + fr, fq * 8);
#define PG8_SA(b, h) (((b) * 2 + (h)) * HTB)
#define PG8_SB(b, h) ((4 + (b) * 2 + (h)) * HTB)
#define PG8_STAGE(bufoff, gbase, voff) do { _Pragma("unroll") for (int _i = 0; _i < 2; ++_i) \
        __builtin_amdgcn_global_load_lds((const unsigned*)((const char*)(gbase) + (voff)[_i]), (PG8_LAS unsigned*)(lds + (bufoff) + ldsw + _i * 8192), 16, 0, 0); } while (0)
#define PG8_LDA(dst, b, h) do { _Pragma("unroll") for (int m = 0; m < 4; ++m) _Pragma("unroll") for (int k = 0; k < 2; ++k) dst[m][k] = *(const PG8_LAS bf16x8*)(lds + PG8_SA(b, h) + aoff + m * 2048 + k * 1024); } while (0)
#define PG8_LDB(dst, b, h) do { _Pragma("unroll") for (int n = 0; n < 2; ++n) _Pragma("unroll") for (int k = 0; k < 2; ++k) dst[n][k] = *(const PG8_LAS bf16x8*)(lds + PG8_SB(b, h) + boff + n * 2048 + k * 1024); } while (0)
#define PG8_MMA(ai, bj, At, Bt) do { __builtin_amdgcn_s_setprio(1); _Pragma("unroll") for (int m = 0; m < 4; ++m) _Pragma("unroll") for (int n = 0; n < 2; ++n) _Pragma("unroll") for (int k = 0; k < 2; ++k) \
        acc[ai][bj][m][n] = __builtin_amdgcn_mfma_f32_16x16x32_bf16(Bt[n][k], At[m][k], acc[ai][bj][m][n], 0, 0, 0); __builtin_amdgcn_s_setprio(0); } while (0)
#define PG8_WAIT_V(n) asm volatile("s_waitcnt vmcnt(" #n ")" ::: "memory")
#define PG8_WAIT_L(n) asm volatile("s_waitcnt lgkmcnt(" #n ")" ::: "memory")
#define PG8_BAR __builtin_amdgcn_s_barrier()
#define PG8_SCHED __builtin_amdgcn_sched_barrier(0)
    Unit cur, nxt; int ui = 0;
    if (!S.next(0, cur)) return;
    f32x4 acc[2][2][4][2];
#pragma unroll
    for (int a = 0; a < 2; ++a)
#pragma unroll
        for (int b = 0; b < 2; ++b)
#pragma unroll
            for (int m = 0; m < 4; ++m)
#pragma unroll
                for (int n = 0; n < 2; ++n) acc[a][b][m][n] = (f32x4){0.f, 0.f, 0.f, 0.f};
    bf16x8 At[4][2], B0[2][2], B1[2][2];
    const char* cA = (const char*)g.A + (size_t)cur.pm * tstep; const char* cB = (const char*)g.Bt + (size_t)cur.pn * tstep;
    S.a_ready(cur);
    if constexpr (SP2) {
        PG8_STAGE(PG8_SB(0, 0), cB, voffB); PG8_STAGE(PG8_SB(0, 1), cB + hstep, voffB); PG8_STAGE(PG8_SA(0, 0), cA, voffA); PG8_STAGE(PG8_SA(0, 1), cA + hstep, voffA);
        if (wr == 1) PG8_BAR;
        PG8_WAIT_V(2); PG8_BAR;
        PG8_STAGE(PG8_SB(1, 0), cB + kstep, voffB); PG8_STAGE(PG8_SA(1, 0), cA + kstep, voffA); PG8_STAGE(PG8_SB(1, 1), cB + hstep + kstep, voffB);
        PG8_WAIT_V(6); PG8_BAR;
    } else {
        PG8_STAGE(PG8_SB(0, 0), cB, voffB); PG8_STAGE(PG8_SA(0, 0), cA, voffA); PG8_STAGE(PG8_SB(0, 1), cB + hstep, voffB); PG8_STAGE(PG8_SA(0, 1), cA + hstep, voffA);
        if (wr == 1) PG8_BAR;
        PG8_WAIT_V(4); PG8_BAR;
        PG8_STAGE(PG8_SB(1, 0), cB + kstep, voffB); PG8_STAGE(PG8_SA(1, 0), cA + kstep, voffA); PG8_STAGE(PG8_SB(1, 1), cB + hstep + kstep, voffB);
        PG8_WAIT_V(6); PG8_BAR;
    }
    for (;;) {
        const bool has_next = S.next(ui + 1, nxt);
        const char* nA = has_next ? (const char*)g.A + (size_t)nxt.pm * tstep : cA; const char* nB = has_next ? (const char*)g.Bt + (size_t)nxt.pn * tstep : cB;
        for (int t = 0; t < nt; t += 2) {
            const bool last = (t == nt - 2);
            const char* a1 = cA + (size_t)(t + 1) * kstep;
            const char* a2 = last ? nA : cA + (size_t)(t + 2) * kstep; const char* b2 = last ? nB : cB + (size_t)(t + 2) * kstep;
            const char* a3 = a2 + kstep; const char* b3 = b2 + kstep;
            if (last && has_next) S.a_ready(nxt);
            if constexpr (SP2) {
            PG8_LDB(B0, 0, 0); PG8_LDB(B1, 0, 1); PG8_SCHED; PG8_LDA(At, 0, 0); PG8_STAGE(PG8_SA(1, 1), a1 + hstep, voffA);
            PG8_WAIT_V(8); PG8_WAIT_L(0); PG8_BAR; PG8_MMA(0, 0, At, B0); PG8_MMA(0, 1, At, B1); PG8_BAR; PG8_SCHED;
            PG8_LDA(At, 0, 1); PG8_STAGE(PG8_SB(0, 0), b2, voffB); PG8_STAGE(PG8_SB(0, 1), b2 + hstep, voffB); PG8_STAGE(PG8_SA(0, 0), a2, voffA);
            PG8_WAIT_V(8); PG8_WAIT_L(0); PG8_BAR; PG8_MMA(1, 0, At, B0); PG8_MMA(1, 1, At, B1); PG8_BAR; PG8_SCHED;
            PG8_LDB(B0, 1, 0); PG8_LDB(B1, 1, 1); PG8_SCHED; PG8_LDA(At, 1, 0); PG8_STAGE(PG8_SA(0, 1), a2 + hstep, voffA);
            PG8_WAIT_V(8); PG8_WAIT_L(0); PG8_BAR; PG8_MMA(0, 0, At, B0); PG8_MMA(0, 1, At, B1); PG8_BAR; PG8_SCHED;
            PG8_LDA(At, 1, 1); PG8_STAGE(PG8_SB(1, 0), b3, voffB); PG8_STAGE(PG8_SB(1, 1), b3 + hstep, voffB); PG8_STAGE(PG8_SA(1, 0), a3, voffA);
            PG8_WAIT_V(8); PG8_WAIT_L(0); PG8_BAR; PG8_MMA(1, 0, At, B0); PG8_MMA(1, 1, At, B1); PG8_BAR; PG8_SCHED;
            } else {
            PG8_LDB(B0, 0, 0); PG8_SCHED; PG8_LDA(At, 0, 0); PG8_STAGE(PG8_SA(1, 1), a1 + hstep, voffA);
            PG8_WAIT_L(8); PG8_BAR; PG8_WAIT_L(0); PG8_MMA(0, 0, At, B0); PG8_BAR; PG8_SCHED;
            PG8_LDB(B1, 0, 1); PG8_STAGE(PG8_SB(0, 0), b2, voffB);
            PG8_BAR; PG8_WAIT_L(0); PG8_MMA(0, 1, At, B1); PG8_BAR;
            PG8_LDA(At, 0, 1); PG8_STAGE(PG8_SA(0, 0), a2, voffA);
            PG8_BAR; PG8_WAIT_L(0); PG8_MMA(1, 0, At, B0); PG8_BAR; PG8_SCHED;
            PG8_STAGE(PG8_SB(0, 1), b2 + hstep, voffB);
            PG8_WAIT_V(6); PG8_BAR; PG8_MMA(1, 1, At, B1); PG8_BAR;
            PG8_LDB(B0, 1, 0); PG8_SCHED; PG8_LDA(At, 1, 0); PG8_STAGE(PG8_SA(0, 1), a2 + hstep, voffA);
            PG8_WAIT_L(8); PG8_BAR; PG8_WAIT_L(0); PG8_MMA(0, 0, At, B0); PG8_BAR; PG8_SCHED;
            PG8_LDB(B1, 1, 1); PG8_STAGE(PG8_SB(1, 0), b3, voffB);
            PG8_BAR; PG8_WAIT_L(0); PG8_MMA(0, 1, At, B1); PG8_BAR;
            PG8_LDA(At, 1, 1); PG8_STAGE(PG8_SA(1, 0), a3, voffA);
            PG8_BAR; PG8_WAIT_L(0); PG8_MMA(1, 0, At, B0); PG8_BAR; PG8_SCHED;
            PG8_STAGE(PG8_SB(1, 1), b3 + hstep, voffB);
            PG8_WAIT_V(6); PG8_BAR; PG8_MMA(1, 1, At, B1); PG8_BAR;
            }
        }
        if constexpr (ALIGN_EPI) { if (wr == 0) PG8_BAR; }
        if constexpr (!Epi::AFTER_DRAIN) { E(acc, cur, wr, wc, fr, fq); S.done(cur); }
        if (!has_next) break;
#pragma unroll
        for (int a = 0; a < 2; ++a)
#pragma unroll
            for (int b = 0; b < 2; ++b)
#pragma unroll
                for (int m = 0; m < 4; ++m)
#pragma unroll
                    for (int n = 0; n < 2; ++n) acc[a][b][m][n] = (f32x4){0.f, 0.f, 0.f, 0.f};
        cur = nxt; cA = nA; cB = nB; ++ui;
        if constexpr (ALIGN_EPI) { if (wr == 1) PG8_BAR; }
    }
    PG8_WAIT_V(0);
    if constexpr (!ALIGN_EPI) { if (wr == 0) PG8_BAR; }
    PG8_BAR;
    if constexpr (Epi::AFTER_DRAIN) { E.fused(acc, cur, wr, wc, fr, fq, lds, wid, lane); S.done(cur); }
#undef PG8_SA
#undef PG8_SB
#undef PG8_STAGE
#undef PG8_LDA
#undef PG8_LDB
#undef PG8_MMA
#undef PG8_WAIT_V
#undef PG8_WAIT_L
#undef PG8_BAR
#undef PG8_SCHED
}
}

constexpr int SEQ = 16384, DM = 4096, DEPTH = 4, NMEM = 256, BRW = 3072, MEMW = 1024, NHEAD = 4, HDIM = 256;
constexpr int NIN_CONV = 14336, NIN_GMLP = 11264, NKV = 2048;
constexpr float RMS_EPS = 1e-6f, LNORM_EPS = 1e-5f;
constexpr int NWAVES = 8;
#ifndef MK_ONE_LAUNCH
#define MK_ONE_LAUNCH 1
#endif
constexpr int NPHASE = 2 + 4 * DEPTH;

constexpr size_t MiB = 1u << 20;
constexpr size_t WS_CTL = 0, CTL_ZERO_BYTES = 1 * MiB;
constexpr size_t WS_WIN = 2 * MiB;
constexpr size_t WIN_OFF0 = 0, WIN_OFF1 = 112 * MiB, WIN_OFF2 = 200 * MiB, WIN_OFF3 = 312 * MiB;
constexpr size_t WS_WOUT = WS_WIN + 400 * MiB;
constexpr size_t WS_WKV = WS_WOUT + 128 * MiB;
constexpr size_t WS_MEMB = WS_WKV + 64 * MiB;
constexpr size_t WS_KV = WS_MEMB + 2 * MiB;
constexpr size_t WS_XB = WS_KV + 4 * MiB;
constexpr size_t WS_A1 = WS_XB + 128 * MiB;
constexpr size_t WS_A2 = WS_A1 + 96 * MiB;
constexpr size_t WS_Q = WS_A2 + 96 * MiB;
constexpr size_t WS_SZ = WS_Q + 32 * MiB;
constexpr size_t WS_Y = WS_SZ + 32 * MiB;
constexpr size_t WS_YO = WS_Y + 128 * MiB;
constexpr size_t WS_RSTD = WS_YO + 128 * MiB;
constexpr size_t WS_RSTDM = WS_RSTD + 1 * MiB;
constexpr size_t WS_VST = WS_RSTDM + 1 * MiB;
constexpr size_t WS_YSS = WS_VST + 6 * MiB;
constexpr size_t WS_END = WS_YSS + 4 * MiB;
static_assert(WS_A2 - WS_A1 == 2 * pg8::EpiProj::OFF_A2 && WS_Q - WS_A1 == 2 * pg8::EpiProj::OFF_Q && WS_SZ - WS_A1 == 2 * pg8::EpiProj::OFF_SZ, "EpiProj output offsets");
constexpr int CW_BAR = 4096;

constexpr int RING_BYTES = 131072;
constexpr int LDS_BYTES = 147456;
constexpr int MISC_OFF = LDS_BYTES - 128;

#define GAS __attribute__((address_space(1)))
#define LAS __attribute__((address_space(3)))
typedef unsigned short bf16;
typedef unsigned v4u __attribute__((ext_vector_type(4)));
typedef unsigned v2u __attribute__((ext_vector_type(2)));
typedef float f32x4 __attribute__((ext_vector_type(4)));
typedef short bf16x8 __attribute__((ext_vector_type(8)));
#define LDS_WAIT() asm volatile("s_waitcnt lgkmcnt(0)" ::: "memory")
__device__ __forceinline__ unsigned f2bf(float f) { unsigned u = __builtin_bit_cast(unsigned, f); return (u + 0x7fffu + ((u >> 16) & 1u)) >> 16; }
__device__ __forceinline__ unsigned pk2(float lo, float hi) { return pg8::cvt_pk_bf16(lo, hi); }
__device__ __forceinline__ float bflo(unsigned w) { return __builtin_bit_cast(float, w << 16); }
__device__ __forceinline__ float bfhi(unsigned w) { return __builtin_bit_cast(float, w & 0xffff0000u); }
__device__ __forceinline__ float wave_sum(float v) {
#pragma unroll
    for (int o = 1; o < 64; o <<= 1) v += __shfl_xor(v, o);
    return v;
}

#define XB_TMO      128
#define XB_XCNT(j)  (256  + 64 * (j))
#define XB_XSUB(j)  (1280 + 64 * (j))
#define XB_XGEN(j)  (2304 + 64 * (j))
#define XB_TOP      3328
#define XB_TOPGEN   3392
#define XCD_BAR_WORDS 3456
#define XB_SPIN_CAP (1u << 18)

__device__ __forceinline__ unsigned xb_ld(unsigned* p)              { return __hip_atomic_load(p, __ATOMIC_RELAXED, __HIP_MEMORY_SCOPE_AGENT); }
__device__ __forceinline__ unsigned xb_add(unsigned* p, unsigned v) { return __hip_atomic_fetch_add(p, v, __ATOMIC_RELAXED, __HIP_MEMORY_SCOPE_AGENT); }
__device__ __forceinline__ unsigned xb_xcc_id() { return (unsigned)__builtin_amdgcn_s_getreg((3 << 11) | 20) & 0xFu; }
#define XB_SPIN(cond, bar) do { unsigned _sp = 0; while (cond) { __builtin_amdgcn_s_sleep(1); \
    if ((++_sp & 255u) == 0u) { if (xb_ld(&(bar)[XB_TMO])) break; if (_sp > XB_SPIN_CAP) { atomicAdd(&(bar)[XB_TMO], 1u); break; } } } } while (0)

struct XcdBarrier {
    unsigned* bar; unsigned x;
    volatile LAS unsigned* st;
};
__device__ __forceinline__ XcdBarrier xcd_barrier_post(unsigned* bar, volatile LAS unsigned* st) {
    XcdBarrier b; b.bar = bar; b.x = xb_xcc_id(); b.st = st;
    if (threadIdx.x == 0) (void)xb_add(&bar[XB_XCNT(b.x)], 1u);
    return b;
}
__device__ __forceinline__ void xcd_barrier_complete(unsigned* bar, unsigned x, unsigned& nloc, unsigned& nx) {
    const unsigned G = gridDim.x * gridDim.y * gridDim.z;
    unsigned sum, cnt, mine, sp = 0u;
    for (;;) {
        sum = 0u; cnt = 0u; mine = 0u;
#pragma unroll
        for (unsigned j = 0; j < 16; ++j) { const unsigned c = xb_ld(&bar[XB_XCNT(j)]); sum += c; cnt += (c > 0u) ? 1u : 0u; mine = (j == x) ? c : mine; }
        if (sum == G) break;
        __builtin_amdgcn_s_sleep(1);
        if ((++sp & 255u) == 0u) { if (xb_ld(&bar[XB_TMO])) break; if (sp > XB_SPIN_CAP) { atomicAdd(&bar[XB_TMO], 1u); break; } }
    }
    nloc = mine > 0u ? mine : 1u; nx = cnt > 0u ? cnt : 1u;
}
__device__ __forceinline__ void xcd_barrier(const XcdBarrier& b) {
    asm volatile("s_waitcnt vmcnt(0)" ::: "memory");
    __syncthreads();
    if (threadIdx.x == 0) {
        unsigned* bar = b.bar;
        __builtin_amdgcn_s_waitcnt(0);
        unsigned nloc = b.st[0], nx = b.st[1];
        if (nloc == 0u) { xcd_barrier_complete(bar, b.x, nloc, nx); b.st[0] = nloc; b.st[1] = nx; }
        const unsigned old = xb_add(&bar[XB_XSUB(b.x)], 1u);
        const unsigned gen = old / nloc;
        if (old + 1u == (gen + 1u) * nloc) {
            __builtin_amdgcn_fence(__ATOMIC_RELEASE, "agent");
            asm volatile("s_waitcnt vmcnt(0)" ::: "memory");
            const unsigned og = xb_add(&bar[XB_TOP], 1u);
            const unsigned tg = og / nx;
            if (og + 1u == (tg + 1u) * nx) xb_add(&bar[XB_TOPGEN], 1u);
            else XB_SPIN(xb_ld(&bar[XB_TOPGEN]) == tg, bar);
            __builtin_amdgcn_fence(__ATOMIC_ACQUIRE, "agent");
            xb_add(&bar[XB_XGEN(b.x)], 1u);
            asm volatile("s_waitcnt vmcnt(0)" ::: "memory");
        } else {
            XB_SPIN(xb_ld(&bar[XB_XGEN(b.x)]) == gen, bar);
            __builtin_amdgcn_fence(__ATOMIC_ACQUIRE, "agent");
            asm volatile("s_waitcnt vmcnt(0)" ::: "memory");
        }
    }
    __syncthreads();
}

__device__ __forceinline__ int src32_conv(int gi) { const int pn = gi >> 3, bj = (gi >> 2) & 1, wc = gi & 3;
    if (pn < 24) return (bj ? 10240 : 0) + 128 * pn + 32 * wc;
    if (pn < 48) return (bj ? 6144 : 3072) + 128 * (pn - 24) + 32 * wc;
    if (pn < 52) return 9216 + 256 * (pn - 48) + 128 * bj + 32 * wc;
    return 13312 + 256 * (pn - 52) + 128 * bj + 32 * wc; }
__device__ __forceinline__ int src32_gmlp(int gi) { const int pn = gi >> 3, bj = (gi >> 2) & 1, wc = gi & 3;
    if (pn < 24) return (bj ? 7168 : 0) + 128 * pn + 32 * wc;
    if (pn < 36) return 3072 + 256 * (pn - 24) + 128 * bj + 32 * wc;
    if (pn < 40) return 6144 + 256 * (pn - 36) + 128 * bj + 32 * wc;
    return 10240 + 256 * (pn - 40) + 128 * bj + 32 * wc; }
__device__ __forceinline__ void cvt_item(const float* W, int N, int src32, const float* gk, bf16* WT, int slot0, int k0, LAS float* scr, int lane) {
#pragma unroll 8
    for (int i = 0; i < 32; ++i) { const int kk = 2 * i + (lane >> 5); scr[kk * 33 + (lane & 31)] = W[(size_t)(k0 + kk) * N + src32 + (lane & 31)]; }
    const int c = lane & 7;
    f32x4 g0 = (f32x4){1.f, 1.f, 1.f, 1.f}, g1 = g0;
    if (gk) { g0 = *(const f32x4*)(gk + k0 + 8 * c); g1 = *(const f32x4*)(gk + k0 + 8 * c + 4); }
    LDS_WAIT(); asm volatile("" ::: "memory");
#pragma unroll
    for (int j = 0; j < 4; ++j) { const int n = (lane >> 3) + 8 * j; const LAS float* s = scr + (8 * c) * 33 + pg8::perm32(n);
        v4u o; o.x = pk2(s[0 * 33] * g0[0], s[1 * 33] * g0[1]); o.y = pk2(s[2 * 33] * g0[2], s[3 * 33] * g0[3]); o.z = pk2(s[4 * 33] * g1[0], s[5 * 33] * g1[1]); o.w = pk2(s[6 * 33] * g1[2], s[7 * 33] * g1[3]);
        *(v4u*)(WT + (size_t)(slot0 + n) * DM + k0 + 8 * c) = o; }
    LDS_WAIT(); asm volatile("" ::: "memory");
}
__device__ __forceinline__ void row_to_bf16(const float* xr, bf16* orow, float* rstd_out, int lane) {
    float ss = 0.f;
#pragma unroll
    for (int i = 0; i < 8; ++i) { const int col = 512 * i + 8 * lane; const f32x4 a = *(const f32x4*)(xr + col), b = *(const f32x4*)(xr + col + 4);
        ss += (a[0] * a[0] + a[1] * a[1]) + (a[2] * a[2] + a[3] * a[3]) + (b[0] * b[0] + b[1] * b[1]) + (b[2] * b[2] + b[3] * b[3]);
        v4u o; o.x = pk2(a[0], a[1]); o.y = pk2(a[2], a[3]); o.z = pk2(b[0], b[1]); o.w = pk2(b[2], b[3]); *(v4u*)(orow + col) = o; }
    ss = wave_sum(ss);
    if (lane == 0) *rstd_out = 1.0f / sqrtf(ss * (1.0f / DM) + RMS_EPS);
}

struct Args { const float* in[14]; float* out; unsigned char* ws; int ph_lo, ph_hi; };

__device__ __forceinline__ void p0_convert(const Args& a, unsigned char* ws, LAS unsigned char* lds, int gw, int NGW, int wave, int lane) {
    LAS float* scr = (LAS float*)(lds + wave * 16384);
    const float* x = a.in[0]; const float* mem = a.in[1]; const float* pre_g = a.in[2]; const float* mem_g = a.in[4];
    const float* w_kv = a.in[5]; const float* w_out = a.in[6]; const float* conv_w_in = a.in[7]; const float* gmlp_w_in = a.in[9];
    constexpr int I_KV = 64 * (NKV / 32), I_OUT = 64 * (DM / 32), I_CONV = 64 * (NIN_CONV / 32), I_GMLP = 64 * (NIN_GMLP / 32);
    constexpr int NITEMS = 4 * I_KV + 4 * I_OUT + 2 * I_CONV + 2 * I_GMLP;
    for (int it = gw; it < NITEMS; it += NGW) {
        int r = it; const float* W; const float* gk; bf16* WT; int N, ng, type;
        if (r < 4 * I_KV) { const int l = r / I_KV; r -= l * I_KV; W = w_kv + (size_t)l * DM * NKV; N = NKV; ng = NKV / 32; type = 2; gk = mem_g + l * DM; WT = (bf16*)(ws + WS_WKV) + (size_t)l * NKV * DM; }
        else { r -= 4 * I_KV;
            if (r < 4 * I_OUT) { const int l = r / I_OUT; r -= l * I_OUT; W = w_out + (size_t)l * DM * DM; N = DM; ng = DM / 32; type = 2; gk = nullptr; WT = (bf16*)(ws + WS_WOUT) + (size_t)l * DM * DM; }
            else { r -= 4 * I_OUT;
                if (r < 2 * I_CONV) { const int j = r / I_CONV; r -= j * I_CONV; W = conv_w_in + (size_t)j * DM * NIN_CONV; N = NIN_CONV; ng = NIN_CONV / 32; type = 0; gk = pre_g + (2 * j) * DM; WT = (bf16*)(ws + WS_WIN + (j ? WIN_OFF2 : WIN_OFF0)); }
                else { r -= 2 * I_CONV; const int j = r / I_GMLP; r -= j * I_GMLP; W = gmlp_w_in + (size_t)j * DM * NIN_GMLP; N = NIN_GMLP; ng = NIN_GMLP / 32; type = 1; gk = pre_g + (2 * j + 1) * DM; WT = (bf16*)(ws + WS_WIN + (j ? WIN_OFF3 : WIN_OFF1)); } } }
        const int kb = r / ng, gi = r - kb * ng;
        const int s32 = (type == 0) ? src32_conv(gi) : (type == 1) ? src32_gmlp(gi) : 32 * gi;
        cvt_item(W, N, s32, gk, WT, 32 * gi, 64 * kb, scr, lane);
    }
    for (int m = gw; m < SEQ; m += NGW) row_to_bf16(x + (size_t)m * DM, (bf16*)(ws + WS_XB) + (size_t)m * DM, (float*)(ws + WS_RSTD) + m, lane);
    for (int m = gw; m < NMEM; m += NGW) row_to_bf16(mem + (size_t)m * DM, (bf16*)(ws + WS_MEMB) + (size_t)m * DM, (float*)(ws + WS_RSTDM) + m, lane);
}

__device__ __forceinline__ void attn_task(const bf16* Q, const bf16* SZ, const bf16* Kl, const bf16* VTl, bf16* Y, int t0, int h, int lane) {
    const int fr = lane & 15, fq = lane >> 4;
    bf16x8 qf[8];
    const bf16* qp = Q + (size_t)(t0 + fr) * MEMW + HDIM * h + 8 * fq;
#pragma unroll
    for (int ks = 0; ks < 8; ++ks) qf[ks] = *(const bf16x8*)(qp + 32 * ks);
    f32x4 s[16];
    const bf16* kp = Kl + (size_t)fr * MEMW + HDIM * h + 8 * fq;
#pragma unroll
    for (int mb = 0; mb < 16; ++mb) { f32x4 acc = (f32x4){0.f, 0.f, 0.f, 0.f};
#pragma unroll
        for (int ks = 0; ks < 8; ++ks) { const bf16x8 kf = *(const bf16x8*)(kp + (size_t)mb * 16 * MEMW + 32 * ks); acc = __builtin_amdgcn_mfma_f32_16x16x32_bf16(kf, qf[ks], acc, 0, 0, 0); }
        s[mb] = acc; }
    float mx = s[0][0];
#pragma unroll
    for (int mb = 0; mb < 16; ++mb)
#pragma unroll
        for (int j = 0; j < 4; ++j) mx = fmaxf(mx, s[mb][j]);
    mx = fmaxf(mx, __shfl_xor(mx, 16)); mx = fmaxf(mx, __shfl_xor(mx, 32));
    float sum = 0.f; const float mxl = mx * 1.44269504f;
#pragma unroll
    for (int mb = 0; mb < 16; ++mb)
#pragma unroll
        for (int j = 0; j < 4; ++j) { const float p = __builtin_amdgcn_exp2f(s[mb][j] * 1.44269504f - mxl); s[mb][j] = p; sum += p; }
    sum += __shfl_xor(sum, 16); sum += __shfl_xor(sum, 32);
    const float inv = 1.0f / sum;
    bf16x8 pf[8];
#pragma unroll
    for (int ks2 = 0; ks2 < 8; ++ks2) { v4u w; w.x = pk2(s[2 * ks2][0], s[2 * ks2][1]); w.y = pk2(s[2 * ks2][2], s[2 * ks2][3]); w.z = pk2(s[2 * ks2 + 1][0], s[2 * ks2 + 1][1]); w.w = pk2(s[2 * ks2 + 1][2], s[2 * ks2 + 1][3]);
        pf[ks2] = __builtin_bit_cast(bf16x8, w); }
    const bf16* vp = VTl + (size_t)(HDIM * h + 8 * (fr >> 2) + (fr & 3)) * NMEM + 4 * fq;
    const bf16* szp = SZ + (size_t)(t0 + fr) * MEMW + HDIM * h + 8 * fq;
    bf16* yp = Y + (size_t)(t0 + fr) * DM + BRW + HDIM * h + 8 * fq;
#pragma unroll
    for (int db2 = 0; db2 < 8; ++db2) { f32x4 o0 = (f32x4){0.f, 0.f, 0.f, 0.f}, o1 = o0;
#pragma unroll
        for (int ks2 = 0; ks2 < 8; ++ks2) { const bf16* v0 = vp + (size_t)(32 * db2) * NMEM + 32 * ks2; const bf16* v1 = v0 + 4 * NMEM;
            v4u a0, a1; const v2u x0 = *(const v2u*)v0, x1 = *(const v2u*)(v0 + 16), y0 = *(const v2u*)v1, y1 = *(const v2u*)(v1 + 16);
            a0.x = x0.x; a0.y = x0.y; a0.z = x1.x; a0.w = x1.y; a1.x = y0.x; a1.y = y0.y; a1.z = y1.x; a1.w = y1.y;
            o0 = __builtin_amdgcn_mfma_f32_16x16x32_bf16(__builtin_bit_cast(bf16x8, a0), pf[ks2], o0, 0, 0, 0);
            o1 = __builtin_amdgcn_mfma_f32_16x16x32_bf16(__builtin_bit_cast(bf16x8, a1), pf[ks2], o1, 0, 0, 0); }
        const v4u z = *(const v4u*)(szp + 32 * db2);
        v4u w; w.x = pk2(o0[0] * inv * bflo(z.x), o0[1] * inv * bfhi(z.x)); w.y = pk2(o0[2] * inv * bflo(z.y), o0[3] * inv * bfhi(z.y));
        w.z = pk2(o1[0] * inv * bflo(z.z), o1[1] * inv * bfhi(z.z)); w.w = pk2(o1[2] * inv * bflo(z.w), o1[3] * inv * bfhi(z.w));
        *(v4u*)(yp + 32 * db2) = w; }
}

__device__ __forceinline__ void conv_task(const bf16* GZ, const bf16* CH, const float* cw  , bf16* Y, int task, int lane) {
    const int rsx = task / 6, cs = task - rsx * 6; const int t0 = 32 * rsx, c = 512 * cs + 8 * lane;
    float w0[8], w1[8], w2[8], p2[8], p1[8];
    { const f32x4 a = *(const f32x4*)(cw + c), b = *(const f32x4*)(cw + c + 4), d = *(const f32x4*)(cw + BRW + c), e = *(const f32x4*)(cw + BRW + c + 4), f = *(const f32x4*)(cw + 2 * BRW + c), g = *(const f32x4*)(cw + 2 * BRW + c + 4);
#pragma unroll
      for (int i = 0; i < 4; ++i) { w0[i] = a[i]; w0[4 + i] = b[i]; w1[i] = d[i]; w1[4 + i] = e[i]; w2[i] = f[i]; w2[4 + i] = g[i]; } }
    if (t0 >= 2) { const v4u u2 = *(const v4u*)(CH + (size_t)(t0 - 2) * BRW + c), u1 = *(const v4u*)(CH + (size_t)(t0 - 1) * BRW + c);
        p2[0] = bflo(u2.x); p2[1] = bfhi(u2.x); p2[2] = bflo(u2.y); p2[3] = bfhi(u2.y); p2[4] = bflo(u2.z); p2[5] = bfhi(u2.z); p2[6] = bflo(u2.w); p2[7] = bfhi(u2.w);
        p1[0] = bflo(u1.x); p1[1] = bfhi(u1.x); p1[2] = bflo(u1.y); p1[3] = bfhi(u1.y); p1[4] = bflo(u1.z); p1[5] = bfhi(u1.z); p1[6] = bflo(u1.w); p1[7] = bfhi(u1.w); }
    else {
#pragma unroll
        for (int i = 0; i < 8; ++i) { p2[i] = 0.f; p1[i] = 0.f; } }
#pragma unroll 4
    for (int t = t0; t < t0 + 32; ++t) {
        const v4u uc = *(const v4u*)(CH + (size_t)t * BRW + c), ug = *(const v4u*)(GZ + (size_t)t * BRW + c);
        float cu[8], gz[8], o[8];
        cu[0] = bflo(uc.x); cu[1] = bfhi(uc.x); cu[2] = bflo(uc.y); cu[3] = bfhi(uc.y); cu[4] = bflo(uc.z); cu[5] = bfhi(uc.z); cu[6] = bflo(uc.w); cu[7] = bfhi(uc.w);
        gz[0] = bflo(ug.x); gz[1] = bfhi(ug.x); gz[2] = bflo(ug.y); gz[3] = bfhi(ug.y); gz[4] = bflo(ug.z); gz[5] = bfhi(ug.z); gz[6] = bflo(ug.w); gz[7] = bfhi(ug.w);
#pragma unroll
        for (int i = 0; i < 8; ++i) { o[i] = gz[i] * (w0[i] * p2[i] + w1[i] * p1[i] + w2[i] * cu[i]); p2[i] = p1[i]; p1[i] = cu[i]; }
        v4u w; w.x = pk2(o[0], o[1]); w.y = pk2(o[2], o[3]); w.z = pk2(o[4], o[5]); w.w = pk2(o[6], o[7]);
        *(v4u*)(Y + (size_t)t * DM + c) = w; }
}

constexpr int SP_LD = 136;
constexpr int SP_WL = 0, SP_VTL = 128 * SP_LD * 2, SP_MU = SP_VTL + 384 * SP_LD * 2, SP_RS = SP_MU + 512, SP_END = SP_RS + 512;
static_assert(SP_END <= MISC_OFF, "spatial LDS map");
__device__ __forceinline__ void spatial_unit(const bf16* VG, const bf16* UZ, const float* vst, const float* Wg, const float* bsg, const float* lng, const float* lnb, bf16* Y, int nb, int g, LAS unsigned char* lds, int tid) {
    LAS bf16* WL = (LAS bf16*)(lds + SP_WL); LAS bf16* VTL = (LAS bf16*)(lds + SP_VTL); LAS float* MU = (LAS float*)(lds + SP_MU); LAS float* RS = (LAS float*)(lds + SP_RS);
    const int lane = tid & 63, wave = __builtin_amdgcn_readfirstlane(tid >> 6), fr = lane & 15, fq = lane >> 4;
    if (tid < 128) { const float* q = vst + (size_t)(128 * nb + tid) * 96; float s1 = 0.f, s2 = 0.f;
#pragma unroll 8
        for (int k = 0; k < 48; ++k) { s1 += q[2 * k]; s2 += q[2 * k + 1]; }
        const float mu = s1 * (1.0f / BRW), var = s2 * (1.0f / BRW) - mu * mu; MU[tid] = mu; RS[tid] = 1.0f / sqrtf(var + LNORM_EPS); }
    { const int t = tid >> 2, s0 = (tid & 3) * 32;
#pragma unroll
        for (int q = 0; q < 4; ++q) { const int sb = s0 + 8 * q; const f32x4 a = *(const f32x4*)(Wg + t * 128 + sb), b = *(const f32x4*)(Wg + t * 128 + sb + 4);
            float v[8] = {a[0], a[1], a[2], a[3], b[0], b[1], b[2], b[3]};
#pragma unroll
            for (int e = 0; e < 8; ++e) v[e] = (sb + e <= t) ? v[e] : 0.f;
            v4u o; o.x = pk2(v[0], v[1]); o.y = pk2(v[2], v[3]); o.z = pk2(v[4], v[5]); o.w = pk2(v[6], v[7]);
            *(LAS v4u*)(WL + t * SP_LD + sb) = o; } }
    __syncthreads();
    { const int s = (lane & 31) + 32 * (wave & 3); const float mu = MU[s], rs = RS[s];
#pragma unroll 4
        for (int it = 0; it < 12; ++it) { const int c = 8 * ((lane >> 5) + 2 * (wave >> 2) + 4 * it);
            const v4u u = *(const v4u*)(VG + (size_t)(128 * nb + s) * BRW + 384 * g + c);
            const f32x4 g0 = *(const f32x4*)(lng + 384 * g + c), g1 = *(const f32x4*)(lng + 384 * g + c + 4), b0 = *(const f32x4*)(lnb + 384 * g + c), b1 = *(const f32x4*)(lnb + 384 * g + c + 4);
            float v[8] = {bflo(u.x), bfhi(u.x), bflo(u.y), bfhi(u.y), bflo(u.z), bfhi(u.z), bflo(u.w), bfhi(u.w)};
#pragma unroll
            for (int e = 0; e < 8; ++e) { const float gg = e < 4 ? g0[e & 3] : g1[e & 3], bb = e < 4 ? b0[e & 3] : b1[e & 3]; VTL[(c + e) * SP_LD + s] = (bf16)f2bf((v[e] - mu) * rs * gg + bb); } } }
    __syncthreads();
    const int th = wave >> 2, d0w = 96 * (wave & 3);
    f32x4 acc[4][3][2];
#pragma unroll
    for (int i = 0; i < 4; ++i)
#pragma unroll
        for (int dp = 0; dp < 3; ++dp) { acc[i][dp][0] = (f32x4){0.f, 0.f, 0.f, 0.f}; acc[i][dp][1] = (f32x4){0.f, 0.f, 0.f, 0.f}; }
#pragma unroll
    for (int i = 0; i < 4; ++i) { const int tb = th ? ((i == 0) ? 1 : (i == 1) ? 2 : (i == 2) ? 5 : 6) : ((i == 0) ? 0 : (i == 1) ? 3 : (i == 2) ? 4 : 7); const int kmax = tb >> 1;
#pragma unroll
        for (int ks = 0; ks < 4; ++ks) if (ks <= kmax) {
            const bf16x8 bw = *(const LAS bf16x8*)(WL + (16 * tb + fr) * SP_LD + 32 * ks + 8 * fq);
#pragma unroll
            for (int dp = 0; dp < 3; ++dp)
#pragma unroll
                for (int e = 0; e < 2; ++e) { const bf16x8 av = *(const LAS bf16x8*)(VTL + (d0w + 32 * dp + 8 * (fr >> 2) + 4 * e + (fr & 3)) * SP_LD + 32 * ks + 8 * fq);
                    acc[i][dp][e] = __builtin_amdgcn_mfma_f32_16x16x32_bf16(av, bw, acc[i][dp][e], 0, 0, 0); } } }
#pragma unroll
    for (int i = 0; i < 4; ++i) { const int tb = th ? ((i == 0) ? 1 : (i == 1) ? 2 : (i == 2) ? 5 : 6) : ((i == 0) ? 0 : (i == 1) ? 3 : (i == 2) ? 4 : 7);
        const int tl = 16 * tb + fr; const float bs = bsg[tl]; const size_t row = (size_t)(128 * nb + tl);
#pragma unroll
        for (int dp = 0; dp < 3; ++dp) { const int d = 384 * g + d0w + 32 * dp + 8 * fq; const v4u u = *(const v4u*)(UZ + row * BRW + d);
            const f32x4 f0 = acc[i][dp][0] + bs, f1 = acc[i][dp][1] + bs;
            v4u w; w.x = pk2(bflo(u.x) * f0[0], bfhi(u.x) * f0[1]); w.y = pk2(bflo(u.y) * f0[2], bfhi(u.y) * f0[3]); w.z = pk2(bflo(u.z) * f1[0], bfhi(u.z) * f1[1]); w.w = pk2(bflo(u.w) * f1[2], bfhi(u.w) * f1[3]);
            *(v4u*)(Y + row * DM + d) = w; } }
    __syncthreads();
}

__device__ __forceinline__ void p4_rows(const bf16* YO, const float* yss, const float* gpost, bf16* XB, float* rstd, float* out, bool last, int gw, int NGW, int lane) {
    for (int m = gw; m < SEQ; m += NGW) {
        const float tot = wave_sum(yss[(size_t)m * 64 + lane]); const float rsy = 1.0f / sqrtf(tot * (1.0f / DM) + RMS_EPS);
        float ss = 0.f;
#pragma unroll 2
        for (int i = 0; i < 8; ++i) { const int col = 512 * i + 8 * lane;
            const v4u yo = *(const v4u*)(YO + (size_t)m * DM + col), xb = *(const v4u*)(XB + (size_t)m * DM + col); const f32x4 g0 = *(const f32x4*)(gpost + col), g1 = *(const f32x4*)(gpost + col + 4);
            float xn[8];
            xn[0] = bflo(xb.x) + bflo(yo.x) * rsy * g0[0]; xn[1] = bfhi(xb.x) + bfhi(yo.x) * rsy * g0[1]; xn[2] = bflo(xb.y) + bflo(yo.y) * rsy * g0[2]; xn[3] = bfhi(xb.y) + bfhi(yo.y) * rsy * g0[3];
            xn[4] = bflo(xb.z) + bflo(yo.z) * rsy * g1[0]; xn[5] = bfhi(xb.z) + bfhi(yo.z) * rsy * g1[1]; xn[6] = bflo(xb.w) + bflo(yo.w) * rsy * g1[2]; xn[7] = bfhi(xb.w) + bfhi(yo.w) * rsy * g1[3];
#pragma unroll
            for (int e = 0; e < 8; ++e) ss += xn[e] * xn[e];
            if (last) { *(f32x4*)(out + (size_t)m * DM + col) = (f32x4){xn[0], xn[1], xn[2], xn[3]}; *(f32x4*)(out + (size_t)m * DM + col + 4) = (f32x4){xn[4], xn[5], xn[6], xn[7]}; }
            else { v4u w; w.x = pk2(xn[0], xn[1]); w.y = pk2(xn[2], xn[3]); w.z = pk2(xn[4], xn[5]); w.w = pk2(xn[6], xn[7]); *(v4u*)(XB + (size_t)m * DM + col) = w; } }
        if (!last) { ss = wave_sum(ss); if (lane == 0) rstd[m] = 1.0f / sqrtf(ss * (1.0f / DM) + RMS_EPS); }
    }
}

__global__ void __launch_bounds__(NWAVES * 64, 2) mk_fwd(Args args) {
    extern __shared__ __attribute__((aligned(16))) unsigned char lds_raw[];
    LAS unsigned char* lds = (LAS unsigned char*)lds_raw;
    const int G = gridDim.x, NGW = G * NWAVES;
    unsigned char* ws = args.ws;
    const int lo = args.ph_lo, hi = args.ph_hi;
    if (threadIdx.x < 32) ((LAS unsigned*)(lds + MISC_OFF))[threadIdx.x] = 0u;
    __syncthreads();
    XcdBarrier bar; bar.bar = (unsigned*)(ws + WS_CTL) + CW_BAR; bar.x = 0; bar.st = (volatile LAS unsigned*)(lds + MISC_OFF);
    if (hi - lo > 1) bar = xcd_barrier_post((unsigned*)(ws + WS_CTL) + CW_BAR, (volatile LAS unsigned*)(lds + MISC_OFF));
#define IN(k) (lo <= (k) && (k) < hi)
#define OPAQUE_IDS() int tid_ = threadIdx.x; asm volatile("" : "+v"(tid_)); const int tid = tid_, lane = tid & 63, wave = __builtin_amdgcn_readfirstlane(tid >> 6); int bx_ = blockIdx.x; asm volatile("" : "+s"(bx_)); const int gw = bx_ * NWAVES + wave; (void)gw; (void)lane
#define SEAM(k) do { if (IN(k) && IN((k) + 1)) xcd_barrier(bar); } while (0)

    bf16* const XB = (bf16*)(ws + WS_XB); bf16* const A1 = (bf16*)(ws + WS_A1); bf16* const A2 = (bf16*)(ws + WS_A2); bf16* const QB = (bf16*)(ws + WS_Q); bf16* const SZ = (bf16*)(ws + WS_SZ);
    bf16* const YB = (bf16*)(ws + WS_Y); bf16* const YO = (bf16*)(ws + WS_YO); bf16* const KVB = (bf16*)(ws + WS_KV);
    float* const RSTD = (float*)(ws + WS_RSTD); float* const RSTDM = (float*)(ws + WS_RSTDM); float* const VST = (float*)(ws + WS_VST); float* const YSS = (float*)(ws + WS_YSS);

    if (IN(0)) { OPAQUE_IDS(); p0_convert(args, ws, lds, gw, NGW, wave, lane); }
    SEAM(0);
    if (IN(1)) {
        pg8::Gemm g{(const bf16*)(ws + WS_MEMB), (const bf16*)(ws + WS_WKV), NMEM, DEPTH * NKV, DM}; pg8::StaticOrder S; S.init(NMEM, DEPTH * NKV, G, (int)blockIdx.x);
        pg8::EpiKV E{KVB, RSTDM};
        pg8::gemm_phase<pg8::EpiKV, pg8::StaticOrder, true, true>(lds, g, S, E);
    }
    SEAM(1);
    for (int L = 0; L < DEPTH; ++L) {
        const int k0 = 2 + 4 * L, gm = L & 1, jj = L >> 1;
        if (IN(k0)) {
            const size_t woff = (L == 0) ? WIN_OFF0 : (L == 1) ? WIN_OFF1 : (L == 2) ? WIN_OFF2 : WIN_OFF3; const int nin = gm ? NIN_GMLP : NIN_CONV;
            pg8::Gemm g{XB, (const bf16*)(ws + WS_WIN + woff), SEQ, nin, DM}; pg8::StaticOrder S; S.init(SEQ, nin, G, (int)blockIdx.x);
            pg8::EpiProj E{A1, RSTD, VST, gm};
            pg8::gemm_phase<pg8::EpiProj, pg8::StaticOrder, true, true>(lds, g, S, E);
        }
        SEAM(k0);
        if (IN(k0 + 1)) { OPAQUE_IDS();
            const bf16* Kl = KVB + (size_t)L * (2 * 256 * 1024); const bf16* VTl = Kl + 256 * 1024;
            if (gm) {
                const float* ws_w = args.in[12] + (size_t)jj * 8 * 128 * 128; const float* bs = args.in[13] + (size_t)jj * 8 * 128; const float* lng = args.in[10] + (size_t)jj * BRW; const float* lnb = args.in[11] + (size_t)jj * BRW;
                for (int un = bx_; un < 1024; un += G) { const int nb = un >> 3, gg = un & 7;
                    spatial_unit(A2, A1, VST, ws_w + (size_t)gg * 128 * 128, bs + gg * 128, lng, lnb, YB, nb, gg, lds, tid); }
            } else {
                const float* cw = args.in[8] + (size_t)jj * 3 * BRW;
                for (int task = gw; task < 512 * 6; task += NGW) conv_task(A1, A2, cw, YB, task, lane);
            }
            for (int task = gw; task < (SEQ / 16) * NHEAD; task += NGW) attn_task(QB, SZ, Kl, VTl, YB, 16 * (task >> 2), task & 3, lane);
        }
        SEAM(k0 + 1);
        if (IN(k0 + 2)) {
            pg8::Gemm g{YB, (const bf16*)(ws + WS_WOUT) + (size_t)L * DM * DM, SEQ, DM, DM}; pg8::StaticOrder S; S.init(SEQ, DM, G, (int)blockIdx.x);
            pg8::EpiOut E{YO, YSS};
            pg8::gemm_phase<pg8::EpiOut, pg8::StaticOrder, true, true>(lds, g, S, E);
        }
        SEAM(k0 + 2);
        if (IN(k0 + 3)) { OPAQUE_IDS(); p4_rows(YO, YSS, args.in[3] + (size_t)L * DM, XB, RSTD, args.out, L == DEPTH - 1, gw, NGW, lane); }
        if (L < DEPTH - 1) SEAM(k0 + 3);
    }
#undef IN
#undef SEAM
}

extern "C" void kernel_launch(void* const* d_in, const int* in_sizes, int n_in, void* d_out, int out_size, void* d_ws, size_t ws_size, hipStream_t stream) {
    static int grid = 0;
    if (grid == 0) {
        if (n_in != 14 || in_sizes[0] != SEQ * DM || out_size != SEQ * DM || ws_size < WS_END) { fprintf(stderr, "kernel_launch: unexpected shapes / workspace (n_in %d, in0 %d, out %d, ws %zu, need %zu); nothing launched\n", n_in, n_in > 0 ? in_sizes[0] : -1, out_size, ws_size, (size_t)WS_END); grid = -1; return; }
        int dev = 0, cus = 0, per_cu = 0;
        if (hipGetDevice(&dev) != hipSuccess || hipDeviceGetAttribute(&cus, hipDeviceAttributeMultiprocessorCount, dev) != hipSuccess) { grid = -1; return; }
        if (hipFuncSetAttribute((const void*)mk_fwd, hipFuncAttributeMaxDynamicSharedMemorySize, LDS_BYTES) != hipSuccess) { fprintf(stderr, "kernel_launch: hipFuncSetAttribute failed\n"); grid = -1; return; }
        if (hipOccupancyMaxActiveBlocksPerMultiprocessor(&per_cu, (const void*)mk_fwd, NWAVES * 64, LDS_BYTES) != hipSuccess || per_cu < 1) { fprintf(stderr, "kernel_launch: occupancy query says %d\n", per_cu); }
        (void)hipGetLastError();
        grid = cus;
    }
    if (grid < 0) return;
    if (hipMemsetAsync((char*)d_ws + WS_CTL, 0, CTL_ZERO_BYTES, stream) != hipSuccess) return;
    Args a{};
    for (int i = 0; i < 14; ++i) a.in[i] = (const float*)d_in[i];
    a.out = (float*)d_out; a.ws = (unsigned char*)d_ws;
#if MK_ONE_LAUNCH
    a.ph_lo = 0; a.ph_hi = NPHASE;
    hipLaunchKernelGGL(mk_fwd, dim3(grid), dim3(NWAVES * 64), LDS_BYTES, stream, a);
#else
    for (int k = 0; k < NPHASE; ++k) { a.ph_lo = k; a.ph_hi = k + 1; hipLaunchKernelGGL(mk_fwd, dim3(grid), dim3(NWAVES * 64), LDS_BYTES, stream, a); }
#endif
}
```

```cpp
#include <hip/hip_runtime.h>
#include <cstdio>
#include <cstdint>
namespace pg8 {
#define PG8_LAS __attribute__((address_space(3)))
typedef unsigned short bf16_t;
typedef short bf16x8 __attribute__((ext_vector_type(8)));
typedef float f32x4 __attribute__((ext_vector_type(4)));
typedef unsigned u32x4 __attribute__((ext_vector_type(4)));
constexpr int BM = 256, BK = 64, HALF = 128, HTB = HALF * BK * 2  , STAGE_BYTES = 8 * HTB, NXCD = 8, WGM = 8;

__host__ __device__ __forceinline__ int lds_byte(int r, int c) { const int st = (r >> 4) * 2 + (c >> 5), rr = r & 15, cc = c & 31, ob = rr * 64 + cc * 2; return st * 1024 + (ob ^ (((ob >> 9) & 1) << 5)); }
__host__ __device__ __forceinline__ void stage_rc(int b, int& R, int& C) { const int st = b / 1024, sb = b % 1024, swz = sb ^ (((sb >> 9) & 1) << 5); R = (st >> 1) * 16 + swz / 64; C = (st & 1) * 32 + (swz % 64) / 2; }
__host__ __device__ __forceinline__ int perm32(int rho) { const int n = rho >> 4, i = rho & 15; return 8 * (i >> 2) + 4 * n + (i & 3); }

struct Unit { int pm, pn; };
struct Gemm { const bf16_t* A; const bf16_t* Bt; int M, N, K; };

struct StaticOrder {
    int nM, nN, nwg, G, c;
    __host__ __device__ void init(int M, int N, int G_, int c_) { nM = M / BM; nN = N / BM; nwg = nM * nN; G = G_; c = c_; }
    __host__ __device__ bool next(int i, Unit& u) const {
        const long L = (long)i * G + c; if (L >= nwg) return false;
        int wgid = (int)L; { const int q = nwg / NXCD, r = nwg % NXCD, xcd = wgid % NXCD, off = wgid / NXCD; wgid = (xcd < r ? xcd * (q + 1) : r * (q + 1) + (xcd - r) * q) + off; }
        const int nig = WGM * nN, gid = wgid / nig, fm = gid * WGM, gsz = (nM - fm) < WGM ? (nM - fm) : WGM;
        u.pm = fm + ((wgid % nig) % gsz); u.pn = (wgid % nig) / gsz; return true;
    }
    __device__ __forceinline__ void a_ready(const Unit&) const {}
    __device__ __forceinline__ void done(const Unit&) const {}
};


__device__ __forceinline__ unsigned cvt_pk_bf16(float lo, float hi) { unsigned r; asm("v_cvt_pk_bf16_f32 %0, %1, %2" : "=v"(r) : "v"(lo), "v"(hi)); return r; }
__device__ __forceinline__ float silu_f(float z) { return z * __builtin_amdgcn_rcpf(1.0f + __builtin_amdgcn_exp2f(-1.44269504f * z)); }
__device__ __forceinline__ float gelu_f(float x) { const float u = x * (0.7978845608f + 0.0356774081f * x * x); return x * __builtin_amdgcn_rcpf(1.0f + __builtin_amdgcn_exp2f(-2.88539008f * u)); }
__device__ __forceinline__ unsigned short f2bf1(float f) { unsigned u = __builtin_bit_cast(unsigned, f); return (unsigned short)((u + 0x7fffu + ((u >> 16) & 1u)) >> 16); }

struct EpiProj {
    static constexpr bool PERM = false, AFTER_DRAIN = false;
    bf16_t* base; float* vst; int gm;
    static constexpr size_t OFF_A2 = (size_t)48 << 20, OFF_Q = (size_t)96 << 20, OFF_SZ = (size_t)112 << 20;
    __device__ __forceinline__ void operator()(const f32x4 (&acc)[2][2][4][2], const Unit& u, int wr, int wc, int fr, int fq) const {
        asm volatile("" : "+v"(fr), "+v"(fq));
        const int pn = u.pn; int kind, p;
        if (gm == 0) { if (pn < 24) { kind = 0; p = pn; } else if (pn < 48) { kind = 1; p = pn - 24; } else if (pn < 52) { kind = 3; p = pn - 48; } else { kind = 4; p = pn - 52; } }
        else         { if (pn < 24) { kind = 2; p = pn; } else if (pn < 36) { kind = 5; p = pn - 24; } else if (pn < 40) { kind = 3; p = pn - 36; } else { kind = 4; p = pn - 40; } }
        const int row0 = u.pm * BM + wr * 64 + fr;
        if (kind <= 2) {
            bf16_t* O = base + ((kind == 1) ? OFF_A2 : (size_t)0); const int col0 = 128 * p + 32 * wc + 8 * fq;
#pragma unroll
            for (int ai = 0; ai < 2; ++ai)
#pragma unroll
                for (int m = 0; m < 4; ++m) { const int r = row0 + ai * HALF + m * 16;
                    f32x4 o[2];
#pragma unroll
                    for (int n = 0; n < 2; ++n) { const f32x4 a = acc[ai][0][m][n], b = acc[ai][1][m][n];
#pragma unroll
                        for (int j = 0; j < 4; ++j) o[n][j] = (kind == 0) ? a[j] * silu_f(b[j]) : (kind == 1) ? a[j] * b[j] : gelu_f(a[j]) * silu_f(b[j]); }
                    u32x4 w; w.x = cvt_pk_bf16(o[0][0], o[0][1]); w.y = cvt_pk_bf16(o[0][2], o[0][3]); w.z = cvt_pk_bf16(o[1][0], o[1][1]); w.w = cvt_pk_bf16(o[1][2], o[1][3]);
                    *(u32x4*)(O + (size_t)r * 3072 + col0) = w; }
        } else {
            bf16_t* O = base + ((kind == 3) ? OFF_Q : (kind == 4) ? OFF_SZ : OFF_A2); const int ldo = (kind == 5) ? 3072 : 1024; const int col0 = 256 * p + 32 * wc + 8 * fq;
#pragma unroll
            for (int ai = 0; ai < 2; ++ai)
#pragma unroll
                for (int m = 0; m < 4; ++m) { const int r = row0 + ai * HALF + m * 16; float s1 = 0.f, s2 = 0.f;
#pragma unroll
                    for (int bj = 0; bj < 2; ++bj) { f32x4 o[2];
#pragma unroll
                        for (int n = 0; n < 2; ++n) { const f32x4 a = acc[ai][bj][m][n];
#pragma unroll
                            for (int j = 0; j < 4; ++j) { const float v = (kind == 3) ? a[j] * 0.0625f : (kind == 4) ? silu_f(a[j]) : gelu_f(a[j]); o[n][j] = v; s1 += v; s2 += v * v; } }
                        u32x4 w; w.x = cvt_pk_bf16(o[0][0], o[0][1]); w.y = cvt_pk_bf16(o[0][2], o[0][3]); w.z = cvt_pk_bf16(o[1][0], o[1][1]); w.w = cvt_pk_bf16(o[1][2], o[1][3]);
                        *(u32x4*)(O + (size_t)r * ldo + col0 + bj * HALF) = w; }
                    if (kind == 5) { s1 += __shfl_xor(s1, 16); s1 += __shfl_xor(s1, 32); s2 += __shfl_xor(s2, 16); s2 += __shfl_xor(s2, 32);
                        if (fq == 0) { float* q = vst + ((size_t)r * 48 + p * 4 + wc) * 2; q[0] = s1; q[1] = s2; } } }
        }
    }
};
struct EpiOut {
    static constexpr bool PERM = false, AFTER_DRAIN = false;
    bf16_t* YO; float* yss;
    __device__ __forceinline__ void operator()(const f32x4 (&acc)[2][2][4][2], const Unit& u, int wr, int wc, int fr, int fq) const {
        asm volatile("" : "+v"(fr), "+v"(fq));
        const int row0 = u.pm * BM + wr * 64 + fr, col0 = 256 * u.pn + 32 * wc + 8 * fq;
#pragma unroll
        for (int ai = 0; ai < 2; ++ai)
#pragma unroll
            for (int m = 0; m < 4; ++m) { const int r = row0 + ai * HALF + m * 16; float ss = 0.f;
#pragma unroll
                for (int bj = 0; bj < 2; ++bj) { const f32x4 a = acc[ai][bj][m][0], b = acc[ai][bj][m][1];
                    ss += (a[0] * a[0] + a[1] * a[1]) + (a[2] * a[2] + a[3] * a[3]) + (b[0] * b[0] + b[1] * b[1]) + (b[2] * b[2] + b[3] * b[3]);
                    u32x4 w; w.x = cvt_pk_bf16(a[0], a[1]); w.y = cvt_pk_bf16(a[2], a[3]); w.z = cvt_pk_bf16(b[0], b[1]); w.w = cvt_pk_bf16(b[2], b[3]);
                    *(u32x4*)(YO + (size_t)r * 4096 + col0 + bj * HALF) = w; }
                ss += __shfl_xor(ss, 16); ss += __shfl_xor(ss, 32);
                if (fq == 0) yss[(size_t)r * 64 + u.pn * 4 + wc] = ss; }
    }
};
struct EpiKV {
    static constexpr bool PERM = false, AFTER_DRAIN = false;
    bf16_t* KV;
    __device__ __forceinline__ void operator()(const f32x4 (&acc)[2][2][4][2], const Unit& u, int wr, int wc, int fr, int fq) const {
        asm volatile("" : "+v"(fr), "+v"(fq));
        const int l = u.pn >> 3, t = u.pn & 7; bf16_t* base = KV + (size_t)l * (2 * 256 * 1024); const int row0 = wr * 64 + fr;
#pragma unroll
        for (int ai = 0; ai < 2; ++ai)
#pragma unroll
            for (int m = 0; m < 4; ++m) { const int r = row0 + ai * HALF + m * 16;
#pragma unroll
                for (int bj = 0; bj < 2; ++bj) { const f32x4 a = acc[ai][bj][m][0], b = acc[ai][bj][m][1];
                    if (t < 4) { u32x4 w; w.x = cvt_pk_bf16(a[0], a[1]); w.y = cvt_pk_bf16(a[2], a[3]); w.z = cvt_pk_bf16(b[0], b[1]); w.w = cvt_pk_bf16(b[2], b[3]);
                        *(u32x4*)(base + (size_t)r * 1024 + 256 * t + bj * HALF + 32 * wc + 8 * fq) = w; }
                    else { bf16_t* vt = base + 256 * 1024 + (size_t)(256 * (t - 4) + bj * HALF + 32 * wc + 8 * fq) * 256 + r;
#pragma unroll
                        for (int j = 0; j < 4; ++j) { vt[(size_t)j * 256] = f2bf1(a[j]); vt[(size_t)(4 + j) * 256] = f2bf1(b[j]); } } } }
    }
};
template <class Epi, class Sched, bool ALIGN_EPI = false, bool SP2 = false>
__device__ __forceinline__ void gemm_phase(PG8_LAS unsigned char* lds, const Gemm g, const Sched& S, const Epi& E) {
    int tid_ = threadIdx.x; asm volatile("" : "+v"(tid_));
    const int tid = tid_, wid = __builtin_amdgcn_readfirstlane(tid >> 6), lane = tid & 63, wr = wid >> 2, wc = wid & 3, fr = lane & 15, fq = lane >> 4;
    const int K = g.K, nt = K / BK;
    unsigned voffA[2], voffB[2];
#pragma unroll
    for (int i = 0; i < 2; ++i) { int R, C; stage_rc(tid * 16 + i * 8192, R, C); const int Rb = Epi::PERM ? ((R & ~31) + perm32(R & 31)) : R;
        voffA[i] = (unsigned)(R * K + C) * 2u; voffB[i] = (unsigned)(Rb * K + C) * 2u; }
    const size_t kstep = (size_t)(BK * 2);
    const size_t hstep = (size_t)HALF * K * 2;
    const size_t tstep = 2 * hstep;
    const unsigned ldsw = (unsigned)wid * 1024u;
    const int aoff = lds_byte(wr * 64 + fr, fq * 8), boff = lds_byte(wc * 32 + fr, fq * 8);
#define PG8_SA(b, h) (((b) * 2 + (h)) * HTB)
#define PG8_SB(b, h) ((4 + (b) * 2 + (h)) * HTB)
#define PG8_STAGE(bufoff, gbase, voff) do { _Pragma("unroll") for (int _i = 0; _i < 2; ++_i) \
        __builtin_amdgcn_global_load_lds((const unsigned*)((const char*)(gbase) + (voff)[_i]), (PG8_LAS unsigned*)(lds + (bufoff) + ldsw + _i * 8192), 16, 0, 0); } while (0)
#define PG8_LDA(dst, b, h) do { _Pragma("unroll") for (int m = 0; m < 4; ++m) _Pragma("unroll") for (int k = 0; k < 2; ++k) dst[m][k] = *(const PG8_LAS bf16x8*)(lds + PG8_SA(b, h) + aoff + m * 2048 + k * 1024); } while (0)
#define PG8_LDB(dst, b, h) do { _Pragma("unroll") for (int n = 0; n < 2; ++n) _Pragma("unroll") for (int k = 0; k < 2; ++k) dst[n][k] = *(const PG8_LAS bf16x8*)(lds + PG8_SB(b, h) + boff + n * 2048 + k * 1024); } while (0)
#define PG8_MMA(ai, bj, At, Bt) do { __builtin_amdgcn_s_setprio(1); _Pragma("unroll") for (int m = 0; m < 4; ++m) _Pragma("unroll") for (int n = 0; n < 2; ++n) _Pragma("unroll") for (int k = 0; k < 2; ++k) \
        acc[ai][bj][m][n] = __builtin_amdgcn_mfma_f32_16x16x32_bf16(Bt[n][k], At[m][k], acc[ai][bj][m][n], 0, 0, 0); __builtin_amdgcn_s_setprio(0); } while (0)
#define PG8_WAIT_V(n) asm volatile("s_waitcnt vmcnt(" #n ")" ::: "memory")
#define PG8_WAIT_L(n) asm volatile("s_waitcnt lgkmcnt(" #n ")" ::: "memory")
#define PG8_BAR __builtin_amdgcn_s_barrier()
#define PG8_SCHED __builtin_amdgcn_sched_barrier(0)
    Unit cur, nxt; int ui = 0;
    if (!S.next(0, cur)) return;
    f32x4 acc[2][2][4][2];
#pragma unroll
    for (int a = 0; a < 2; ++a)
#pragma unroll
        for (int b = 0; b < 2; ++b)
#pragma unroll
            for (int m = 0; m < 4; ++m)
#pragma unroll
                for (int n = 0; n < 2; ++n) acc[a][b][m][n] = (f32x4){0.f, 0.f, 0.f, 0.f};
    bf16x8 At[4][2], B0[2][2], B1[2][2];
    const char* cA = (const char*)g.A + (size_t)cur.pm * tstep; const char* cB = (const char*)g.Bt + (size_t)cur.pn * tstep;
    S.a_ready(cur);
    if constexpr (SP2) {
        PG8_STAGE(PG8_SB(0, 0), cB, voffB); PG8_STAGE(PG8_SB(0, 1), cB + hstep, voffB); PG8_STAGE(PG8_SA(0, 0), cA, voffA); PG8_STAGE(PG8_SA(0, 1), cA + hstep, voffA);
        if (wr == 1) PG8_BAR;
        PG8_WAIT_V(2); PG8_BAR;
        PG8_STAGE(PG8_SB(1, 0), cB + kstep, voffB); PG8_STAGE(PG8_SA(1, 0), cA + kstep, voffA); PG8_STAGE(PG8_SB(1, 1), cB + hstep + kstep, voffB);
        PG8_WAIT_V(6); PG8_BAR;
    } else {
        PG8_STAGE(PG8_SB(0, 0), cB, voffB); PG8_STAGE(PG8_SA(0, 0), cA, voffA); PG8_STAGE(PG8_SB(0, 1), cB + hstep, voffB); PG8_STAGE(PG8_SA(0, 1), cA + hstep, voffA);
        if (wr == 1) PG8_BAR;
        PG8_WAIT_V(4); PG8_BAR;
        PG8_STAGE(PG8_SB(1, 0), cB + kstep, voffB); PG8_STAGE(PG8_SA(1, 0), cA + kstep, voffA); PG8_STAGE(PG8_SB(1, 1), cB + hstep + kstep, voffB);
        PG8_WAIT_V(6); PG8_BAR;
    }
    for (;;) {
        const bool has_next = S.next(ui + 1, nxt);
        const char* nA = has_next ? (const char*)g.A + (size_t)nxt.pm * tstep : cA; const char* nB = has_next ? (const char*)g.Bt + (size_t)nxt.pn * tstep : cB;
        for (int t = 0; t < nt; t += 2) {
            const bool last = (t == nt - 2);
            const char* a1 = cA + (size_t)(t + 1) * kstep;
            const char* a2 = last ? nA : cA + (size_t)(t + 2) * kstep; const char* b2 = last ? nB : cB + (size_t)(t + 2) * kstep;
            const char* a3 = a2 + kstep; const char* b3 = b2 + kstep;
            if (last && has_next) S.a_ready(nxt);
            if constexpr (SP2) {
            PG8_LDB(B0, 0, 0); PG8_LDB(B1, 0, 1); PG8_SCHED; PG8_LDA(At, 0, 0); PG8_STAGE(PG8_SA(1, 1), a1 + hstep, voffA);
            PG8_WAIT_V(8); PG8_WAIT_L(0); PG8_BAR; PG8_MMA(0, 0, At, B0); PG8_MMA(0, 1, At, B1); PG8_BAR; PG8_SCHED;
            PG8_LDA(At, 0, 1); PG8_STAGE(PG8_SB(0, 0), b2, voffB); PG8_STAGE(PG8_SB(0, 1), b2 + hstep, voffB); PG8_STAGE(PG8_SA(0, 0), a2, voffA);
            PG8_WAIT_V(8); PG8_WAIT_L(0); PG8_BAR; PG8_MMA(1, 0, At, B0); PG8_MMA(1, 1, At, B1); PG8_BAR; PG8_SCHED;
            PG8_LDB(B0, 1, 0); PG8_LDB(B1, 1, 1); PG8_SCHED; PG8_LDA(At, 1, 0); PG8_STAGE(PG8_SA(0, 1), a2 + hstep, voffA);
            PG8_WAIT_V(8); PG8_WAIT_L(0); PG8_BAR; PG8_MMA(0, 0, At, B0); PG8_MMA(0, 1, At, B1); PG8_BAR; PG8_SCHED;
            PG8_LDA(At, 1, 1); PG8_STAGE(PG8_SB(1, 0), b3, voffB); PG8_STAGE(PG8_SB(1, 1), b3 + hstep, voffB); PG8_STAGE(PG8_SA(1, 0), a3, voffA);
            PG8_WAIT_V(8); PG8_WAIT_L(0); PG8_BAR; PG8_MMA(1, 0, At, B0); PG8_MMA(1, 1, At, B1); PG8_BAR; PG8_SCHED;
            } else {
            PG8_LDB(B0, 0, 0); PG8_SCHED; PG8_LDA(At, 0, 0); PG8_STAGE(PG8_SA(1, 1), a1 + hstep, voffA);
            PG8_WAIT_L(8); PG8_BAR; PG8_WAIT_L(0); PG8_MMA(0, 0, At, B0); PG8_BAR; PG8_SCHED;
            PG8_LDB(B1, 0, 1); PG8_STAGE(PG8_SB(0, 0), b2, voffB);
            PG8_BAR; PG8_WAIT_L(0); PG8_MMA(0, 1, At, B1); PG8_BAR;
            PG8_LDA(At, 0, 1); PG8_STAGE(PG8_SA(0, 0), a2, voffA);
            PG8_BAR; PG8_WAIT_L(0); PG8_MMA(1, 0, At, B0); PG8_BAR; PG8_SCHED;
            PG8_STAGE(PG8_SB(0, 1), b2 + hstep, voffB);
            PG8_WAIT_V(6); PG8_BAR; PG8_MMA(1, 1, At, B1); PG8_BAR;
            PG8_LDB(B0, 1, 0); PG8_SCHED; PG8_LDA(At, 1, 0); PG8_STAGE(PG8_SA(0, 1), a2 + hstep, voffA);
            PG8_WAIT_L(8); PG8_BAR; PG8_WAIT_L(0); PG8_MMA(0, 0, At, B0); PG8_BAR; PG8_SCHED;
            PG8_LDB(B1, 1, 1); PG8_STAGE(PG8_SB(1, 0), b3, voffB);
            PG8_BAR; PG8_WAIT_L(0); PG8_MMA(0, 1, At, B1); PG8_BAR;
            PG8_LDA(At, 1, 1); PG8_STAGE(PG8_SA(1, 0), a3, voffA);
            PG8_BAR; PG8_WAIT_L(0); PG8_MMA(1, 0, At, B0); PG8_BAR; PG8_SCHED;
            PG8_STAGE(PG8_SB(1, 1), b3 + hstep, voffB);
            PG8_WAIT_V(6); PG8_BAR; PG8_MMA(1, 1, At, B1); PG8_BAR;
            }
        }
        if constexpr (ALIGN_EPI) { if (wr == 0) PG8_BAR; }
        if constexpr (!Epi::AFTER_DRAIN) { E(acc, cur, wr, wc, fr, fq); S.done(cur); }
        if (!has_next) break;
#pragma unroll
        for (int a = 0; a < 2; ++a)
#pragma unroll
            for (int b = 0; b < 2; ++b)
#pragma unroll
                for (int m = 0; m < 4; ++m)
#pragma unroll
                    for (int n = 0; n < 2; ++n) acc[a][b][m][n] = (f32x4){0.f, 0.f, 0.f, 0.f};
        cur = nxt; cA = nA; cB = nB; ++ui;
        if constexpr (ALIGN_EPI) { if (wr == 1) PG8_BAR; }
    }
    PG8_WAIT_V(0);
    if constexpr (!ALIGN_EPI) { if (wr == 0) PG8_BAR; }
    PG8_BAR;
    if constexpr (Epi::AFTER_DRAIN) { E.fused(acc, cur, wr, wc, fr, fq, lds, wid, lane); S.done(cur); }
#undef PG8_SA
#undef PG8_SB
#undef PG8_STAGE
#undef PG8_LDA
#undef PG8_LDB
#undef PG8_MMA
#undef PG8_WAIT_V
#undef PG8_WAIT_L
#undef PG8_BAR
#undef PG8_SCHED
}
}

constexpr int SEQ = 16384, DM = 4096, DEPTH = 4, NMEM = 256, BRW = 3072, MEMW = 1024, NHEAD = 4, HDIM = 256;
constexpr int NIN_CONV = 14336, NIN_GMLP = 11264, NKV = 2048;
constexpr float RMS_EPS = 1e-6f, LNORM_EPS = 1e-5f;
constexpr int NWAVES = 8;
#ifndef MK_ONE_LAUNCH
#define MK_ONE_LAUNCH 1
#endif
constexpr int NPHASE = 2 + 4 * DEPTH;
#ifndef REP_P0
#define REP_P0 1
#endif
#ifndef REP_P1
#define REP_P1 1
#endif
#ifndef REP_P2
#define REP_P2 1
#endif
#ifndef REP_P3
#define REP_P3 1
#endif
#ifndef REP_KV
#define REP_KV 1
#endif
#ifndef REP_BAR
#define REP_BAR 1
#endif
#ifndef DRY_P4
#define DRY_P4 0
#endif

constexpr size_t MiB = 1u << 20;
constexpr size_t WS_CTL = 0, CTL_ZERO_BYTES = 1 * MiB;
constexpr size_t WS_WIN = 2 * MiB;
constexpr size_t WIN_OFF0 = 0, WIN_OFF1 = 112 * MiB, WIN_OFF2 = 200 * MiB, WIN_OFF3 = 312 * MiB;
constexpr size_t WS_WOUT = WS_WIN + 400 * MiB;
constexpr size_t WS_WKV = WS_WOUT + 128 * MiB;
constexpr size_t WS_MEMB = WS_WKV + 64 * MiB;
constexpr size_t WS_KV = WS_MEMB + 2 * MiB;
constexpr size_t WS_XB = WS_KV + 4 * MiB;
constexpr size_t WS_A1 = WS_XB + 128 * MiB;
constexpr size_t WS_A2 = WS_A1 + 96 * MiB;
constexpr size_t WS_Q = WS_A2 + 96 * MiB;
constexpr size_t WS_SZ = WS_Q + 32 * MiB;
constexpr size_t WS_Y = WS_SZ + 32 * MiB;
constexpr size_t WS_YO = WS_Y + 128 * MiB;
constexpr size_t WS_RSTD = WS_YO + 128 * MiB;
constexpr size_t WS_RSTDM = WS_RSTD + 1 * MiB;
constexpr size_t WS_VST = WS_RSTDM + 1 * MiB;
constexpr size_t WS_YSS = WS_VST + 6 * MiB;
constexpr size_t WS_HN = WS_YSS + 4 * MiB;
constexpr size_t WS_END = WS_HN + 128 * MiB;
static_assert(WS_A2 - WS_A1 == 2 * pg8::EpiProj::OFF_A2 && WS_Q - WS_A1 == 2 * pg8::EpiProj::OFF_Q && WS_SZ - WS_A1 == 2 * pg8::EpiProj::OFF_SZ, "EpiProj output offsets");
constexpr int CW_BAR = 4096;

constexpr int RING_BYTES = 131072;
constexpr int LDS_BYTES = 147456;
constexpr int MISC_OFF = LDS_BYTES - 128;

#define GAS __attribute__((address_space(1)))
#define LAS __attribute__((address_space(3)))
typedef unsigned short bf16;
typedef unsigned v4u __attribute__((ext_vector_type(4)));
typedef unsigned v2u __attribute__((ext_vector_type(2)));
typedef float f32x4 __attribute__((ext_vector_type(4)));
typedef short bf16x8 __attribute__((ext_vector_type(8)));
#define LDS_WAIT() asm volatile("s_waitcnt lgkmcnt(0)" ::: "memory")
__device__ __forceinline__ unsigned f2bf(float f) { unsigned u = __builtin_bit_cast(unsigned, f); return (u + 0x7fffu + ((u >> 16) & 1u)) >> 16; }
__device__ __forceinline__ unsigned pk2(float lo, float hi) { return pg8::cvt_pk_bf16(lo, hi); }
__device__ __forceinline__ float bflo(unsigned w) { return __builtin_bit_cast(float, w << 16); }
__device__ __forceinline__ float bfhi(unsigned w) { return __builtin_bit_cast(float, w & 0xffff0000u); }
__device__ __forceinline__ float wave_sum(float v) {
#pragma unroll
    for (int o = 1; o < 64; o <<= 1) v += __shfl_xor(v, o);
    return v;
}

#define XB_TMO      128
#define XB_XCNT(j)  (256  + 64 * (j))
#define XB_XSUB(j)  (1280 + 64 * (j))
#define XB_XGEN(j)  (2304 + 64 * (j))
#define XB_TOP      3328
#define XB_TOPGEN   3392
#define XCD_BAR_WORDS 3456
#define XB_SPIN_CAP (1u << 18)

__device__ __forceinline__ unsigned xb_ld(unsigned* p)              { return __hip_atomic_load(p, __ATOMIC_RELAXED, __HIP_MEMORY_SCOPE_AGENT); }
__device__ __forceinline__ unsigned xb_add(unsigned* p, unsigned v) { return __hip_atomic_fetch_add(p, v, __ATOMIC_RELAXED, __HIP_MEMORY_SCOPE_AGENT); }
__device__ __forceinline__ unsigned xb_xcc_id() { return (unsigned)__builtin_amdgcn_s_getreg((3 << 11) | 20) & 0xFu; }
#define XB_SPIN(cond, bar) do { unsigned _sp = 0; while (cond) { __builtin_amdgcn_s_sleep(1); \
    if ((++_sp & 255u) == 0u) { if (xb_ld(&(bar)[XB_TMO])) break; if (_sp > XB_SPIN_CAP) { atomicAdd(&(bar)[XB_TMO], 1u); break; } } } } while (0)

struct XcdBarrier {
    unsigned* bar; unsigned x;
    volatile LAS unsigned* st;
};
__device__ __forceinline__ XcdBarrier xcd_barrier_post(unsigned* bar, volatile LAS unsigned* st) {
    XcdBarrier b; b.bar = bar; b.x = xb_xcc_id(); b.st = st;
    if (threadIdx.x == 0) (void)xb_add(&bar[XB_XCNT(b.x)], 1u);
    return b;
}
__device__ __forceinline__ void xcd_barrier_complete(unsigned* bar, unsigned x, unsigned& nloc, unsigned& nx) {
    const unsigned G = gridDim.x * gridDim.y * gridDim.z;
    unsigned sum, cnt, mine, sp = 0u;
    for (;;) {
        sum = 0u; cnt = 0u; mine = 0u;
#pragma unroll
        for (unsigned j = 0; j < 16; ++j) { const unsigned c = xb_ld(&bar[XB_XCNT(j)]); sum += c; cnt += (c > 0u) ? 1u : 0u; mine = (j == x) ? c : mine; }
        if (sum == G) break;
        __builtin_amdgcn_s_sleep(1);
        if ((++sp & 255u) == 0u) { if (xb_ld(&bar[XB_TMO])) break; if (sp > XB_SPIN_CAP) { atomicAdd(&bar[XB_TMO], 1u); break; } }
    }
    nloc = mine > 0u ? mine : 1u; nx = cnt > 0u ? cnt : 1u;
}
__device__ __forceinline__ void xcd_barrier(const XcdBarrier& b) {
    asm volatile("s_waitcnt vmcnt(0)" ::: "memory");
    __syncthreads();
    if (threadIdx.x == 0) {
        unsigned* bar = b.bar;
        __builtin_amdgcn_s_waitcnt(0);
        unsigned nloc = b.st[0], nx = b.st[1];
        if (nloc == 0u) { xcd_barrier_complete(bar, b.x, nloc, nx); b.st[0] = nloc; b.st[1] = nx; }
        const unsigned old = xb_add(&bar[XB_XSUB(b.x)], 1u);
        const unsigned gen = old / nloc;
        if (old + 1u == (gen + 1u) * nloc) {
            __builtin_amdgcn_fence(__ATOMIC_RELEASE, "agent");
            asm volatile("s_waitcnt vmcnt(0)" ::: "memory");
            const unsigned og = xb_add(&bar[XB_TOP], 1u);
            const unsigned tg = og / nx;
            if (og + 1u == (tg + 1u) * nx) xb_add(&bar[XB_TOPGEN], 1u);
            else XB_SPIN(xb_ld(&bar[XB_TOPGEN]) == tg, bar);
            __builtin_amdgcn_fence(__ATOMIC_ACQUIRE, "agent");
            xb_add(&bar[XB_XGEN(b.x)], 1u);
            asm volatile("s_waitcnt vmcnt(0)" ::: "memory");
        } else {
            XB_SPIN(xb_ld(&bar[XB_XGEN(b.x)]) == gen, bar);
            __builtin_amdgcn_fence(__ATOMIC_ACQUIRE, "agent");
            asm volatile("s_waitcnt vmcnt(0)" ::: "memory");
        }
    }
    __syncthreads();
}

__device__ __forceinline__ int src32_conv(int gi) { const int pn = gi >> 3, bj = (gi >> 2) & 1, wc = gi & 3;
    if (pn < 24) return (bj ? 10240 : 0) + 128 * pn + 32 * wc;
    if (pn < 48) return (bj ? 6144 : 3072) + 128 * (pn - 24) + 32 * wc;
    if (pn < 52) return 9216 + 256 * (pn - 48) + 128 * bj + 32 * wc;
    return 13312 + 256 * (pn - 52) + 128 * bj + 32 * wc; }
__device__ __forceinline__ int src32_gmlp(int gi) { const int pn = gi >> 3, bj = (gi >> 2) & 1, wc = gi & 3;
    if (pn < 24) return (bj ? 7168 : 0) + 128 * pn + 32 * wc;
    if (pn < 36) return 3072 + 256 * (pn - 24) + 128 * bj + 32 * wc;
    if (pn < 40) return 6144 + 256 * (pn - 36) + 128 * bj + 32 * wc;
    return 10240 + 256 * (pn - 40) + 128 * bj + 32 * wc; }
__device__ __forceinline__ void cvt_item(const float* W, int N, int src32, const float* gk, bf16* WT, int slot0, int k0, LAS float* scr, int lane) {
#pragma unroll 8
    for (int i = 0; i < 32; ++i) { const int kk = 2 * i + (lane >> 5); scr[kk * 33 + (lane & 31)] = W[(size_t)(k0 + kk) * N + src32 + (lane & 31)]; }
    const int c = lane & 7;
    f32x4 g0 = (f32x4){1.f, 1.f, 1.f, 1.f}, g1 = g0;
    if (gk) { g0 = *(const f32x4*)(gk + k0 + 8 * c); g1 = *(const f32x4*)(gk + k0 + 8 * c + 4); }
    LDS_WAIT(); asm volatile("" ::: "memory");
#pragma unroll
    for (int j = 0; j < 4; ++j) { const int n = (lane >> 3) + 8 * j; const LAS float* s = scr + (8 * c) * 33 + pg8::perm32(n);
        v4u o; o.x = pk2(s[0 * 33] * g0[0], s[1 * 33] * g0[1]); o.y = pk2(s[2 * 33] * g0[2], s[3 * 33] * g0[3]); o.z = pk2(s[4 * 33] * g1[0], s[5 * 33] * g1[1]); o.w = pk2(s[6 * 33] * g1[2], s[7 * 33] * g1[3]);
        *(v4u*)(WT + (size_t)(slot0 + n) * DM + k0 + 8 * c) = o; }
    LDS_WAIT(); asm volatile("" ::: "memory");
}
__device__ __forceinline__ void row_to_bf16(const float* xr, bf16* orow  , bf16* nrow, int lane) {
    f32x4 v[16]; float ss = 0.f;
#pragma unroll
    for (int i = 0; i < 8; ++i) { const int col = 512 * i + 8 * lane; const f32x4 a = *(const f32x4*)(xr + col), b = *(const f32x4*)(xr + col + 4); v[2 * i] = a; v[2 * i + 1] = b;
        ss += (a[0] * a[0] + a[1] * a[1]) + (a[2] * a[2] + a[3] * a[3]) + (b[0] * b[0] + b[1] * b[1]) + (b[2] * b[2] + b[3] * b[3]); }
    ss = wave_sum(ss);
    const float rs = 1.0f / sqrtf(ss * (1.0f / DM) + RMS_EPS);
#pragma unroll
    for (int i = 0; i < 8; ++i) { const int col = 512 * i + 8 * lane; const f32x4 a = v[2 * i], b = v[2 * i + 1];
        if (orow) { v4u o; o.x = pk2(a[0], a[1]); o.y = pk2(a[2], a[3]); o.z = pk2(b[0], b[1]); o.w = pk2(b[2], b[3]); *(v4u*)(orow + col) = o; }
        v4u n; n.x = pk2(a[0] * rs, a[1] * rs); n.y = pk2(a[2] * rs, a[3] * rs); n.z = pk2(b[0] * rs, b[1] * rs); n.w = pk2(b[2] * rs, b[3] * rs); *(v4u*)(nrow + col) = n; }
}

struct Args { const float* in[14]; float* out; unsigned char* ws; int ph_lo, ph_hi; };

__device__ __forceinline__ void p0_convert(const Args& a, unsigned char* ws, LAS unsigned char* lds, int gw, int NGW, int wave, int lane) {
    LAS float* scr = (LAS float*)(lds + wave * 16384);
    const float* x = a.in[0]; const float* mem = a.in[1]; const float* pre_g = a.in[2]; const float* mem_g = a.in[4];
    const float* w_kv = a.in[5]; const float* w_out = a.in[6]; const float* conv_w_in = a.in[7]; const float* gmlp_w_in = a.in[9];
    constexpr int I_KV = 64 * (NKV / 32), I_OUT = 64 * (DM / 32), I_CONV = 64 * (NIN_CONV / 32), I_GMLP = 64 * (NIN_GMLP / 32);
    constexpr int NITEMS = 4 * I_KV + 4 * I_OUT + 2 * I_CONV + 2 * I_GMLP;
    for (int it = gw; it < NITEMS; it += NGW) {
        int r = it; const float* W; const float* gk; bf16* WT; int N, ng, type;
        if (r < 4 * I_KV) { const int l = r / I_KV; r -= l * I_KV; W = w_kv + (size_t)l * DM * NKV; N = NKV; ng = NKV / 32; type = 2; gk = mem_g + l * DM; WT = (bf16*)(ws + WS_WKV) + (size_t)l * NKV * DM; }
        else { r -= 4 * I_KV;
            if (r < 4 * I_OUT) { const int l = r / I_OUT; r -= l * I_OUT; W = w_out + (size_t)l * DM * DM; N = DM; ng = DM / 32; type = 2; gk = nullptr; WT = (bf16*)(ws + WS_WOUT) + (size_t)l * DM * DM; }
            else { r -= 4 * I_OUT;
                if (r < 2 * I_CONV) { const int j = r / I_CONV; r -= j * I_CONV; W = conv_w_in + (size_t)j * DM * NIN_CONV; N = NIN_CONV; ng = NIN_CONV / 32; type = 0; gk = pre_g + (2 * j) * DM; WT = (bf16*)(ws + WS_WIN + (j ? WIN_OFF2 : WIN_OFF0)); }
                else { r -= 2 * I_CONV; const int j = r / I_GMLP; r -= j * I_GMLP; W = gmlp_w_in + (size_t)j * DM * NIN_GMLP; N = NIN_GMLP; ng = NIN_GMLP / 32; type = 1; gk = pre_g + (2 * j + 1) * DM; WT = (bf16*)(ws + WS_WIN + (j ? WIN_OFF3 : WIN_OFF1)); } } }
        const int kb = r / ng, gi = r - kb * ng;
        const int s32 = (type == 0) ? src32_conv(gi) : (type == 1) ? src32_gmlp(gi) : 32 * gi;
        cvt_item(W, N, s32, gk, WT, 32 * gi, 64 * kb, scr, lane);
    }
    for (int m = gw; m < SEQ; m += NGW) row_to_bf16(x + (size_t)m * DM, (bf16*)(ws + WS_XB) + (size_t)m * DM, (bf16*)(ws + WS_HN) + (size_t)m * DM, lane);
    for (int m = gw; m < NMEM; m += NGW) row_to_bf16(mem + (size_t)m * DM, nullptr, (bf16*)(ws + WS_MEMB) + (size_t)m * DM, lane);
}

constexpr int AT_LD = 264;
static_assert(256 * AT_LD * 2 <= MISC_OFF, "attention LDS map");
__device__ __forceinline__ void attn_stage(const bf16* src, size_t row_pitch, LAS unsigned char* lds, int tid) {
    v4u r[16];
#pragma unroll
    for (int it = 0; it < 16; ++it) { const int idx = it * 512 + tid; r[it] = *(const v4u*)(src + (size_t)(idx >> 5) * row_pitch + 8 * (idx & 31)); }
#pragma unroll
    for (int it = 0; it < 16; ++it) { const int idx = it * 512 + tid; *(LAS v4u*)(lds + (idx >> 5) * (AT_LD * 2) + 16 * (idx & 31)) = r[it]; }
}
__device__ __forceinline__ void attn_wg(const bf16* Q, const bf16* SZ, const bf16* Kl, const bf16* VTl, bf16* Y, int pb, int h, LAS unsigned char* lds, int tid) {
    const int lane = tid & 63, wave = __builtin_amdgcn_readfirstlane(tid >> 6), fr = lane & 15, fq = lane >> 4;
    const int t0 = 256 * pb + 32 * wave;
    attn_stage(Kl + HDIM * h, MEMW, lds, tid);
    const bf16* qp0 = Q + (size_t)(t0 + fr) * MEMW + HDIM * h + 8 * fq; const bf16* qp1 = qp0 + (size_t)16 * MEMW;
    bf16x8 qa = *(const bf16x8*)qp0, qb = *(const bf16x8*)qp1;
    __syncthreads();
    const LAS bf16* lrow = (const LAS bf16*)lds + (8 * (fr >> 2) + (fr & 3)) * AT_LD + 8 * fq;
    f32x4 s[2][16];
#pragma unroll
    for (int i = 0; i < 16; ++i) { s[0][i] = (f32x4){0.f, 0.f, 0.f, 0.f}; s[1][i] = s[0][i]; }
#pragma unroll 1
    for (int ks = 0; ks < 8; ++ks) {
        const int kn = (ks < 7) ? ks + 1 : 7; const bf16x8 qan = *(const bf16x8*)(qp0 + 32 * kn), qbn = *(const bf16x8*)(qp1 + 32 * kn);
#pragma unroll
        for (int g = 0; g < 8; ++g)
#pragma unroll
            for (int e = 0; e < 2; ++e) { const bf16x8 kf = *(const LAS bf16x8*)(lrow + (32 * g + 4 * e) * AT_LD + 32 * ks);
                s[0][2 * g + e] = __builtin_amdgcn_mfma_f32_16x16x32_bf16(kf, qa, s[0][2 * g + e], 0, 0, 0); s[1][2 * g + e] = __builtin_amdgcn_mfma_f32_16x16x32_bf16(kf, qb, s[1][2 * g + e], 0, 0, 0); }
        qa = qan; qb = qbn; }
    float inv[2]; bf16x8 pf[2][8];
#pragma unroll
    for (int tg = 0; tg < 2; ++tg) { float mx = s[tg][0][0];
#pragma unroll
        for (int i = 0; i < 16; ++i)
#pragma unroll
            for (int j = 0; j < 4; ++j) mx = fmaxf(mx, s[tg][i][j]);
        mx = fmaxf(mx, __shfl_xor(mx, 16)); mx = fmaxf(mx, __shfl_xor(mx, 32));
        float sum = 0.f; const float mxl = mx * 1.44269504f;
#pragma unroll
        for (int i = 0; i < 16; ++i)
#pragma unroll
            for (int j = 0; j < 4; ++j) { const float p = __builtin_amdgcn_exp2f(s[tg][i][j] * 1.44269504f - mxl); s[tg][i][j] = p; sum += p; }
        sum += __shfl_xor(sum, 16); sum += __shfl_xor(sum, 32); inv[tg] = 1.0f / sum;
#pragma unroll
        for (int g = 0; g < 8; ++g) { v4u w; w.x = pk2(s[tg][2 * g][0], s[tg][2 * g][1]); w.y = pk2(s[tg][2 * g][2], s[tg][2 * g][3]); w.z = pk2(s[tg][2 * g + 1][0], s[tg][2 * g + 1][1]); w.w = pk2(s[tg][2 * g + 1][2], s[tg][2 * g + 1][3]);
            pf[tg][g] = __builtin_bit_cast(bf16x8, w); } }
    __syncthreads();
    attn_stage(VTl + (size_t)HDIM * h * NMEM, NMEM, lds, tid);
    __syncthreads();
#pragma unroll 1
    for (int db2 = 0; db2 < 8; ++db2) { f32x4 o[2][2];
#pragma unroll
        for (int tg = 0; tg < 2; ++tg) { o[tg][0] = (f32x4){0.f, 0.f, 0.f, 0.f}; o[tg][1] = o[tg][0]; }
#pragma unroll
        for (int ks2 = 0; ks2 < 8; ++ks2)
#pragma unroll
            for (int e = 0; e < 2; ++e) { const bf16x8 vf = *(const LAS bf16x8*)(lrow + (32 * db2 + 4 * e) * AT_LD + 32 * ks2);
                o[0][e] = __builtin_amdgcn_mfma_f32_16x16x32_bf16(vf, pf[0][ks2], o[0][e], 0, 0, 0); o[1][e] = __builtin_amdgcn_mfma_f32_16x16x32_bf16(vf, pf[1][ks2], o[1][e], 0, 0, 0); }
#pragma unroll
        for (int tg = 0; tg < 2; ++tg) { const size_t t = (size_t)(t0 + 16 * tg + fr); const int col = HDIM * h + 32 * db2 + 8 * fq; const float iv = inv[tg];
            const v4u z = *(const v4u*)(SZ + t * MEMW + col);
            v4u w; w.x = pk2(o[tg][0][0] * iv * bflo(z.x), o[tg][0][1] * iv * bfhi(z.x)); w.y = pk2(o[tg][0][2] * iv * bflo(z.y), o[tg][0][3] * iv * bfhi(z.y));
            w.z = pk2(o[tg][1][0] * iv * bflo(z.z), o[tg][1][1] * iv * bfhi(z.z)); w.w = pk2(o[tg][1][2] * iv * bflo(z.w), o[tg][1][3] * iv * bfhi(z.w));
            *(v4u*)(Y + t * DM + BRW + col) = w; } }
    __syncthreads();
}

__device__ __forceinline__ void conv_task(const bf16* GZ, const bf16* CH, const float* cw  , bf16* Y, int task, int lane) {
    const int rsx = task / 6, cs = task - rsx * 6; const int t0 = 32 * rsx, c = 512 * cs + 8 * lane;
    float w0[8], w1[8], w2[8], p2[8], p1[8];
    { const f32x4 a = *(const f32x4*)(cw + c), b = *(const f32x4*)(cw + c + 4), d = *(const f32x4*)(cw + BRW + c), e = *(const f32x4*)(cw + BRW + c + 4), f = *(const f32x4*)(cw + 2 * BRW + c), g = *(const f32x4*)(cw + 2 * BRW + c + 4);
#pragma unroll
      for (int i = 0; i < 4; ++i) { w0[i] = a[i]; w0[4 + i] = b[i]; w1[i] = d[i]; w1[4 + i] = e[i]; w2[i] = f[i]; w2[4 + i] = g[i]; } }
    if (t0 >= 2) { const v4u u2 = *(const v4u*)(CH + (size_t)(t0 - 2) * BRW + c), u1 = *(const v4u*)(CH + (size_t)(t0 - 1) * BRW + c);
        p2[0] = bflo(u2.x); p2[1] = bfhi(u2.x); p2[2] = bflo(u2.y); p2[3] = bfhi(u2.y); p2[4] = bflo(u2.z); p2[5] = bfhi(u2.z); p2[6] = bflo(u2.w); p2[7] = bfhi(u2.w);
        p1[0] = bflo(u1.x); p1[1] = bfhi(u1.x); p1[2] = bflo(u1.y); p1[3] = bfhi(u1.y); p1[4] = bflo(u1.z); p1[5] = bfhi(u1.z); p1[6] = bflo(u1.w); p1[7] = bfhi(u1.w); }
    else {
#pragma unroll
        for (int i = 0; i < 8; ++i) { p2[i] = 0.f; p1[i] = 0.f; } }
#pragma unroll 4
    for (int t = t0; t < t0 + 32; ++t) {
        const v4u uc = *(const v4u*)(CH + (size_t)t * BRW + c), ug = *(const v4u*)(GZ + (size_t)t * BRW + c);
        float cu[8], gz[8], o[8];
        cu[0] = bflo(uc.x); cu[1] = bfhi(uc.x); cu[2] = bflo(uc.y); cu[3] = bfhi(uc.y); cu[4] = bflo(uc.z); cu[5] = bfhi(uc.z); cu[6] = bflo(uc.w); cu[7] = bfhi(uc.w);
        gz[0] = bflo(ug.x); gz[1] = bfhi(ug.x); gz[2] = bflo(ug.y); gz[3] = bfhi(ug.y); gz[4] = bflo(ug.z); gz[5] = bfhi(ug.z); gz[6] = bflo(ug.w); gz[7] = bfhi(ug.w);
#pragma unroll
        for (int i = 0; i < 8; ++i) { o[i] = gz[i] * (w0[i] * p2[i] + w1[i] * p1[i] + w2[i] * cu[i]); p2[i] = p1[i]; p1[i] = cu[i]; }
        v4u w; w.x = pk2(o[0], o[1]); w.y = pk2(o[2], o[3]); w.z = pk2(o[4], o[5]); w.w = pk2(o[6], o[7]);
        *(v4u*)(Y + (size_t)t * DM + c) = w; }
}

constexpr int SP_LD = 136;
constexpr int SP_WL = 0, SP_VTL = 128 * SP_LD * 2, SP_MU = SP_VTL + 384 * SP_LD * 2, SP_RS = SP_MU + 512, SP_END = SP_RS + 512;
static_assert(SP_END <= MISC_OFF, "spatial LDS map");
__device__ __forceinline__ void spatial_unit(const bf16* VG, const bf16* UZ, const float* vst, const float* Wg, const float* bsg, const float* lng, const float* lnb, bf16* Y, int nb, int g, LAS unsigned char* lds, int tid) {
    LAS bf16* WL = (LAS bf16*)(lds + SP_WL); LAS bf16* VTL = (LAS bf16*)(lds + SP_VTL); LAS float* MU = (LAS float*)(lds + SP_MU); LAS float* RS = (LAS float*)(lds + SP_RS);
    const int lane = tid & 63, wave = __builtin_amdgcn_readfirstlane(tid >> 6), fr = lane & 15, fq = lane >> 4;
    if (tid < 128) { const float* q = vst + (size_t)(128 * nb + tid) * 96; float s1 = 0.f, s2 = 0.f;
#pragma unroll 8
        for (int k = 0; k < 48; ++k) { s1 += q[2 * k]; s2 += q[2 * k + 1]; }
        const float mu = s1 * (1.0f / BRW), var = s2 * (1.0f / BRW) - mu * mu; MU[tid] = mu; RS[tid] = 1.0f / sqrtf(var + LNORM_EPS); }
    { const int t = tid >> 2, s0 = (tid & 3) * 32;
#pragma unroll
        for (int q = 0; q < 4; ++q) { const int sb = s0 + 8 * q; const f32x4 a = *(const f32x4*)(Wg + t * 128 + sb), b = *(const f32x4*)(Wg + t * 128 + sb + 4);
            float v[8] = {a[0], a[1], a[2], a[3], b[0], b[1], b[2], b[3]};
#pragma unroll
            for (int e = 0; e < 8; ++e) v[e] = (sb + e <= t) ? v[e] : 0.f;
            v4u o; o.x = pk2(v[0], v[1]); o.y = pk2(v[2], v[3]); o.z = pk2(v[4], v[5]); o.w = pk2(v[6], v[7]);
            *(LAS v4u*)(WL + t * SP_LD + sb) = o; } }
    __syncthreads();
    { const int s = (lane & 31) + 32 * (wave & 3); const float mu = MU[s], rs = RS[s];
#pragma unroll 4
        for (int it = 0; it < 12; ++it) { const int c = 8 * ((lane >> 5) + 2 * (wave >> 2) + 4 * it);
            const v4u u = *(const v4u*)(VG + (size_t)(128 * nb + s) * BRW + 384 * g + c);
            const f32x4 g0 = *(const f32x4*)(lng + 384 * g + c), g1 = *(const f32x4*)(lng + 384 * g + c + 4), b0 = *(const f32x4*)(lnb + 384 * g + c), b1 = *(const f32x4*)(lnb + 384 * g + c + 4);
            float v[8] = {bflo(u.x), bfhi(u.x), bflo(u.y), bfhi(u.y), bflo(u.z), bfhi(u.z), bflo(u.w), bfhi(u.w)};
#pragma unroll
            for (int e = 0; e < 8; ++e) { const float gg = e < 4 ? g0[e & 3] : g1[e & 3], bb = e < 4 ? b0[e & 3] : b1[e & 3]; VTL[(c + e) * SP_LD + s] = (bf16)f2bf((v[e] - mu) * rs * gg + bb); } } }
    __syncthreads();
    const int th = wave >> 2, d0w = 96 * (wave & 3);
    f32x4 acc[4][3][2];
#pragma unroll
    for (int i = 0; i < 4; ++i)
#pragma unroll
        for (int dp = 0; dp < 3; ++dp) { acc[i][dp][0] = (f32x4){0.f, 0.f, 0.f, 0.f}; acc[i][dp][1] = (f32x4){0.f, 0.f, 0.f, 0.f}; }
#pragma unroll
    for (int i = 0; i < 4; ++i) { const int tb = th ? ((i == 0) ? 1 : (i == 1) ? 2 : (i == 2) ? 5 : 6) : ((i == 0) ? 0 : (i == 1) ? 3 : (i == 2) ? 4 : 7); const int kmax = tb >> 1;
#pragma unroll
        for (int ks = 0; ks < 4; ++ks) if (ks <= kmax) {
            const bf16x8 bw = *(const LAS bf16x8*)(WL + (16 * tb + fr) * SP_LD + 32 * ks + 8 * fq);
#pragma unroll
            for (int dp = 0; dp < 3; ++dp)
#pragma unroll
                for (int e = 0; e < 2; ++e) { const bf16x8 av = *(const LAS bf16x8*)(VTL + (d0w + 32 * dp + 8 * (fr >> 2) + 4 * e + (fr & 3)) * SP_LD + 32 * ks + 8 * fq);
                    acc[i][dp][e] = __builtin_amdgcn_mfma_f32_16x16x32_bf16(av, bw, acc[i][dp][e], 0, 0, 0); } } }
#pragma unroll
    for (int i = 0; i < 4; ++i) { const int tb = th ? ((i == 0) ? 1 : (i == 1) ? 2 : (i == 2) ? 5 : 6) : ((i == 0) ? 0 : (i == 1) ? 3 : (i == 2) ? 4 : 7);
        const int tl = 16 * tb + fr; const float bs = bsg[tl]; const size_t row = (size_t)(128 * nb + tl);
#pragma unroll
        for (int dp = 0; dp < 3; ++dp) { const int d = 384 * g + d0w + 32 * dp + 8 * fq; const v4u u = *(const v4u*)(UZ + row * BRW + d);
            const f32x4 f0 = acc[i][dp][0] + bs, f1 = acc[i][dp][1] + bs;
            v4u w; w.x = pk2(bflo(u.x) * f0[0], bfhi(u.x) * f0[1]); w.y = pk2(bflo(u.y) * f0[2], bfhi(u.y) * f0[3]); w.z = pk2(bflo(u.z) * f1[0], bfhi(u.z) * f1[1]); w.w = pk2(bflo(u.w) * f1[2], bfhi(u.w) * f1[3]);
            *(v4u*)(Y + row * DM + d) = w; } }
    __syncthreads();
}

__device__ __forceinline__ void p4_rows(const bf16* YO, const float* yss, const float* gpost, bf16* XB, bf16* HN, float* out, bool last, int gw, int NGW, int lane) {
    for (int m = gw; m < SEQ; m += NGW) {
        const float tot = wave_sum(yss[(size_t)m * 64 + lane]); const float rsy = 1.0f / sqrtf(tot * (1.0f / DM) + RMS_EPS);
        float ss = 0.f; float xn[8][8];
#pragma unroll
        for (int i = 0; i < 8; ++i) { const int col = 512 * i + 8 * lane;
            const v4u yo = *(const v4u*)(YO + (size_t)m * DM + col), xb = *(const v4u*)(XB + (size_t)m * DM + col); const f32x4 g0 = *(const f32x4*)(gpost + col), g1 = *(const f32x4*)(gpost + col + 4);
            xn[i][0] = bflo(xb.x) + bflo(yo.x) * rsy * g0[0]; xn[i][1] = bfhi(xb.x) + bfhi(yo.x) * rsy * g0[1]; xn[i][2] = bflo(xb.y) + bflo(yo.y) * rsy * g0[2]; xn[i][3] = bfhi(xb.y) + bfhi(yo.y) * rsy * g0[3];
            xn[i][4] = bflo(xb.z) + bflo(yo.z) * rsy * g1[0]; xn[i][5] = bfhi(xb.z) + bfhi(yo.z) * rsy * g1[1]; xn[i][6] = bflo(xb.w) + bflo(yo.w) * rsy * g1[2]; xn[i][7] = bfhi(xb.w) + bfhi(yo.w) * rsy * g1[3];
#pragma unroll
            for (int e = 0; e < 8; ++e) ss += xn[i][e] * xn[i][e];
            if (last) { *(f32x4*)(out + (size_t)m * DM + col) = (f32x4){xn[i][0], xn[i][1], xn[i][2], xn[i][3]}; *(f32x4*)(out + (size_t)m * DM + col + 4) = (f32x4){xn[i][4], xn[i][5], xn[i][6], xn[i][7]}; }
            else { v4u w; w.x = pk2(xn[i][0], xn[i][1]); w.y = pk2(xn[i][2], xn[i][3]); w.z = pk2(xn[i][4], xn[i][5]); w.w = pk2(xn[i][6], xn[i][7]); *(v4u*)(XB + (size_t)m * DM + col) = w; } }
        if (!last) { ss = wave_sum(ss); const float rs = 1.0f / sqrtf(ss * (1.0f / DM) + RMS_EPS);
#pragma unroll
            for (int i = 0; i < 8; ++i) { const int col = 512 * i + 8 * lane;
                v4u w; w.x = pk2(xn[i][0] * rs, xn[i][1] * rs); w.y = pk2(xn[i][2] * rs, xn[i][3] * rs); w.z = pk2(xn[i][4] * rs, xn[i][5] * rs); w.w = pk2(xn[i][6] * rs, xn[i][7] * rs); *(v4u*)(HN + (size_t)m * DM + col) = w; } }
    }
}

__global__ void __launch_bounds__(NWAVES * 64, 2) mk_fwd(Args args) {
    extern __shared__ __attribute__((aligned(16))) unsigned char lds_raw[];
    LAS unsigned char* lds = (LAS unsigned char*)lds_raw;
    const int G = gridDim.x, NGW = G * NWAVES;
    unsigned char* ws = args.ws;
    const int lo = args.ph_lo, hi = args.ph_hi;
    if (threadIdx.x < 32) ((LAS unsigned*)(lds + MISC_OFF))[threadIdx.x] = 0u;
    __syncthreads();
    XcdBarrier bar; bar.bar = (unsigned*)(ws + WS_CTL) + CW_BAR; bar.x = 0; bar.st = (volatile LAS unsigned*)(lds + MISC_OFF);
    if (hi - lo > 1) bar = xcd_barrier_post((unsigned*)(ws + WS_CTL) + CW_BAR, (volatile LAS unsigned*)(lds + MISC_OFF));
#define IN(k) (lo <= (k) && (k) < hi)
#define OPAQUE_IDS() int tid_ = threadIdx.x; asm volatile("" : "+v"(tid_)); const int tid = tid_, lane = tid & 63, wave = __builtin_amdgcn_readfirstlane(tid >> 6); int bx_ = blockIdx.x; asm volatile("" : "+s"(bx_)); const int gw = bx_ * NWAVES + wave; (void)gw; (void)lane
#define SEAM(k) do { if (IN(k) && IN((k) + 1)) for (int rb_ = 0; rb_ < REP_BAR; ++rb_) xcd_barrier(bar); } while (0)

    bf16* const XB = (bf16*)(ws + WS_XB); bf16* const A1 = (bf16*)(ws + WS_A1); bf16* const A2 = (bf16*)(ws + WS_A2); bf16* const QB = (bf16*)(ws + WS_Q); bf16* const SZ = (bf16*)(ws + WS_SZ);
    bf16* const YB = (bf16*)(ws + WS_Y); bf16* const YO = (bf16*)(ws + WS_YO); bf16* const KVB = (bf16*)(ws + WS_KV);
    float* const VST = (float*)(ws + WS_VST); float* const YSS = (float*)(ws + WS_YSS); bf16* const HN = (bf16*)(ws + WS_HN);

    if (IN(0)) { for (int rep = 0; rep < REP_P0; ++rep) { OPAQUE_IDS(); p0_convert(args, ws, lds, gw, NGW, wave, lane); } }
    SEAM(0);
    if (IN(1)) for (int rep = 0; rep < REP_KV; ++rep) {
        pg8::Gemm g{(const bf16*)(ws + WS_MEMB), (const bf16*)(ws + WS_WKV), NMEM, DEPTH * NKV, DM}; pg8::StaticOrder S; S.init(NMEM, DEPTH * NKV, G, (int)blockIdx.x);
        pg8::EpiKV E{KVB};
        pg8::gemm_phase<pg8::EpiKV, pg8::StaticOrder, true, true>(lds, g, S, E);
    }
    SEAM(1);
    for (int L = 0; L < DEPTH; ++L) {
        const int k0 = 2 + 4 * L, gm = L & 1, jj = L >> 1;
        if (IN(k0)) for (int rep = 0; rep < REP_P1; ++rep) {
            const size_t woff = (L == 0) ? WIN_OFF0 : (L == 1) ? WIN_OFF1 : (L == 2) ? WIN_OFF2 : WIN_OFF3; const int nin = gm ? NIN_GMLP : NIN_CONV;
            pg8::Gemm g{HN, (const bf16*)(ws + WS_WIN + woff), SEQ, nin, DM}; pg8::StaticOrder S; S.init(SEQ, nin, G, (int)blockIdx.x);
            pg8::EpiProj E{A1, VST, gm};
            pg8::gemm_phase<pg8::EpiProj, pg8::StaticOrder, true, true>(lds, g, S, E);
        }
        SEAM(k0);
        if (IN(k0 + 1)) for (int rep = 0; rep < REP_P2; ++rep) { OPAQUE_IDS();
            const bf16* Kl = KVB + (size_t)L * (2 * 256 * 1024); const bf16* VTl = Kl + 256 * 1024;
            if (gm) {
                const float* ws_w = args.in[12] + (size_t)jj * 8 * 128 * 128; const float* bs = args.in[13] + (size_t)jj * 8 * 128; const float* lng = args.in[10] + (size_t)jj * BRW; const float* lnb = args.in[11] + (size_t)jj * BRW;
                for (int un = bx_; un < 1024; un += G) { const int nb = un >> 3, gg = un & 7;
                    spatial_unit(A2, A1, VST, ws_w + (size_t)gg * 128 * 128, bs + gg * 128, lng, lnb, YB, nb, gg, lds, tid); }
            } else {
                const float* cw = args.in[8] + (size_t)jj * 3 * BRW;
                for (int task = gw; task < 512 * 6; task += NGW) conv_task(A1, A2, cw, YB, task, lane);
            }
            for (int task = bx_; task < (SEQ / 256) * NHEAD; task += G) attn_wg(QB, SZ, Kl, VTl, YB, task >> 2, task & 3, lds, tid);
        }
        SEAM(k0 + 1);
        if (IN(k0 + 2)) for (int rep = 0; rep < REP_P3; ++rep) {
            pg8::Gemm g{YB, (const bf16*)(ws + WS_WOUT) + (size_t)L * DM * DM, SEQ, DM, DM}; pg8::StaticOrder S; S.init(SEQ, DM, G, (int)blockIdx.x);
            pg8::EpiOut E{YO, YSS};
            pg8::gemm_phase<pg8::EpiOut, pg8::StaticOrder, true, true>(lds, g, S, E);
        }
        SEAM(k0 + 2);
        if (IN(k0 + 3)) { OPAQUE_IDS(); p4_rows(YO, YSS, args.in[3] + (size_t)L * DM, XB, HN, args.out, L == DEPTH - 1, gw, NGW, lane); }
        if (L < DEPTH - 1) SEAM(k0 + 3);
    }
#undef IN
#undef SEAM
}

extern "C" void kernel_launch(void* const* d_in, const int* in_sizes, int n_in, void* d_out, int out_size, void* d_ws, size_t ws_size, hipStream_t stream) {
    static int grid = 0;
    if (grid == 0) {
        if (n_in != 14 || in_sizes[0] != SEQ * DM || out_size != SEQ * DM || ws_size < WS_END) { fprintf(stderr, "kernel_launch: unexpected shapes / workspace (n_in %d, in0 %d, out %d, ws %zu, need %zu); nothing launched\n", n_in, n_in > 0 ? in_sizes[0] : -1, out_size, ws_size, (size_t)WS_END); grid = -1; return; }
        int dev = 0, cus = 0, per_cu = 0;
        if (hipGetDevice(&dev) != hipSuccess || hipDeviceGetAttribute(&cus, hipDeviceAttributeMultiprocessorCount, dev) != hipSuccess) { grid = -1; return; }
        if (hipFuncSetAttribute((const void*)mk_fwd, hipFuncAttributeMaxDynamicSharedMemorySize, LDS_BYTES) != hipSuccess) { fprintf(stderr, "kernel_launch: hipFuncSetAttribute failed\n"); grid = -1; return; }
        if (hipOccupancyMaxActiveBlocksPerMultiprocessor(&per_cu, (const void*)mk_fwd, NWAVES * 64, LDS_BYTES) != hipSuccess || per_cu < 1) { fprintf(stderr, "kernel_launch: occupancy query says %d\n", per_cu); }
        (void)hipGetLastError();
        grid = cus;
    }
    if (grid < 0) return;
    if (hipMemsetAsync((char*)d_ws + WS_CTL, 0, CTL_ZERO_BYTES, stream) != hipSuccess) return;
    Args a{};
    for (int i = 0; i < 14; ++i) a.in[i] = (const float*)d_in[i];
    a.out = (float*)d_out; a.ws = (unsigned char*)d_ws;
#if MK_ONE_LAUNCH
    a.ph_lo = 0; a.ph_hi = NPHASE;
    hipLaunchKernelGGL(mk_fwd, dim3(grid), dim3(NWAVES * 64), LDS_BYTES, stream, a);
#else
    for (int k = 0; k < NPHASE; ++k) { a.ph_lo = k; a.ph_hi = k + 1; hipLaunchKernelGGL(mk_fwd, dim3(grid), dim3(NWAVES * 64), LDS_BYTES, stream, a); }
#endif
}
```

```cpp
#include <hip/hip_runtime.h>
#include <cstdio>
#include <cstdint>
namespace pg8 {
#define PG8_LAS __attribute__((address_space(3)))
typedef unsigned short bf16_t;
typedef short bf16x8 __attribute__((ext_vector_type(8)));
typedef float f32x4 __attribute__((ext_vector_type(4)));
typedef unsigned u32x4 __attribute__((ext_vector_type(4)));
constexpr int BM = 256, BK = 64, HALF = 128, HTB = HALF * BK * 2  , STAGE_BYTES = 8 * HTB, NXCD = 8, WGM = 8;

__host__ __device__ __forceinline__ int lds_byte(int r, int c) { const int st = (r >> 4) * 2 + (c >> 5), rr = r & 15, cc = c & 31, ob = rr * 64 + cc * 2; return st * 1024 + (ob ^ (((ob >> 9) & 1) << 5)); }
__host__ __device__ __forceinline__ void stage_rc(int b, int& R, int& C) { const int st = b / 1024, sb = b % 1024, swz = sb ^ (((sb >> 9) & 1) << 5); R = (st >> 1) * 16 + swz / 64; C = (st & 1) * 32 + (swz % 64) / 2; }
__host__ __device__ __forceinline__ int perm32(int rho) { const int n = rho >> 4, i = rho & 15; return 8 * (i >> 2) + 4 * n + (i & 3); }

struct Unit { int pm, pn; };
struct Gemm { const bf16_t* A; const bf16_t* Bt; int M, N, K; };

struct StaticOrder {
    int nM, nN, nwg, G, c;
    __host__ __device__ void init(int M, int N, int G_, int c_) { nM = M / BM; nN = N / BM; nwg = nM * nN; G = G_; c = c_; }
    __host__ __device__ bool next(int i, Unit& u) const {
        const long L = (long)i * G + c; if (L >= nwg) return false;
        int wgid = (int)L; { const int q = nwg / NXCD, r = nwg % NXCD, xcd = wgid % NXCD, off = wgid / NXCD; wgid = (xcd < r ? xcd * (q + 1) : r * (q + 1) + (xcd - r) * q) + off; }
        const int nig = WGM * nN, gid = wgid / nig, fm = gid * WGM, gsz = (nM - fm) < WGM ? (nM - fm) : WGM;
        u.pm = fm + ((wgid % nig) % gsz); u.pn = (wgid % nig) / gsz; return true;
    }
    __device__ __forceinline__ void a_ready(const Unit&) const {}
    __device__ __forceinline__ void done(const Unit&) const {}
    __device__ __forceinline__ int apm(const Unit& u) const { return u.pm; }
    __device__ __forceinline__ int bpn(const Unit& u) const { return u.pn; }
};
struct FakeOrder : StaticOrder {
    __device__ __forceinline__ int apm(const Unit&) const { return 0; }
    __device__ __forceinline__ int bpn(const Unit&) const { return 0; }
};


__device__ __forceinline__ unsigned cvt_pk_bf16(float lo, float hi) { unsigned r; asm("v_cvt_pk_bf16_f32 %0, %1, %2" : "=v"(r) : "v"(lo), "v"(hi)); return r; }
__device__ __forceinline__ float silu_f(float z) { return z * __builtin_amdgcn_rcpf(1.0f + __builtin_amdgcn_exp2f(-1.44269504f * z)); }
__device__ __forceinline__ float gelu_f(float x) { const float u = x * (0.7978845608f + 0.0356774081f * x * x); return x * __builtin_amdgcn_rcpf(1.0f + __builtin_amdgcn_exp2f(-2.88539008f * u)); }
__device__ __forceinline__ unsigned short f2bf1(float f) { unsigned u = __builtin_bit_cast(unsigned, f); return (unsigned short)((u + 0x7fffu + ((u >> 16) & 1u)) >> 16); }

struct EpiProj {
    static constexpr bool PERM = false, AFTER_DRAIN = false;
    bf16_t* base; float* vst; int gm;
    static constexpr size_t OFF_A2 = (size_t)48 << 20, OFF_Q = (size_t)96 << 20, OFF_SZ = (size_t)112 << 20;
    __device__ __forceinline__ void operator()(const f32x4 (&acc)[2][2][4][2], const Unit& u, int wr, int wc, int fr, int fq) const {
        asm volatile("" : "+v"(fr), "+v"(fq));
        const int pn = u.pn; int kind, p;
        if (gm == 0) { if (pn < 24) { kind = 0; p = pn; } else if (pn < 48) { kind = 1; p = pn - 24; } else if (pn < 52) { kind = 3; p = pn - 48; } else { kind = 4; p = pn - 52; } }
        else         { if (pn < 24) { kind = 2; p = pn; } else if (pn < 36) { kind = 5; p = pn - 24; } else if (pn < 40) { kind = 3; p = pn - 36; } else { kind = 4; p = pn - 40; } }
        const int row0 = u.pm * BM + wr * 64 + fr;
        if (kind <= 2) {
            bf16_t* O = base + ((kind == 1) ? OFF_A2 : (size_t)0); const int col0 = 128 * p + 32 * wc + 8 * fq;
#pragma unroll
            for (int ai = 0; ai < 2; ++ai)
#pragma unroll
                for (int m = 0; m < 4; ++m) { const int r = row0 + ai * HALF + m * 16;
                    f32x4 o[2];
#pragma unroll
                    for (int n = 0; n < 2; ++n) { const f32x4 a = acc[ai][0][m][n], b = acc[ai][1][m][n];
#pragma unroll
                        for (int j = 0; j < 4; ++j) o[n][j] = (kind == 0) ? a[j] * silu_f(b[j]) : (kind == 1) ? a[j] * b[j] : gelu_f(a[j]) * silu_f(b[j]); }
                    u32x4 w; w.x = cvt_pk_bf16(o[0][0], o[0][1]); w.y = cvt_pk_bf16(o[0][2], o[0][3]); w.z = cvt_pk_bf16(o[1][0], o[1][1]); w.w = cvt_pk_bf16(o[1][2], o[1][3]);
                    *(u32x4*)(O + (size_t)r * 3072 + col0) = w; }
        } else {
            bf16_t* O = base + ((kind == 3) ? OFF_Q : (kind == 4) ? OFF_SZ : OFF_A2); const int ldo = (kind == 5) ? 3072 : 1024; const int col0 = 256 * p + 32 * wc + 8 * fq;
#pragma unroll
            for (int ai = 0; ai < 2; ++ai)
#pragma unroll
                for (int m = 0; m < 4; ++m) { const int r = row0 + ai * HALF + m * 16; float s1 = 0.f, s2 = 0.f;
#pragma unroll
                    for (int bj = 0; bj < 2; ++bj) { f32x4 o[2];
#pragma unroll
                        for (int n = 0; n < 2; ++n) { const f32x4 a = acc[ai][bj][m][n];
#pragma unroll
                            for (int j = 0; j < 4; ++j) { const float v = (kind == 3) ? a[j] * 0.0625f : (kind == 4) ? silu_f(a[j]) : gelu_f(a[j]); o[n][j] = v; s1 += v; s2 += v * v; } }
                        u32x4 w; w.x = cvt_pk_bf16(o[0][0], o[0][1]); w.y = cvt_pk_bf16(o[0][2], o[0][3]); w.z = cvt_pk_bf16(o[1][0], o[1][1]); w.w = cvt_pk_bf16(o[1][2], o[1][3]);
                        *(u32x4*)(O + (size_t)r * ldo + col0 + bj * HALF) = w; }
                    if (kind == 5) { s1 += __shfl_xor(s1, 16); s1 += __shfl_xor(s1, 32); s2 += __shfl_xor(s2, 16); s2 += __shfl_xor(s2, 32);
                        if (fq == 0) { float* q = vst + ((size_t)r * 48 + p * 4 + wc) * 2; q[0] = s1; q[1] = s2; } } }
        }
    }
};
struct EpiOut {
    static constexpr bool PERM = false, AFTER_DRAIN = false;
    bf16_t* YO; float* yss;
    __device__ __forceinline__ void operator()(const f32x4 (&acc)[2][2][4][2], const Unit& u, int wr, int wc, int fr, int fq) const {
        asm volatile("" : "+v"(fr), "+v"(fq));
        const int row0 = u.pm * BM + wr * 64 + fr, col0 = 256 * u.pn + 32 * wc + 8 * fq;
#pragma unroll
        for (int ai = 0; ai < 2; ++ai)
#pragma unroll
            for (int m = 0; m < 4; ++m) { const int r = row0 + ai * HALF + m * 16; float ss = 0.f;
#pragma unroll
                for (int bj = 0; bj < 2; ++bj) { const f32x4 a = acc[ai][bj][m][0], b = acc[ai][bj][m][1];
                    ss += (a[0] * a[0] + a[1] * a[1]) + (a[2] * a[2] + a[3] * a[3]) + (b[0] * b[0] + b[1] * b[1]) + (b[2] * b[2] + b[3] * b[3]);
                    u32x4 w; w.x = cvt_pk_bf16(a[0], a[1]); w.y = cvt_pk_bf16(a[2], a[3]); w.z = cvt_pk_bf16(b[0], b[1]); w.w = cvt_pk_bf16(b[2], b[3]);
                    *(u32x4*)(YO + (size_t)r * 4096 + col0 + bj * HALF) = w; }
                ss += __shfl_xor(ss, 16); ss += __shfl_xor(ss, 32);
                if (fq == 0) yss[(size_t)r * 64 + u.pn * 4 + wc] = ss; }
    }
};
struct EpiKV {
    static constexpr bool PERM = false, AFTER_DRAIN = false;
    bf16_t* KV;
    __device__ __forceinline__ void operator()(const f32x4 (&acc)[2][2][4][2], const Unit& u, int wr, int wc, int fr, int fq) const {
        asm volatile("" : "+v"(fr), "+v"(fq));
        const int l = u.pn >> 3, t = u.pn & 7; bf16_t* base = KV + (size_t)l * (2 * 256 * 1024); const int row0 = wr * 64 + fr;
#pragma unroll
        for (int ai = 0; ai < 2; ++ai)
#pragma unroll
            for (int m = 0; m < 4; ++m) { const int r = row0 + ai * HALF + m * 16;
#pragma unroll
                for (int bj = 0; bj < 2; ++bj) { const f32x4 a = acc[ai][bj][m][0], b = acc[ai][bj][m][1];
                    if (t < 4) { u32x4 w; w.x = cvt_pk_bf16(a[0], a[1]); w.y = cvt_pk_bf16(a[2], a[3]); w.z = cvt_pk_bf16(b[0], b[1]); w.w = cvt_pk_bf16(b[2], b[3]);
                        *(u32x4*)(base + (size_t)r * 1024 + 256 * t + bj * HALF + 32 * wc + 8 * fq) = w; }
                    else { bf16_t* vt = base + 256 * 1024 + (size_t)(256 * (t - 4) + bj * HALF + 32 * wc + 8 * fq) * 256 + r;
#pragma unroll
                        for (int j = 0; j < 4; ++j) { vt[(size_t)j * 256] = f2bf1(a[j]); vt[(size_t)(4 + j) * 256] = f2bf1(b[j]); } } } }
    }
};
template <class Epi, class Sched, bool ALIGN_EPI = false, bool SP2 = false>
__device__ __forceinline__ void gemm_phase(PG8_LAS unsigned char* lds, const Gemm g, const Sched& S, const Epi& E) {
    int tid_ = threadIdx.x; asm volatile("" : "+v"(tid_));
    const int tid = tid_, wid = __builtin_amdgcn_readfirstlane(tid >> 6), lane = tid & 63, wr = wid >> 2, wc = wid & 3, fr = lane & 15, fq = lane >> 4;
    const int K = g.K, nt = K / BK;
    unsigned voffA[2], voffB[2];
#pragma unroll
    for (int i = 0; i < 2; ++i) { int R, C; stage_rc(tid * 16 + i * 8192, R, C); const int Rb = Epi::PERM ? ((R & ~31) + perm32(R & 31)) : R;
        voffA[i] = (unsigned)(R * K + C) * 2u; voffB[i] = (unsigned)(Rb * K + C) * 2u; }
    const size_t kstep = (size_t)(BK * 2);
    const size_t hstep = (size_t)HALF * K * 2;
    const size_t tstep = 2 * hstep;
    const unsigned ldsw = (unsigned)wid * 1024u;
    const int aoff = lds_byte(wr * 64 + fr, fq * 8), boff = lds_byte(wc * 32 + fr, fq * 8);
#define PG8_SA(b, h) (((b) * 2 + (h)) * HTB)
#define PG8_SB(b, h) ((4 + (b) * 2 + (h)) * HTB)
#define PG8_STAGE(bufoff, gbase, voff) do { _Pragma("unroll") for (int _i = 0; _i < 2; ++_i) \
        __builtin_amdgcn_global_load_lds((const unsigned*)((const char*)(gbase) + (voff)[_i]), (PG8_LAS unsigned*)(lds + (bufoff) + ldsw + _i * 8192), 16, 0, 0); } while (0)
#define PG8_LDA(dst, b, h) do { _Pragma("unroll") for (int m = 0; m < 4; ++m) _Pragma("unroll") for (int k = 0; k < 2; ++k) dst[m][k] = *(const PG8_LAS bf16x8*)(lds + PG8_SA(b, h) + aoff + m * 2048 + k * 1024); } while (0)
#define PG8_LDB(dst, b, h) do { _Pragma("unroll") for (int n = 0; n < 2; ++n) _Pragma("unroll") for (int k = 0; k < 2; ++k) dst[n][k] = *(const PG8_LAS bf16x8*)(lds + PG8_SB(b, h) + boff + n * 2048 + k * 1024); } while (0)
#define PG8_MMA(ai, bj, At, Bt) do { __builtin_amdgcn_s_setprio(1); _Pragma("unroll") for (int m = 0; m < 4; ++m) _Pragma("unroll") for (int n = 0; n < 2; ++n) _Pragma("unroll") for (int k = 0; k < 2; ++k) \
        acc[ai][bj][m][n] = __builtin_amdgcn_mfma_f32_16x16x32_bf16(Bt[n][k], At[m][k], acc[ai][bj][m][n], 0, 0, 0); __builtin_amdgcn_s_setprio(0); } while (0)
#define PG8_WAIT_V(n) asm volatile("s_waitcnt vmcnt(" #n ")" ::: "memory")
#define PG8_WAIT_L(n) asm volatile("s_waitcnt lgkmcnt(" #n ")" ::: "memory")
#define PG8_BAR __builtin_amdgcn_s_barrier()
#define PG8_SCHED __builtin_amdgcn_sched_barrier(0)
    Unit cur, nxt; int ui = 0;
    if (!S.next(0, cur)) return;
    f32x4 acc[2][2][4][2];
#pragma unroll
    for (int a = 0; a < 2; ++a)
#pragma unroll
        for (int b = 0; b < 2; ++b)
#pragma unroll
            for (int m = 0; m < 4; ++m)
#pragma unroll
                for (int n = 0; n < 2; ++n) acc[a][b][m][n] = (f32x4){0.f, 0.f, 0.f, 0.f};
    bf16x8 At[4][2], B0[2][2], B1[2][2];
    const char* cA = (const char*)g.A + (size_t)S.apm(cur) * tstep; const char* cB = (const char*)g.Bt + (size_t)S.bpn(cur) * tstep;
    S.a_ready(cur);
    if constexpr (SP2) {
        PG8_STAGE(PG8_SB(0, 0), cB, voffB); PG8_STAGE(PG8_SB(0, 1), cB + hstep, voffB); PG8_STAGE(PG8_SA(0, 0), cA, voffA); PG8_STAGE(PG8_SA(0, 1), cA + hstep, voffA);
        if (wr == 1) PG8_BAR;
        PG8_WAIT_V(2); PG8_BAR;
        PG8_STAGE(PG8_SB(1, 0), cB + kstep, voffB); PG8_STAGE(PG8_SA(1, 0), cA + kstep, voffA); PG8_STAGE(PG8_SB(1, 1), cB + hstep + kstep, voffB);
        PG8_WAIT_V(6); PG8_BAR;
    } else {
        PG8_STAGE(PG8_SB(0, 0), cB, voffB); PG8_STAGE(PG8_SA(0, 0), cA, voffA); PG8_STAGE(PG8_SB(0, 1), cB + hstep, voffB); PG8_STAGE(PG8_SA(0, 1), cA + hstep, voffA);
        if (wr == 1) PG8_BAR;
        PG8_WAIT_V(4); PG8_BAR;
        PG8_STAGE(PG8_SB(1, 0), cB + kstep, voffB); PG8_STAGE(PG8_SA(1, 0), cA + kstep, voffA); PG8_STAGE(PG8_SB(1, 1), cB + hstep + kstep, voffB);
        PG8_WAIT_V(6); PG8_BAR;
    }
    for (;;) {
        const bool has_next = S.next(ui + 1, nxt);
        const char* nA = has_next ? (const char*)g.A + (size_t)S.apm(nxt) * tstep : cA; const char* nB = has_next ? (const char*)g.Bt + (size_t)S.bpn(nxt) * tstep : cB;
        for (int t = 0; t < nt; t += 2) {
            const bool last = (t == nt - 2);
            const char* a1 = cA + (size_t)(t + 1) * kstep;
            const char* a2 = last ? nA : cA + (size_t)(t + 2) * kstep; const char* b2 = last ? nB : cB + (size_t)(t + 2) * kstep;
            const char* a3 = a2 + kstep; const char* b3 = b2 + kstep;
            if (last && has_next) S.a_ready(nxt);
            if constexpr (SP2) {
            PG8_LDB(B0, 0, 0); PG8_LDB(B1, 0, 1); PG8_SCHED; PG8_LDA(At, 0, 0); PG8_STAGE(PG8_SA(1, 1), a1 + hstep, voffA);
            PG8_WAIT_V(8); PG8_WAIT_L(0); PG8_BAR; PG8_MMA(0, 0, At, B0); PG8_MMA(0, 1, At, B1); PG8_BAR; PG8_SCHED;
            PG8_LDA(At, 0, 1); PG8_STAGE(PG8_SB(0, 0), b2, voffB); PG8_STAGE(PG8_SB(0, 1), b2 + hstep, voffB); PG8_STAGE(PG8_SA(0, 0), a2, voffA);
            PG8_WAIT_V(8); PG8_WAIT_L(0); PG8_BAR; PG8_MMA(1, 0, At, B0); PG8_MMA(1, 1, At, B1); PG8_BAR; PG8_SCHED;
            PG8_LDB(B0, 1, 0); PG8_LDB(B1, 1, 1); PG8_SCHED; PG8_LDA(At, 1, 0); PG8_STAGE(PG8_SA(0, 1), a2 + hstep, voffA);
            PG8_WAIT_V(8); PG8_WAIT_L(0); PG8_BAR; PG8_MMA(0, 0, At, B0); PG8_MMA(0, 1, At, B1); PG8_BAR; PG8_SCHED;
            PG8_LDA(At, 1, 1); PG8_STAGE(PG8_SB(1, 0), b3, voffB); PG8_STAGE(PG8_SB(1, 1), b3 + hstep, voffB); PG8_STAGE(PG8_SA(1, 0), a3, voffA);
            PG8_WAIT_V(8); PG8_WAIT_L(0); PG8_BAR; PG8_MMA(1, 0, At, B0); PG8_MMA(1, 1, At, B1); PG8_BAR; PG8_SCHED;
            } else {
            PG8_LDB(B0, 0, 0); PG8_SCHED; PG8_LDA(At, 0, 0); PG8_STAGE(PG8_SA(1, 1), a1 + hstep, voffA);
            PG8_WAIT_L(8); PG8_BAR; PG8_WAIT_L(0); PG8_MMA(0, 0, At, B0); PG8_BAR; PG8_SCHED;
            PG8_LDB(B1, 0, 1); PG8_STAGE(PG8_SB(0, 0), b2, voffB);
            PG8_BAR; PG8_WAIT_L(0); PG8_MMA(0, 1, At, B1); PG8_BAR;
            PG8_LDA(At, 0, 1); PG8_STAGE(PG8_SA(0, 0), a2, voffA);
            PG8_BAR; PG8_WAIT_L(0); PG8_MMA(1, 0, At, B0); PG8_BAR; PG8_SCHED;
            PG8_STAGE(PG8_SB(0, 1), b2 + hstep, voffB);
            PG8_WAIT_V(6); PG8_BAR; PG8_MMA(1, 1, At, B1); PG8_BAR;
            PG8_LDB(B0, 1, 0); PG8_SCHED; PG8_LDA(At, 1, 0); PG8_STAGE(PG8_SA(0, 1), a2 + hstep, voffA);
            PG8_WAIT_L(8); PG8_BAR; PG8_WAIT_L(0); PG8_MMA(0, 0, At, B0); PG8_BAR; PG8_SCHED;
            PG8_LDB(B1, 1, 1); PG8_STAGE(PG8_SB(1, 0), b3, voffB);
            PG8_BAR; PG8_WAIT_L(0); PG8_MMA(0, 1, At, B1); PG8_BAR;
            PG8_LDA(At, 1, 1); PG8_STAGE(PG8_SA(1, 0), a3, voffA);
            PG8_BAR; PG8_WAIT_L(0); PG8_MMA(1, 0, At, B0); PG8_BAR; PG8_SCHED;
            PG8_STAGE(PG8_SB(1, 1), b3 + hstep, voffB);
            PG8_WAIT_V(6); PG8_BAR; PG8_MMA(1, 1, At, B1); PG8_BAR;
            }
        }
        if constexpr (ALIGN_EPI) { if (wr == 0) PG8_BAR; }
        if constexpr (!Epi::AFTER_DRAIN) { E(acc, cur, wr, wc, fr, fq); S.done(cur); }
        if (!has_next) break;
#pragma unroll
        for (int a = 0; a < 2; ++a)
#pragma unroll
            for (int b = 0; b < 2; ++b)
#pragma unroll
                for (int m = 0; m < 4; ++m)
#pragma unroll
                    for (int n = 0; n < 2; ++n) acc[a][b][m][n] = (f32x4){0.f, 0.f, 0.f, 0.f};
        cur = nxt; cA = nA; cB = nB; ++ui;
        if constexpr (ALIGN_EPI) { if (wr == 1) PG8_BAR; }
    }
    PG8_WAIT_V(0);
    if constexpr (!ALIGN_EPI) { if (wr == 0) PG8_BAR; }
    PG8_BAR;
    if constexpr (Epi::AFTER_DRAIN) { E.fused(acc, cur, wr, wc, fr, fq, lds, wid, lane); S.done(cur); }
#undef PG8_SA
#undef PG8_SB
#undef PG8_STAGE
#undef PG8_LDA
#undef PG8_LDB
#undef PG8_MMA
#undef PG8_WAIT_V
#undef PG8_WAIT_L
#undef PG8_BAR
#undef PG8_SCHED
}
}

constexpr int SEQ = 16384, DM = 4096, DEPTH = 4, NMEM = 256, BRW = 3072, MEMW = 1024, NHEAD = 4, HDIM = 256;
constexpr int NIN_CONV = 14336, NIN_GMLP = 11264, NKV = 2048;
constexpr float RMS_EPS = 1e-6f, LNORM_EPS = 1e-5f;
constexpr int NWAVES = 8;
#ifndef MK_ONE_LAUNCH
#define MK_ONE_LAUNCH 1
#endif
constexpr int NPHASE = 2 + 4 * DEPTH;
#ifndef REP_P0
#define REP_P0 1
#endif
#ifndef REP_P1
#define REP_P1 1
#endif
#ifndef REP_P2
#define REP_P2 1
#endif
#ifndef REP_P3
#define REP_P3 1
#endif
#ifndef REP_KV
#define REP_KV 1
#endif
#ifndef REP_BAR
#define REP_BAR 1
#endif
#ifndef GP_ALIGN
#define GP_ALIGN true
#endif
#ifndef GP_SP2
#define GP_SP2 true
#endif
#ifndef FAKE_P3
#define FAKE_P3 0
#endif
#ifndef REP_SYNC
#define REP_SYNC 0
#endif
#ifndef GRID_PER_LAYER
#define GRID_PER_LAYER 1
#endif

constexpr size_t MiB = 1u << 20;
constexpr size_t WS_CTL = 0, CTL_ZERO_BYTES = 1 * MiB;
constexpr size_t WS_WIN = 2 * MiB;
constexpr size_t WIN_OFF0 = 0, WIN_OFF1 = 112 * MiB, WIN_OFF2 = 200 * MiB, WIN_OFF3 = 312 * MiB;
constexpr size_t WS_WOUT = WS_WIN + 400 * MiB;
constexpr size_t WS_WKV = WS_WOUT + 128 * MiB;
constexpr size_t WS_MEMB = WS_WKV + 64 * MiB;
constexpr size_t WS_KV = WS_MEMB + 2 * MiB;
constexpr size_t WS_XB = WS_KV + 4 * MiB;
constexpr size_t WS_A1 = WS_XB + 128 * MiB;
constexpr size_t WS_A2 = WS_A1 + 96 * MiB;
constexpr size_t WS_Q = WS_A2 + 96 * MiB;
constexpr size_t WS_SZ = WS_Q + 32 * MiB;
constexpr size_t WS_Y = WS_SZ + 32 * MiB;
constexpr size_t WS_YO = WS_Y + 128 * MiB;
constexpr size_t WS_RSTD = WS_YO + 128 * MiB;
constexpr size_t WS_RSTDM = WS_RSTD + 1 * MiB;
constexpr size_t WS_VST = WS_RSTDM + 1 * MiB;
constexpr size_t WS_YSS = WS_VST + 6 * MiB;
constexpr size_t WS_HN = WS_YSS + 4 * MiB;
constexpr size_t WS_END = WS_HN + 128 * MiB;
static_assert(WS_A2 - WS_A1 == 2 * pg8::EpiProj::OFF_A2 && WS_Q - WS_A1 == 2 * pg8::EpiProj::OFF_Q && WS_SZ - WS_A1 == 2 * pg8::EpiProj::OFF_SZ, "EpiProj output offsets");
constexpr int CW_BAR = 4096;

constexpr int RING_BYTES = 131072;
constexpr int LDS_BYTES = 147456;
constexpr int MISC_OFF = LDS_BYTES - 128;

#define GAS __attribute__((address_space(1)))
#define LAS __attribute__((address_space(3)))
typedef unsigned short bf16;
typedef unsigned v4u __attribute__((ext_vector_type(4)));
typedef unsigned v2u __attribute__((ext_vector_type(2)));
typedef float f32x4 __attribute__((ext_vector_type(4)));
typedef short bf16x8 __attribute__((ext_vector_type(8)));
#define LDS_WAIT() asm volatile("s_waitcnt lgkmcnt(0)" ::: "memory")
__device__ __forceinline__ unsigned f2bf(float f) { unsigned u = __builtin_bit_cast(unsigned, f); return (u + 0x7fffu + ((u >> 16) & 1u)) >> 16; }
__device__ __forceinline__ unsigned pk2(float lo, float hi) { return pg8::cvt_pk_bf16(lo, hi); }
__device__ __forceinline__ float bflo(unsigned w) { return __builtin_bit_cast(float, w << 16); }
__device__ __forceinline__ float bfhi(unsigned w) { return __builtin_bit_cast(float, w & 0xffff0000u); }
__device__ __forceinline__ float wave_sum(float v) {
#pragma unroll
    for (int o = 1; o < 64; o <<= 1) v += __shfl_xor(v, o);
    return v;
}

#define XB_TMO      128
#define XB_XCNT(j)  (256  + 64 * (j))
#define XB_XSUB(j)  (1280 + 64 * (j))
#define XB_XGEN(j)  (2304 + 64 * (j))
#define XB_TOP      3328
#define XB_TOPGEN   3392
#define XCD_BAR_WORDS 3456
#define XB_SPIN_CAP (1u << 18)

__device__ __forceinline__ unsigned xb_ld(unsigned* p)              { return __hip_atomic_load(p, __ATOMIC_RELAXED, __HIP_MEMORY_SCOPE_AGENT); }
__device__ __forceinline__ unsigned xb_add(unsigned* p, unsigned v) { return __hip_atomic_fetch_add(p, v, __ATOMIC_RELAXED, __HIP_MEMORY_SCOPE_AGENT); }
__device__ __forceinline__ unsigned xb_xcc_id() { return (unsigned)__builtin_amdgcn_s_getreg((3 << 11) | 20) & 0xFu; }
#define XB_SPIN(cond, bar) do { unsigned _sp = 0; while (cond) { __builtin_amdgcn_s_sleep(1); \
    if ((++_sp & 255u) == 0u) { if (xb_ld(&(bar)[XB_TMO])) break; if (_sp > XB_SPIN_CAP) { atomicAdd(&(bar)[XB_TMO], 1u); break; } } } } while (0)

struct XcdBarrier {
    unsigned* bar; unsigned x;
    volatile LAS unsigned* st;
};
__device__ __forceinline__ XcdBarrier xcd_barrier_post(unsigned* bar, volatile LAS unsigned* st) {
    XcdBarrier b; b.bar = bar; b.x = xb_xcc_id(); b.st = st;
    if (threadIdx.x == 0) (void)xb_add(&bar[XB_XCNT(b.x)], 1u);
    return b;
}
__device__ __forceinline__ void xcd_barrier_complete(unsigned* bar, unsigned x, unsigned& nloc, unsigned& nx) {
    const unsigned G = gridDim.x * gridDim.y * gridDim.z;
    unsigned sum, cnt, mine, sp = 0u;
    for (;;) {
        sum = 0u; cnt = 0u; mine = 0u;
#pragma unroll
        for (unsigned j = 0; j < 16; ++j) { const unsigned c = xb_ld(&bar[XB_XCNT(j)]); sum += c; cnt += (c > 0u) ? 1u : 0u; mine = (j == x) ? c : mine; }
        if (sum == G) break;
        __builtin_amdgcn_s_sleep(1);
        if ((++sp & 255u) == 0u) { if (xb_ld(&bar[XB_TMO])) break; if (sp > XB_SPIN_CAP) { atomicAdd(&bar[XB_TMO], 1u); break; } }
    }
    nloc = mine > 0u ? mine : 1u; nx = cnt > 0u ? cnt : 1u;
}
__device__ __forceinline__ void xcd_barrier(const XcdBarrier& b) {
    asm volatile("s_waitcnt vmcnt(0)" ::: "memory");
    __syncthreads();
    if (threadIdx.x == 0) {
        unsigned* bar = b.bar;
        __builtin_amdgcn_s_waitcnt(0);
        unsigned nloc = b.st[0], nx = b.st[1];
        if (nloc == 0u) { xcd_barrier_complete(bar, b.x, nloc, nx); b.st[0] = nloc; b.st[1] = nx; }
        const unsigned old = xb_add(&bar[XB_XSUB(b.x)], 1u);
        const unsigned gen = old / nloc;
        if (old + 1u == (gen + 1u) * nloc) {
            __builtin_amdgcn_fence(__ATOMIC_RELEASE, "agent");
            asm volatile("s_waitcnt vmcnt(0)" ::: "memory");
            const unsigned og = xb_add(&bar[XB_TOP], 1u);
            const unsigned tg = og / nx;
            if (og + 1u == (tg + 1u) * nx) xb_add(&bar[XB_TOPGEN], 1u);
            else XB_SPIN(xb_ld(&bar[XB_TOPGEN]) == tg, bar);
            __builtin_amdgcn_fence(__ATOMIC_ACQUIRE, "agent");
            xb_add(&bar[XB_XGEN(b.x)], 1u);
            asm volatile("s_waitcnt vmcnt(0)" ::: "memory");
        } else {
            XB_SPIN(xb_ld(&bar[XB_XGEN(b.x)]) == gen, bar);
            __builtin_amdgcn_fence(__ATOMIC_ACQUIRE, "agent");
            asm volatile("s_waitcnt vmcnt(0)" ::: "memory");
        }
    }
    __syncthreads();
}

__device__ __forceinline__ int src32_conv(int gi) { const int pn = gi >> 3, bj = (gi >> 2) & 1, wc = gi & 3;
    if (pn < 24) return (bj ? 10240 : 0) + 128 * pn + 32 * wc;
    if (pn < 48) return (bj ? 6144 : 3072) + 128 * (pn - 24) + 32 * wc;
    if (pn < 52) return 9216 + 256 * (pn - 48) + 128 * bj + 32 * wc;
    return 13312 + 256 * (pn - 52) + 128 * bj + 32 * wc; }
__device__ __forceinline__ int src32_gmlp(int gi) { const int pn = gi >> 3, bj = (gi >> 2) & 1, wc = gi & 3;
    if (pn < 24) return (bj ? 7168 : 0) + 128 * pn + 32 * wc;
    if (pn < 36) return 3072 + 256 * (pn - 24) + 128 * bj + 32 * wc;
    if (pn < 40) return 6144 + 256 * (pn - 36) + 128 * bj + 32 * wc;
    return 10240 + 256 * (pn - 40) + 128 * bj + 32 * wc; }
__device__ __forceinline__ void cvt_item(const float* W, int N, int src32, const float* gk, bf16* WT, int slot0, int k0, LAS float* scr, int lane) {
#pragma unroll 8
    for (int i = 0; i < 32; ++i) { const int kk = 2 * i + (lane >> 5); scr[kk * 33 + (lane & 31)] = W[(size_t)(k0 + kk) * N + src32 + (lane & 31)]; }
    const int c = lane & 7;
    f32x4 g0 = (f32x4){1.f, 1.f, 1.f, 1.f}, g1 = g0;
    if (gk) { g0 = *(const f32x4*)(gk + k0 + 8 * c); g1 = *(const f32x4*)(gk + k0 + 8 * c + 4); }
    LDS_WAIT(); asm volatile("" ::: "memory");
#pragma unroll
    for (int j = 0; j < 4; ++j) { const int n = (lane >> 3) + 8 * j; const LAS float* s = scr + (8 * c) * 33 + pg8::perm32(n);
        v4u o; o.x = pk2(s[0 * 33] * g0[0], s[1 * 33] * g0[1]); o.y = pk2(s[2 * 33] * g0[2], s[3 * 33] * g0[3]); o.z = pk2(s[4 * 33] * g1[0], s[5 * 33] * g1[1]); o.w = pk2(s[6 * 33] * g1[2], s[7 * 33] * g1[3]);
        *(v4u*)(WT + (size_t)(slot0 + n) * DM + k0 + 8 * c) = o; }
    LDS_WAIT(); asm volatile("" ::: "memory");
}
__device__ __forceinline__ void row_to_bf16(const float* xr, float* rms_out  , bf16* nrow, int lane) {
    f32x4 v[16]; float ss = 0.f;
#pragma unroll
    for (int i = 0; i < 8; ++i) { const int col = 512 * i + 8 * lane; const f32x4 a = *(const f32x4*)(xr + col), b = *(const f32x4*)(xr + col + 4); v[2 * i] = a; v[2 * i + 1] = b;
        ss += (a[0] * a[0] + a[1] * a[1]) + (a[2] * a[2] + a[3] * a[3]) + (b[0] * b[0] + b[1] * b[1]) + (b[2] * b[2] + b[3] * b[3]); }
    ss = wave_sum(ss);
    const float rms = sqrtf(ss * (1.0f / DM) + RMS_EPS), rs = 1.0f / rms;
    if (rms_out && lane == 0) *rms_out = rms;
#pragma unroll
    for (int i = 0; i < 8; ++i) { const int col = 512 * i + 8 * lane; const f32x4 a = v[2 * i], b = v[2 * i + 1];
        v4u n; n.x = pk2(a[0] * rs, a[1] * rs); n.y = pk2(a[2] * rs, a[3] * rs); n.z = pk2(b[0] * rs, b[1] * rs); n.w = pk2(b[2] * rs, b[3] * rs); *(v4u*)(nrow + col) = n; }
}

struct Args { const float* in[14]; float* out; unsigned char* ws; int ph_lo, ph_hi; };

__device__ __forceinline__ void p0_convert(const Args& a, unsigned char* ws, LAS unsigned char* lds, int gw, int NGW, int wave, int lane) {
    LAS float* scr = (LAS float*)(lds + wave * 16384);
    const float* x = a.in[0]; const float* mem = a.in[1]; const float* pre_g = a.in[2]; const float* mem_g = a.in[4];
    const float* w_kv = a.in[5]; const float* w_out = a.in[6]; const float* conv_w_in = a.in[7]; const float* gmlp_w_in = a.in[9];
    constexpr int I_KV = 64 * (NKV / 32), I_OUT = 64 * (DM / 32), I_CONV = 64 * (NIN_CONV / 32), I_GMLP = 64 * (NIN_GMLP / 32);
    constexpr int NITEMS = 4 * I_KV + 4 * I_OUT + 2 * I_CONV + 2 * I_GMLP;
    for (int it = gw; it < NITEMS; it += NGW) {
        int r = it; const float* W; const float* gk; bf16* WT; int N, ng, type;
        if (r < 4 * I_KV) { const int l = r / I_KV; r -= l * I_KV; W = w_kv + (size_t)l * DM * NKV; N = NKV; ng = NKV / 32; type = 2; gk = mem_g + l * DM; WT = (bf16*)(ws + WS_WKV) + (size_t)l * NKV * DM; }
        else { r -= 4 * I_KV;
            if (r < 4 * I_OUT) { const int l = r / I_OUT; r -= l * I_OUT; W = w_out + (size_t)l * DM * DM; N = DM; ng = DM / 32; type = 2; gk = nullptr; WT = (bf16*)(ws + WS_WOUT) + (size_t)l * DM * DM; }
            else { r -= 4 * I_OUT;
                if (r < 2 * I_CONV) { const int j = r / I_CONV; r -= j * I_CONV; W = conv_w_in + (size_t)j * DM * NIN_CONV; N = NIN_CONV; ng = NIN_CONV / 32; type = 0; gk = pre_g + (2 * j) * DM; WT = (bf16*)(ws + WS_WIN + (j ? WIN_OFF2 : WIN_OFF0)); }
                else { r -= 2 * I_CONV; const int j = r / I_GMLP; r -= j * I_GMLP; W = gmlp_w_in + (size_t)j * DM * NIN_GMLP; N = NIN_GMLP; ng = NIN_GMLP / 32; type = 1; gk = pre_g + (2 * j + 1) * DM; WT = (bf16*)(ws + WS_WIN + (j ? WIN_OFF3 : WIN_OFF1)); } } }
        const int kb = r / ng, gi = r - kb * ng;
        const int s32 = (type == 0) ? src32_conv(gi) : (type == 1) ? src32_gmlp(gi) : 32 * gi;
        cvt_item(W, N, s32, gk, WT, 32 * gi, 64 * kb, scr, lane);
    }
    for (int m = gw; m < SEQ; m += NGW) row_to_bf16(x + (size_t)m * DM, (float*)(ws + WS_RSTD) + m, (bf16*)(ws + WS_HN) + (size_t)m * DM, lane);
    for (int m = gw; m < NMEM; m += NGW) row_to_bf16(mem + (size_t)m * DM, nullptr, (bf16*)(ws + WS_MEMB) + (size_t)m * DM, lane);
}

constexpr int AT_LD = 264;
static_assert(256 * AT_LD * 2 <= MISC_OFF, "attention LDS map");
__device__ __forceinline__ void attn_stage(const bf16* src, size_t row_pitch, LAS unsigned char* lds, int tid_in) {
    int tid = tid_in; asm volatile("" : "+v"(tid));
    const bf16* g = src + (size_t)(tid >> 5) * row_pitch + 8 * (tid & 31);
    LAS unsigned char* l = lds + (tid >> 5) * (AT_LD * 2) + 16 * (tid & 31);
    v4u r[16];
#pragma unroll
    for (int it = 0; it < 16; ++it) r[it] = *(const v4u*)(g + (size_t)(16 * it) * row_pitch);
#pragma unroll
    for (int it = 0; it < 16; ++it) *(LAS v4u*)(l + it * (16 * AT_LD * 2)) = r[it];
}
__device__ __forceinline__ void attn_wg(const bf16* Q, const bf16* SZ, const bf16* Kl, const bf16* VTl, bf16* Y, int pb, int h, LAS unsigned char* lds, int tid) {
    const int lane = tid & 63, wave = __builtin_amdgcn_readfirstlane(tid >> 6), fr = lane & 15, fq = lane >> 4;
    const int t0 = 256 * pb + 32 * wave;
    attn_stage(Kl + HDIM * h, MEMW, lds, tid);
    const bf16* qp0 = Q + (size_t)(t0 + fr) * MEMW + HDIM * h + 8 * fq; const bf16* qp1 = qp0 + (size_t)16 * MEMW;
    bf16x8 qa = *(const bf16x8*)qp0, qb = *(const bf16x8*)qp1;
    __syncthreads();
    const LAS bf16* lrow = (const LAS bf16*)lds + (8 * (fr >> 2) + (fr & 3)) * AT_LD + 8 * fq;
    f32x4 s[2][16];
#pragma unroll
    for (int i = 0; i < 16; ++i) { s[0][i] = (f32x4){0.f, 0.f, 0.f, 0.f}; s[1][i] = s[0][i]; }
#pragma unroll 1
    for (int ks = 0; ks < 8; ++ks) {
        const int kn = (ks < 7) ? ks + 1 : 7; const bf16x8 qan = *(const bf16x8*)(qp0 + 32 * kn), qbn = *(const bf16x8*)(qp1 + 32 * kn);
#pragma unroll
        for (int g = 0; g < 8; ++g)
#pragma unroll
            for (int e = 0; e < 2; ++e) { const bf16x8 kf = *(const LAS bf16x8*)(lrow + (32 * g + 4 * e) * AT_LD + 32 * ks);
                s[0][2 * g + e] = __builtin_amdgcn_mfma_f32_16x16x32_bf16(kf, qa, s[0][2 * g + e], 0, 0, 0); s[1][2 * g + e] = __builtin_amdgcn_mfma_f32_16x16x32_bf16(kf, qb, s[1][2 * g + e], 0, 0, 0); }
        qa = qan; qb = qbn; }
    float inv[2]; bf16x8 pf[2][8];
#pragma unroll
    for (int tg = 0; tg < 2; ++tg) { float mx = s[tg][0][0];
#pragma unroll
        for (int i = 0; i < 16; ++i)
#pragma unroll
            for (int j = 0; j < 4; ++j) mx = fmaxf(mx, s[tg][i][j]);
        mx = fmaxf(mx, __shfl_xor(mx, 16)); mx = fmaxf(mx, __shfl_xor(mx, 32));
        float sum = 0.f; const float mxl = mx * 1.44269504f;
#pragma unroll
        for (int i = 0; i < 16; ++i)
#pragma unroll
            for (int j = 0; j < 4; ++j) { const float p = __builtin_amdgcn_exp2f(s[tg][i][j] * 1.44269504f - mxl); s[tg][i][j] = p; sum += p; }
        sum += __shfl_xor(sum, 16); sum += __shfl_xor(sum, 32); inv[tg] = 1.0f / sum;
#pragma unroll
        for (int g = 0; g < 8; ++g) { v4u w; w.x = pk2(s[tg][2 * g][0], s[tg][2 * g][1]); w.y = pk2(s[tg][2 * g][2], s[tg][2 * g][3]); w.z = pk2(s[tg][2 * g + 1][0], s[tg][2 * g + 1][1]); w.w = pk2(s[tg][2 * g + 1][2], s[tg][2 * g + 1][3]);
            pf[tg][g] = __builtin_bit_cast(bf16x8, w); } }
    __syncthreads();
    attn_stage(VTl + (size_t)HDIM * h * NMEM, NMEM, lds, tid);
    __syncthreads();
#pragma unroll 1
    for (int db2 = 0; db2 < 8; ++db2) { f32x4 o[2][2];
#pragma unroll
        for (int tg = 0; tg < 2; ++tg) { o[tg][0] = (f32x4){0.f, 0.f, 0.f, 0.f}; o[tg][1] = o[tg][0]; }
#pragma unroll
        for (int ks2 = 0; ks2 < 8; ++ks2)
#pragma unroll
            for (int e = 0; e < 2; ++e) { const bf16x8 vf = *(const LAS bf16x8*)(lrow + (32 * db2 + 4 * e) * AT_LD + 32 * ks2);
                o[0][e] = __builtin_amdgcn_mfma_f32_16x16x32_bf16(vf, pf[0][ks2], o[0][e], 0, 0, 0); o[1][e] = __builtin_amdgcn_mfma_f32_16x16x32_bf16(vf, pf[1][ks2], o[1][e], 0, 0, 0); }
#pragma unroll
        for (int tg = 0; tg < 2; ++tg) { const size_t t = (size_t)(t0 + 16 * tg + fr); const int col = HDIM * h + 32 * db2 + 8 * fq; const float iv = inv[tg];
            const v4u z = *(const v4u*)(SZ + t * MEMW + col);
            v4u w; w.x = pk2(o[tg][0][0] * iv * bflo(z.x), o[tg][0][1] * iv * bfhi(z.x)); w.y = pk2(o[tg][0][2] * iv * bflo(z.y), o[tg][0][3] * iv * bfhi(z.y));
            w.z = pk2(o[tg][1][0] * iv * bflo(z.z), o[tg][1][1] * iv * bfhi(z.z)); w.w = pk2(o[tg][1][2] * iv * bflo(z.w), o[tg][1][3] * iv * bfhi(z.w));
            *(v4u*)(Y + t * DM + BRW + col) = w; } }
    __syncthreads();
}

constexpr int CONV_ROWS = 16;
__device__ __forceinline__ void conv_rows(const bf16* GZ, const bf16* CH, const float* cw  , bf16* Y, int t0, int cs, int lane) {
    const int c = 512 * cs + 8 * lane;
    float w0[8], w1[8], w2[8], p2[8], p1[8];
    { const f32x4 a = *(const f32x4*)(cw + c), b = *(const f32x4*)(cw + c + 4), d = *(const f32x4*)(cw + BRW + c), e = *(const f32x4*)(cw + BRW + c + 4), f = *(const f32x4*)(cw + 2 * BRW + c), g = *(const f32x4*)(cw + 2 * BRW + c + 4);
#pragma unroll
      for (int i = 0; i < 4; ++i) { w0[i] = a[i]; w0[4 + i] = b[i]; w1[i] = d[i]; w1[4 + i] = e[i]; w2[i] = f[i]; w2[4 + i] = g[i]; } }
    if (t0 >= 2) { const v4u u2 = *(const v4u*)(CH + (size_t)(t0 - 2) * BRW + c), u1 = *(const v4u*)(CH + (size_t)(t0 - 1) * BRW + c);
        p2[0] = bflo(u2.x); p2[1] = bfhi(u2.x); p2[2] = bflo(u2.y); p2[3] = bfhi(u2.y); p2[4] = bflo(u2.z); p2[5] = bfhi(u2.z); p2[6] = bflo(u2.w); p2[7] = bfhi(u2.w);
        p1[0] = bflo(u1.x); p1[1] = bfhi(u1.x); p1[2] = bflo(u1.y); p1[3] = bfhi(u1.y); p1[4] = bflo(u1.z); p1[5] = bfhi(u1.z); p1[6] = bflo(u1.w); p1[7] = bfhi(u1.w); }
    else {
#pragma unroll
        for (int i = 0; i < 8; ++i) { p2[i] = 0.f; p1[i] = 0.f; } }
#pragma unroll 4
    for (int t = t0; t < t0 + CONV_ROWS; ++t) {
        const v4u uc = *(const v4u*)(CH + (size_t)t * BRW + c), ug = *(const v4u*)(GZ + (size_t)t * BRW + c);
        float cu[8], gz[8], o[8];
        cu[0] = bflo(uc.x); cu[1] = bfhi(uc.x); cu[2] = bflo(uc.y); cu[3] = bfhi(uc.y); cu[4] = bflo(uc.z); cu[5] = bfhi(uc.z); cu[6] = bflo(uc.w); cu[7] = bfhi(uc.w);
        gz[0] = bflo(ug.x); gz[1] = bfhi(ug.x); gz[2] = bflo(ug.y); gz[3] = bfhi(ug.y); gz[4] = bflo(ug.z); gz[5] = bfhi(ug.z); gz[6] = bflo(ug.w); gz[7] = bfhi(ug.w);
#pragma unroll
        for (int i = 0; i < 8; ++i) { o[i] = gz[i] * (w0[i] * p2[i] + w1[i] * p1[i] + w2[i] * cu[i]); p2[i] = p1[i]; p1[i] = cu[i]; }
        v4u w; w.x = pk2(o[0], o[1]); w.y = pk2(o[2], o[3]); w.z = pk2(o[4], o[5]); w.w = pk2(o[6], o[7]);
        *(v4u*)(Y + (size_t)t * DM + c) = w; }
}

constexpr int SP_LD = 136;
constexpr int SP_WL = 0, SP_VTL = 128 * SP_LD * 2, SP_MU = SP_VTL + 384 * SP_LD * 2, SP_RS = SP_MU + 512, SP_END = SP_RS + 512;
static_assert(SP_END <= MISC_OFF, "spatial LDS map");
__device__ __forceinline__ void spatial_unit(const bf16* VG, const bf16* UZ, const float* vst, const float* Wg, const float* bsg, const float* lng, const float* lnb, bf16* Y, int nb, int g, LAS unsigned char* lds, int tid) {
    LAS bf16* WL = (LAS bf16*)(lds + SP_WL); LAS bf16* VTL = (LAS bf16*)(lds + SP_VTL); LAS float* MU = (LAS float*)(lds + SP_MU); LAS float* RS = (LAS float*)(lds + SP_RS);
    const int lane = tid & 63, wave = __builtin_amdgcn_readfirstlane(tid >> 6), fr = lane & 15, fq = lane >> 4;
    if (tid < 128) { const float* q = vst + (size_t)(128 * nb + tid) * 96; float s1 = 0.f, s2 = 0.f;
#pragma unroll 8
        for (int k = 0; k < 48; ++k) { s1 += q[2 * k]; s2 += q[2 * k + 1]; }
        const float mu = s1 * (1.0f / BRW), var = s2 * (1.0f / BRW) - mu * mu; MU[tid] = mu; RS[tid] = 1.0f / sqrtf(var + LNORM_EPS); }
    { const int t = tid >> 2, s0 = (tid & 3) * 32;
#pragma unroll
        for (int q = 0; q < 4; ++q) { const int sb = s0 + 8 * q; const f32x4 a = *(const f32x4*)(Wg + t * 128 + sb), b = *(const f32x4*)(Wg + t * 128 + sb + 4);
            float v[8] = {a[0], a[1], a[2], a[3], b[0], b[1], b[2], b[3]};
#pragma unroll
            for (int e = 0; e < 8; ++e) v[e] = (sb + e <= t) ? v[e] : 0.f;
            v4u o; o.x = pk2(v[0], v[1]); o.y = pk2(v[2], v[3]); o.z = pk2(v[4], v[5]); o.w = pk2(v[6], v[7]);
            *(LAS v4u*)(WL + t * SP_LD + sb) = o; } }
    __syncthreads();
    { const int s = (lane & 31) + 32 * (wave & 3); const float mu = MU[s], rs = RS[s];
#pragma unroll 4
        for (int it = 0; it < 12; ++it) { const int c = 8 * ((lane >> 5) + 2 * (wave >> 2) + 4 * it);
            const v4u u = *(const v4u*)(VG + (size_t)(128 * nb + s) * BRW + 384 * g + c);
            const f32x4 g0 = *(const f32x4*)(lng + 384 * g + c), g1 = *(const f32x4*)(lng + 384 * g + c + 4), b0 = *(const f32x4*)(lnb + 384 * g + c), b1 = *(const f32x4*)(lnb + 384 * g + c + 4);
            float v[8] = {bflo(u.x), bfhi(u.x), bflo(u.y), bfhi(u.y), bflo(u.z), bfhi(u.z), bflo(u.w), bfhi(u.w)};
#pragma unroll
            for (int e = 0; e < 8; ++e) { const float gg = e < 4 ? g0[e & 3] : g1[e & 3], bb = e < 4 ? b0[e & 3] : b1[e & 3]; VTL[(c + e) * SP_LD + s] = (bf16)f2bf((v[e] - mu) * rs * gg + bb); } } }
    __syncthreads();
    const int th = wave >> 2, d0w = 96 * (wave & 3);
    f32x4 acc[4][3][2];
#pragma unroll
    for (int i = 0; i < 4; ++i)
#pragma unroll
        for (int dp = 0; dp < 3; ++dp) { acc[i][dp][0] = (f32x4){0.f, 0.f, 0.f, 0.f}; acc[i][dp][1] = (f32x4){0.f, 0.f, 0.f, 0.f}; }
#pragma unroll
    for (int i = 0; i < 4; ++i) { const int tb = th ? ((i == 0) ? 1 : (i == 1) ? 2 : (i == 2) ? 5 : 6) : ((i == 0) ? 0 : (i == 1) ? 3 : (i == 2) ? 4 : 7); const int kmax = tb >> 1;
#pragma unroll
        for (int ks = 0; ks < 4; ++ks) if (ks <= kmax) {
            const bf16x8 bw = *(const LAS bf16x8*)(WL + (16 * tb + fr) * SP_LD + 32 * ks + 8 * fq);
#pragma unroll
            for (int dp = 0; dp < 3; ++dp)
#pragma unroll
                for (int e = 0; e < 2; ++e) { const bf16x8 av = *(const LAS bf16x8*)(VTL + (d0w + 32 * dp + 8 * (fr >> 2) + 4 * e + (fr & 3)) * SP_LD + 32 * ks + 8 * fq);
                    acc[i][dp][e] = __builtin_amdgcn_mfma_f32_16x16x32_bf16(av, bw, acc[i][dp][e], 0, 0, 0); } } }
#pragma unroll
    for (int i = 0; i < 4; ++i) { const int tb = th ? ((i == 0) ? 1 : (i == 1) ? 2 : (i == 2) ? 5 : 6) : ((i == 0) ? 0 : (i == 1) ? 3 : (i == 2) ? 4 : 7);
        const int tl = 16 * tb + fr; const float bs = bsg[tl]; const size_t row = (size_t)(128 * nb + tl);
#pragma unroll
        for (int dp = 0; dp < 3; ++dp) { const int d = 384 * g + d0w + 32 * dp + 8 * fq; const v4u u = *(const v4u*)(UZ + row * BRW + d);
            const f32x4 f0 = acc[i][dp][0] + bs, f1 = acc[i][dp][1] + bs;
            v4u w; w.x = pk2(bflo(u.x) * f0[0], bfhi(u.x) * f0[1]); w.y = pk2(bflo(u.y) * f0[2], bfhi(u.y) * f0[3]); w.z = pk2(bflo(u.z) * f1[0], bfhi(u.z) * f1[1]); w.w = pk2(bflo(u.w) * f1[2], bfhi(u.w) * f1[3]);
            *(v4u*)(Y + row * DM + d) = w; } }
    __syncthreads();
}

__device__ __forceinline__ void p4_rows(const bf16* YO, const float* yss, const float* gpost, bf16* HN, float* rmsv, float* out, bool last, int m0, int nrows, int lane) {
    for (int m = m0; m < m0 + nrows; ++m) {
        const float tot = wave_sum(yss[(size_t)m * 64 + lane]); const float rsy = 1.0f / sqrtf(tot * (1.0f / DM) + RMS_EPS); const float rmo = rmsv[m];
        float ss = 0.f; float xn[8][8];
#pragma unroll
        for (int i = 0; i < 8; ++i) { const int col = 512 * i + 8 * lane;
            const v4u yo = *(const v4u*)(YO + (size_t)m * DM + col), hb = *(const v4u*)(HN + (size_t)m * DM + col); const f32x4 g0 = *(const f32x4*)(gpost + col) * rsy, g1 = *(const f32x4*)(gpost + col + 4) * rsy;
            xn[i][0] = bflo(hb.x) * rmo + bflo(yo.x) * g0[0]; xn[i][1] = bfhi(hb.x) * rmo + bfhi(yo.x) * g0[1]; xn[i][2] = bflo(hb.y) * rmo + bflo(yo.y) * g0[2]; xn[i][3] = bfhi(hb.y) * rmo + bfhi(yo.y) * g0[3];
            xn[i][4] = bflo(hb.z) * rmo + bflo(yo.z) * g1[0]; xn[i][5] = bfhi(hb.z) * rmo + bfhi(yo.z) * g1[1]; xn[i][6] = bflo(hb.w) * rmo + bflo(yo.w) * g1[2]; xn[i][7] = bfhi(hb.w) * rmo + bfhi(yo.w) * g1[3];
#pragma unroll
            for (int e = 0; e < 8; ++e) ss += xn[i][e] * xn[i][e];
            if (last) { *(f32x4*)(out + (size_t)m * DM + col) = (f32x4){xn[i][0], xn[i][1], xn[i][2], xn[i][3]}; *(f32x4*)(out + (size_t)m * DM + col + 4) = (f32x4){xn[i][4], xn[i][5], xn[i][6], xn[i][7]}; } }
        if (!last) { ss = wave_sum(ss); const float rmn = sqrtf(ss * (1.0f / DM) + RMS_EPS), rs = 1.0f / rmn;
            if (lane == 0) rmsv[m] = rmn;
#pragma unroll
            for (int i = 0; i < 8; ++i) { const int col = 512 * i + 8 * lane;
                v4u w; w.x = pk2(xn[i][0] * rs, xn[i][1] * rs); w.y = pk2(xn[i][2] * rs, xn[i][3] * rs); w.z = pk2(xn[i][4] * rs, xn[i][5] * rs); w.w = pk2(xn[i][6] * rs, xn[i][7] * rs); *(v4u*)(HN + (size_t)m * DM + col) = w; } }
    }
}

constexpr int CW_TEAM = 8192;
constexpr int CW_TMO = 64;
__device__ __forceinline__ void team_barrier(unsigned* ctl, int tm, unsigned gen, int nbr) {
    asm volatile("s_waitcnt vmcnt(0)" ::: "memory");
    __syncthreads();
    if (threadIdx.x == 0) {
        __builtin_amdgcn_fence(__ATOMIC_RELEASE, "agent");
        asm volatile("s_waitcnt vmcnt(0)" ::: "memory");
        unsigned* mine = ctl + CW_TEAM + 64 * tm; unsigned* other = ctl + CW_TEAM + 64 * (nbr >= 0 ? nbr : tm);
        (void)xb_add(mine, 1u);
        const unsigned want = 4u * gen; unsigned sp = 0u;
        while (xb_ld(mine) < want || xb_ld(other) < want) { __builtin_amdgcn_s_sleep(1);
            if ((++sp & 255u) == 0u) { if (xb_ld(ctl + CW_TMO)) break; if (sp > XB_SPIN_CAP) { atomicAdd(ctl + CW_TMO, 1u); break; } } }
        __builtin_amdgcn_fence(__ATOMIC_ACQUIRE, "agent");
        asm volatile("s_waitcnt vmcnt(0)" ::: "memory");
    }
    __syncthreads();
}

__global__ void __launch_bounds__(NWAVES * 64, 2) mk_fwd(Args args) {
    extern __shared__ __attribute__((aligned(16))) unsigned char lds_raw[];
    LAS unsigned char* lds = (LAS unsigned char*)lds_raw;
    const int G = gridDim.x, NGW = G * NWAVES;
    unsigned char* ws = args.ws;
    const int lo = args.ph_lo, hi = args.ph_hi;
    if (threadIdx.x < 32) ((LAS unsigned*)(lds + MISC_OFF))[threadIdx.x] = 0u;
    __syncthreads();
    XcdBarrier bar; bar.bar = (unsigned*)(ws + WS_CTL) + CW_BAR; bar.x = 0; bar.st = (volatile LAS unsigned*)(lds + MISC_OFF);
    if (hi - lo > 1) bar = xcd_barrier_post((unsigned*)(ws + WS_CTL) + CW_BAR, (volatile LAS unsigned*)(lds + MISC_OFF));
#define IN(k) (lo <= (k) && (k) < hi)
#define OPAQUE_IDS() int tid_ = threadIdx.x; asm volatile("" : "+v"(tid_)); const int tid = tid_, lane = tid & 63, wave = __builtin_amdgcn_readfirstlane(tid >> 6); int bx_ = blockIdx.x; asm volatile("" : "+s"(bx_)); const int gw = bx_ * NWAVES + wave; (void)gw; (void)lane
#define SEAM(k) do { if (IN(k) && IN((k) + 1)) for (int rb_ = 0; rb_ < REP_BAR; ++rb_) xcd_barrier(bar); } while (0)

    bf16* const A1 = (bf16*)(ws + WS_A1); bf16* const A2 = (bf16*)(ws + WS_A2); bf16* const QB = (bf16*)(ws + WS_Q); bf16* const SZ = (bf16*)(ws + WS_SZ);
    bf16* const YB = (bf16*)(ws + WS_Y); bf16* const YO = (bf16*)(ws + WS_YO); bf16* const KVB = (bf16*)(ws + WS_KV);
    float* const VST = (float*)(ws + WS_VST); float* const YSS = (float*)(ws + WS_YSS); bf16* const HN = (bf16*)(ws + WS_HN);

    if (IN(0)) { for (int rep = 0; rep < REP_P0; ++rep) { OPAQUE_IDS(); p0_convert(args, ws, lds, gw, NGW, wave, lane); } }
    SEAM(0);
    if (IN(1)) for (int rep = 0; rep < REP_KV; ++rep) {
        pg8::Gemm g{(const bf16*)(ws + WS_MEMB), (const bf16*)(ws + WS_WKV), NMEM, DEPTH * NKV, DM}; pg8::StaticOrder S; S.init(NMEM, DEPTH * NKV, G, (int)blockIdx.x);
        pg8::EpiKV E{KVB};
        pg8::gemm_phase<pg8::EpiKV, pg8::StaticOrder, GP_ALIGN, GP_SP2>(lds, g, S, E);
    }
    SEAM(1);
    unsigned* const ctl = (unsigned*)(ws + WS_CTL);
    for (int L = 0; L < DEPTH; ++L) {
        const int k0 = 2 + 4 * L, gm = L & 1, jj = L >> 1;
        if (IN(k0)) for (int rep = 0; rep < REP_P1; ++rep) {
            const size_t woff = (L == 0) ? WIN_OFF0 : (L == 1) ? WIN_OFF1 : (L == 2) ? WIN_OFF2 : WIN_OFF3; const int nin = gm ? NIN_GMLP : NIN_CONV;
            pg8::Gemm g{HN, (const bf16*)(ws + WS_WIN + woff), SEQ, nin, DM}; pg8::StaticOrder S; S.init(SEQ, nin, G, (int)blockIdx.x);
            pg8::EpiProj E{A1, VST, gm};
            pg8::gemm_phase<pg8::EpiProj, pg8::StaticOrder, GP_ALIGN, GP_SP2>(lds, g, S, E);
            if (REP_SYNC && rep + 1 < REP_P1) xcd_barrier(bar);
        }
        { OPAQUE_IDS(); const int tm = 8 * (bx_ & 7) + ((bx_ >> 3) & 7); team_barrier(ctl, tm, 4 * L + 1, (gm == 0 && tm > 0) ? tm - 1 : -1); }
        if (IN(k0 + 1)) for (int rep = 0; rep < REP_P2; ++rep) { OPAQUE_IDS(); const int tm = 8 * (bx_ & 7) + ((bx_ >> 3) & 7), km = bx_ >> 6;
            const bf16* Kl = KVB + (size_t)L * (2 * 256 * 1024); const bf16* VTl = Kl + 256 * 1024;
            if (gm) {
                const float* ws_w = args.in[12] + (size_t)jj * 8 * 128 * 128; const float* bs = args.in[13] + (size_t)jj * 8 * 128; const float* lng = args.in[10] + (size_t)jj * BRW; const float* lnb = args.in[11] + (size_t)jj * BRW;
                for (int i = 0; i < 4; ++i) { const int un = 4 * km + i, nb = 2 * tm + (un >> 3), gg = un & 7;
                    spatial_unit(A2, A1, VST, ws_w + (size_t)gg * 128 * 128, bs + gg * 128, lng, lnb, YB, nb, gg, lds, tid); }
            } else {
                const float* cw = args.in[8] + (size_t)jj * 3 * BRW;
                for (int task = wave; task < (64 / CONV_ROWS) * 6; task += NWAVES) { const int rc = task / 6, cs = task - 6 * rc; conv_rows(A1, A2, cw, YB, 256 * tm + 64 * km + CONV_ROWS * rc, cs, lane); }
            }
            attn_wg(QB, SZ, Kl, VTl, YB, tm, km, lds, tid);
        }
        { OPAQUE_IDS(); const int tm = 8 * (bx_ & 7) + ((bx_ >> 3) & 7); team_barrier(ctl, tm, 4 * L + 2, -1); }
        if (IN(k0 + 2)) for (int rep = 0; rep < REP_P3; ++rep) {
            pg8::Gemm g{YB, (const bf16*)(ws + WS_WOUT) + (size_t)L * DM * DM, SEQ, DM, DM}; pg8::StaticOrder S; S.init(SEQ, DM, G, (int)blockIdx.x);
            pg8::EpiOut E{YO, YSS};
            if (FAKE_P3) { pg8::FakeOrder SF; SF.init(SEQ, DM, G, (int)blockIdx.x); pg8::gemm_phase<pg8::EpiOut, pg8::FakeOrder, GP_ALIGN, GP_SP2>(lds, g, SF, E); }
            pg8::gemm_phase<pg8::EpiOut, pg8::StaticOrder, GP_ALIGN, GP_SP2>(lds, g, S, E);
            if (REP_SYNC && rep + 1 < REP_P3) xcd_barrier(bar);
        }
        { OPAQUE_IDS(); const int tm = 8 * (bx_ & 7) + ((bx_ >> 3) & 7); team_barrier(ctl, tm, 4 * L + 3, -1); }
        if (IN(k0 + 3)) { OPAQUE_IDS(); const int tm = 8 * (bx_ & 7) + ((bx_ >> 3) & 7), km = bx_ >> 6;
            p4_rows(YO, YSS, args.in[3] + (size_t)L * DM, HN, (float*)(ws + WS_RSTD), args.out, L == DEPTH - 1, 256 * tm + 64 * km + 8 * wave, 8, lane); }
        if (L < DEPTH - 1) { OPAQUE_IDS(); const int tm = 8 * (bx_ & 7) + ((bx_ >> 3) & 7); team_barrier(ctl, tm, 4 * L + 4, -1); if (GRID_PER_LAYER) xcd_barrier(bar); }
    }
#undef IN
#undef SEAM
}

extern "C" void kernel_launch(void* const* d_in, const int* in_sizes, int n_in, void* d_out, int out_size, void* d_ws, size_t ws_size, hipStream_t stream) {
    static int grid = 0;
    if (grid == 0) {
        if (n_in != 14 || in_sizes[0] != SEQ * DM || out_size != SEQ * DM || ws_size < WS_END) { fprintf(stderr, "kernel_launch: unexpected shapes / workspace (n_in %d, in0 %d, out %d, ws %zu, need %zu); nothing launched\n", n_in, n_in > 0 ? in_sizes[0] : -1, out_size, ws_size, (size_t)WS_END); grid = -1; return; }
        int dev = 0, cus = 0, per_cu = 0;
        if (hipGetDevice(&dev) != hipSuccess || hipDeviceGetAttribute(&cus, hipDeviceAttributeMultiprocessorCount, dev) != hipSuccess) { grid = -1; return; }
        if (hipFuncSetAttribute((const void*)mk_fwd, hipFuncAttributeMaxDynamicSharedMemorySize, LDS_BYTES) != hipSuccess) { fprintf(stderr, "kernel_launch: hipFuncSetAttribute failed\n"); grid = -1; return; }
        if (hipOccupancyMaxActiveBlocksPerMultiprocessor(&per_cu, (const void*)mk_fwd, NWAVES * 64, LDS_BYTES) != hipSuccess || per_cu < 1) { fprintf(stderr, "kernel_launch: occupancy query says %d\n", per_cu); }
        (void)hipGetLastError();
        grid = cus;
    }
    if (grid < 0) return;
    if (hipMemsetAsync((char*)d_ws + WS_CTL, 0, CTL_ZERO_BYTES, stream) != hipSuccess) return;
    Args a{};
    for (int i = 0; i < 14; ++i) a.in[i] = (const float*)d_in[i];
    a.out = (float*)d_out; a.ws = (unsigned char*)d_ws;
#if MK_ONE_LAUNCH
    a.ph_lo = 0; a.ph_hi = NPHASE;
    hipLaunchKernelGGL(mk_fwd, dim3(grid), dim3(NWAVES * 64), LDS_BYTES, stream, a);
#else
    for (int k = 0; k < NPHASE; ++k) { a.ph_lo = k; a.ph_hi = k + 1; hipLaunchKernelGGL(mk_fwd, dim3(grid), dim3(NWAVES * 64), LDS_BYTES, stream, a); }
#endif
}
```

```cpp
#include <hip/hip_runtime.h>
#include <cstdio>
#include <cstdint>
namespace pg8 {
#define PG8_LAS __attribute__((address_space(3)))
typedef unsigned short bf16_t;
typedef short bf16x8 __attribute__((ext_vector_type(8)));
typedef float f32x4 __attribute__((ext_vector_type(4)));
typedef unsigned u32x4 __attribute__((ext_vector_type(4)));
constexpr int BM = 256, BK = 64, HALF = 128, HTB = HALF * BK * 2  , STAGE_BYTES = 8 * HTB, NXCD = 8, WGM = 8;

__host__ __device__ __forceinline__ int lds_byte(int r, int c) { const int st = (r >> 4) * 2 + (c >> 5), rr = r & 15, cc = c & 31, ob = rr * 64 + cc * 2; return st * 1024 + (ob ^ (((ob >> 9) & 1) << 5)); }
__host__ __device__ __forceinline__ void stage_rc(int b, int& R, int& C) { const int st = b / 1024, sb = b % 1024, swz = sb ^ (((sb >> 9) & 1) << 5); R = (st >> 1) * 16 + swz / 64; C = (st & 1) * 32 + (swz % 64) / 2; }
__host__ __device__ __forceinline__ int perm32(int rho) { const int n = rho >> 4, i = rho & 15; return 8 * (i >> 2) + 4 * n + (i & 3); }

struct Unit { int pm, pn; };
struct Gemm { const bf16_t* A; const bf16_t* Bt; int M, N, K; };

struct StaticOrder {
    int nM, nN, nwg, G, c;
    __host__ __device__ void init(int M, int N, int G_, int c_) { nM = M / BM; nN = N / BM; nwg = nM * nN; G = G_; c = c_; }
    __host__ __device__ bool next(int i, Unit& u) const {
        const long L = (long)i * G + c; if (L >= nwg) return false;
        int wgid = (int)L; { const int q = nwg / NXCD, r = nwg % NXCD, xcd = wgid % NXCD, off = wgid / NXCD; wgid = (xcd < r ? xcd * (q + 1) : r * (q + 1) + (xcd - r) * q) + off; }
        const int nig = WGM * nN, gid = wgid / nig, fm = gid * WGM, gsz = (nM - fm) < WGM ? (nM - fm) : WGM;
        u.pm = fm + ((wgid % nig) % gsz); u.pn = (wgid % nig) / gsz; return true;
    }
    __device__ __forceinline__ void a_ready(const Unit&) const {}
    __device__ __forceinline__ void done(const Unit&) const {}
    __device__ __forceinline__ int apm(const Unit& u) const { return u.pm; }
    __device__ __forceinline__ int bpn(const Unit& u) const { return u.pn; }
};
struct FakeOrder : StaticOrder {
    __device__ __forceinline__ int apm(const Unit&) const { return 0; }
    __device__ __forceinline__ int bpn(const Unit&) const { return 0; }
};


__device__ __forceinline__ unsigned cvt_pk_bf16(float lo, float hi) { unsigned r; asm("v_cvt_pk_bf16_f32 %0, %1, %2" : "=v"(r) : "v"(lo), "v"(hi)); return r; }
__device__ __forceinline__ float silu_f(float z) { return z * __builtin_amdgcn_rcpf(1.0f + __builtin_amdgcn_exp2f(-1.44269504f * z)); }
__device__ __forceinline__ float gelu_f(float x) { const float u = x * (0.7978845608f + 0.0356774081f * x * x); return x * __builtin_amdgcn_rcpf(1.0f + __builtin_amdgcn_exp2f(-2.88539008f * u)); }
__device__ __forceinline__ unsigned short f2bf1(float f) { unsigned u = __builtin_bit_cast(unsigned, f); return (unsigned short)((u + 0x7fffu + ((u >> 16) & 1u)) >> 16); }

template <int CTRL> __device__ __forceinline__ float dpp_keep(float old, float src) {
    return __builtin_bit_cast(float, __builtin_amdgcn_update_dpp(__builtin_bit_cast(int, old), __builtin_bit_cast(int, src), CTRL, 0xf, 0xf, false)); }
struct EpiProj {
    static constexpr bool PERM = false, AFTER_DRAIN = false;
    bf16_t* base; float* vst; int gm; bf16_t* Y; const float* cw; float* cht; float* gzh;
    static constexpr size_t OFF_A2 = (size_t)48 << 20, OFF_Q = (size_t)96 << 20, OFF_SZ = (size_t)112 << 20;
    __device__ __forceinline__ void operator()(const f32x4 (&acc)[2][2][4][2], const Unit& u, int wr, int wc, int fr, int fq) const {
        asm volatile("" : "+v"(fr), "+v"(fq));
        const int pn = u.pn; int kind, p;
        if (gm == 0) { if (pn < 48) { kind = 6; p = pn; } else if (pn < 52) { kind = 3; p = pn - 48; } else { kind = 4; p = pn - 52; } }
        else         { if (pn < 24) { kind = 2; p = pn; } else if (pn < 36) { kind = 5; p = pn - 24; } else if (pn < 40) { kind = 3; p = pn - 36; } else { kind = 4; p = pn - 40; } }
        const int row0 = u.pm * BM + wr * 64 + fr;
        if (kind == 6) {
            const int c0 = 64 * p + 16 * wc + 4 * fq;
            const f32x4 w0 = *(const f32x4*)(cw + c0), w1 = *(const f32x4*)(cw + 3072 + c0), w2 = *(const f32x4*)(cw + 2 * 3072 + c0);
#pragma unroll
            for (int ai = 0; ai < 2; ++ai) { f32x4 chp = (f32x4){0.f, 0.f, 0.f, 0.f};
#pragma unroll
                for (int m = 0; m < 4; ++m) { const int r = row0 + ai * HALF + m * 16;
                    const f32x4 bv = acc[ai][0][m][0], cv = acc[ai][0][m][1], hv = acc[ai][1][m][0], zv = acc[ai][1][m][1];
                    f32x4 ch, gz, o;
#pragma unroll
                    for (int j = 0; j < 4; ++j) { ch[j] = cv[j] * hv[j]; gz[j] = bv[j] * silu_f(zv[j]); }
#pragma unroll
                    for (int j = 0; j < 4; ++j) {
                        const float p1 = dpp_keep<0x111>(dpp_keep<0x121>(0.f, chp[j]), ch[j]);
                        const float p2 = dpp_keep<0x112>(dpp_keep<0x122>(0.f, chp[j]), ch[j]);
                        o[j] = gz[j] * (w0[j] * p2 + w1[j] * p1 + w2[j] * ch[j]); }
                    typedef unsigned u32x2 __attribute__((ext_vector_type(2)));
                    u32x2 w; w.x = cvt_pk_bf16(o[0], o[1]); w.y = cvt_pk_bf16(o[2], o[3]);
                    *(u32x2*)(Y + (size_t)r * 4096 + c0) = w;
                    const int gr = (u.pm * 4 + ai * 2 + wr);
                    if (m == 0 && fr < 2) *(f32x4*)(gzh + ((size_t)gr * 2 + fr) * 3072 + c0) = gz;
                    if (m == 3 && fr >= 14) *(f32x4*)(cht + ((size_t)gr * 2 + (fr - 14)) * 3072 + c0) = ch;
                    chp = ch; } }
        } else if (kind <= 2) {
            bf16_t* O = base + ((kind == 1) ? OFF_A2 : (size_t)0); const int col0 = 128 * p + 32 * wc + 8 * fq;
#pragma unroll
            for (int ai = 0; ai < 2; ++ai)
#pragma unroll
                for (int m = 0; m < 4; ++m) { const int r = row0 + ai * HALF + m * 16;
                    f32x4 o[2];
#pragma unroll
                    for (int n = 0; n < 2; ++n) { const f32x4 a = acc[ai][0][m][n], b = acc[ai][1][m][n];
#pragma unroll
                        for (int j = 0; j < 4; ++j) o[n][j] = (kind == 0) ? a[j] * silu_f(b[j]) : (kind == 1) ? a[j] * b[j] : gelu_f(a[j]) * silu_f(b[j]); }
                    u32x4 w; w.x = cvt_pk_bf16(o[0][0], o[0][1]); w.y = cvt_pk_bf16(o[0][2], o[0][3]); w.z = cvt_pk_bf16(o[1][0], o[1][1]); w.w = cvt_pk_bf16(o[1][2], o[1][3]);
                    *(u32x4*)(O + (size_t)r * 3072 + col0) = w; }
        } else {
            bf16_t* O = base + ((kind == 3) ? OFF_Q : (kind == 4) ? OFF_SZ : OFF_A2); const int ldo = (kind == 5) ? 3072 : 1024; const int col0 = 256 * p + 32 * wc + 8 * fq;
#pragma unroll
            for (int ai = 0; ai < 2; ++ai)
#pragma unroll
                for (int m = 0; m < 4; ++m) { const int r = row0 + ai * HALF + m * 16; float s1 = 0.f, s2 = 0.f;
#pragma unroll
                    for (int bj = 0; bj < 2; ++bj) { f32x4 o[2];
#pragma unroll
                        for (int n = 0; n < 2; ++n) { const f32x4 a = acc[ai][bj][m][n];
#pragma unroll
                            for (int j = 0; j < 4; ++j) { const float v = (kind == 3) ? a[j] * 0.0625f : (kind == 4) ? silu_f(a[j]) : gelu_f(a[j]); o[n][j] = v; s1 += v; s2 += v * v; } }
                        u32x4 w; w.x = cvt_pk_bf16(o[0][0], o[0][1]); w.y = cvt_pk_bf16(o[0][2], o[0][3]); w.z = cvt_pk_bf16(o[1][0], o[1][1]); w.w = cvt_pk_bf16(o[1][2], o[1][3]);
                        *(u32x4*)(O + (size_t)r * ldo + col0 + bj * HALF) = w; }
                    if (kind == 5) { s1 += __shfl_xor(s1, 16); s1 += __shfl_xor(s1, 32); s2 += __shfl_xor(s2, 16); s2 += __shfl_xor(s2, 32);
                        if (fq == 0) { float* q = vst + ((size_t)r * 48 + p * 4 + wc) * 2; q[0] = s1; q[1] = s2; } } }
        }
    }
};
struct EpiOut {
    static constexpr bool PERM = false, AFTER_DRAIN = false;
    bf16_t* YO; float* yss;
    __device__ __forceinline__ void operator()(const f32x4 (&acc)[2][2][4][2], const Unit& u, int wr, int wc, int fr, int fq) const {
        asm volatile("" : "+v"(fr), "+v"(fq));
        const int row0 = u.pm * BM + wr * 64 + fr, col0 = 256 * u.pn + 32 * wc + 8 * fq;
#pragma unroll
        for (int ai = 0; ai < 2; ++ai)
#pragma unroll
            for (int m = 0; m < 4; ++m) { const int r = row0 + ai * HALF + m * 16; float ss = 0.f;
#pragma unroll
                for (int bj = 0; bj < 2; ++bj) { const f32x4 a = acc[ai][bj][m][0], b = acc[ai][bj][m][1];
                    ss += (a[0] * a[0] + a[1] * a[1]) + (a[2] * a[2] + a[3] * a[3]) + (b[0] * b[0] + b[1] * b[1]) + (b[2] * b[2] + b[3] * b[3]);
                    u32x4 w; w.x = cvt_pk_bf16(a[0], a[1]); w.y = cvt_pk_bf16(a[2], a[3]); w.z = cvt_pk_bf16(b[0], b[1]); w.w = cvt_pk_bf16(b[2], b[3]);
                    *(u32x4*)(YO + (size_t)r * 4096 + col0 + bj * HALF) = w; }
                ss += __shfl_xor(ss, 16); ss += __shfl_xor(ss, 32);
                if (fq == 0) yss[(size_t)r * 64 + u.pn * 4 + wc] = ss; }
    }
};
struct EpiKV {
    static constexpr bool PERM = false, AFTER_DRAIN = false;
    bf16_t* KV;
    __device__ __forceinline__ void operator()(const f32x4 (&acc)[2][2][4][2], const Unit& u, int wr, int wc, int fr, int fq) const {
        asm volatile("" : "+v"(fr), "+v"(fq));
        const int l = u.pn >> 3, t = u.pn & 7; bf16_t* base = KV + (size_t)l * (2 * 256 * 1024); const int row0 = wr * 64 + fr;
#pragma unroll
        for (int ai = 0; ai < 2; ++ai)
#pragma unroll
            for (int m = 0; m < 4; ++m) { const int r = row0 + ai * HALF + m * 16;
#pragma unroll
                for (int bj = 0; bj < 2; ++bj) { const f32x4 a = acc[ai][bj][m][0], b = acc[ai][bj][m][1];
                    if (t < 4) { u32x4 w; w.x = cvt_pk_bf16(a[0], a[1]); w.y = cvt_pk_bf16(a[2], a[3]); w.z = cvt_pk_bf16(b[0], b[1]); w.w = cvt_pk_bf16(b[2], b[3]);
                        *(u32x4*)(base + (size_t)r * 1024 + 256 * t + bj * HALF + 32 * wc + 8 * fq) = w; }
                    else { bf16_t* vt = base + 256 * 1024 + (size_t)(256 * (t - 4) + bj * HALF + 32 * wc + 8 * fq) * 256 + r;
#pragma unroll
                        for (int j = 0; j < 4; ++j) { vt[(size_t)j * 256] = f2bf1(a[j]); vt[(size_t)(4 + j) * 256] = f2bf1(b[j]); } } } }
    }
};
template <class Epi, class Sched, bool ALIGN_EPI = false, bool SP2 = false>
__device__ __forceinline__ void gemm_phase(PG8_LAS unsigned char* lds, const Gemm g, const Sched& S, const Epi& E) {
    int tid_ = threadIdx.x; asm volatile("" : "+v"(tid_));
    const int tid = tid_, wid = __builtin_amdgcn_readfirstlane(tid >> 6), lane = tid & 63, wr = wid >> 2, wc = wid & 3, fr = lane & 15, fq = lane >> 4;
    const int K = g.K, nt = K / BK;
    unsigned voffA[2], voffB[2];
#pragma unroll
    for (int i = 0; i < 2; ++i) { int R, C; stage_rc(tid * 16 + i * 8192, R, C); const int Rb = Epi::PERM ? ((R & ~31) + perm32(R & 31)) : R;
        voffA[i] = (unsigned)(R * K + C) * 2u; voffB[i] = (unsigned)(Rb * K + C) * 2u; }
    const size_t kstep = (size_t)(BK * 2);
    const size_t hstep = (size_t)HALF * K * 2;
    const size_t tstep = 2 * hstep;
    const unsigned ldsw = (unsigned)wid * 1024u;
    const int aoff = lds_byte(wr * 64 + fr, fq * 8), boff = lds_byte(wc * 32 + fr, fq * 8);
#define PG8_SA(b, h) (((b) * 2 + (h)) * HTB)
#define PG8_SB(b, h) ((4 + (b) * 2 + (h)) * HTB)
#define PG8_STAGE(bufoff, gbase, voff) do { _Pragma("unroll") for (int _i = 0; _i < 2; ++_i) \
        __builtin_amdgcn_global_load_lds((const unsigned*)((const char*)(gbase) + (voff)[_i]), (PG8_LAS unsigned*)(lds + (bufoff) + ldsw + _i * 8192), 16, 0, 0); } while (0)
#define PG8_LDA(dst, b, h) do { _Pragma("unroll") for (int m = 0; m < 4; ++m) _Pragma("unroll") for (int k = 0; k < 2; ++k) dst[m][k] = *(const PG8_LAS bf16x8*)(lds + PG8_SA(b, h) + aoff + m * 2048 + k * 1024); } while (0)
#define PG8_LDB(dst, b, h) do { _Pragma("unroll") for (int n = 0; n < 2; ++n) _Pragma("unroll") for (int k = 0; k < 2; ++k) dst[n][k] = *(const PG8_LAS bf16x8*)(lds + PG8_SB(b, h) + boff + n * 2048 + k * 1024); } while (0)
#define PG8_MMA(ai, bj, At, Bt) do { __builtin_amdgcn_s_setprio(1); _Pragma("unroll") for (int m = 0; m < 4; ++m) _Pragma("unroll") for (int n = 0; n < 2; ++n) _Pragma("unroll") for (int k = 0; k < 2; ++k) \
        acc[ai][bj][m][n] = __builtin_amdgcn_mfma_f32_16x16x32_bf16(Bt[n][k], At[m][k], acc[ai][bj][m][n], 0, 0, 0); __builtin_amdgcn_s_setprio(0); } while (0)
#define PG8_WAIT_V(n) asm volatile("s_waitcnt vmcnt(" #n ")" ::: "memory")
#define PG8_WAIT_L(n) asm volatile("s_waitcnt lgkmcnt(" #n ")" ::: "memory")
#define PG8_BAR __builtin_amdgcn_s_barrier()
#define PG8_SCHED __builtin_amdgcn_sched_barrier(0)
    Unit cur, nxt; int ui = 0;
    if (!S.next(0, cur)) return;
    f32x4 acc[2][2][4][2];
#pragma unroll
    for (int a = 0; a < 2; ++a)
#pragma unroll
        for (int b = 0; b < 2; ++b)
#pragma unroll
            for (int m = 0; m < 4; ++m)
#pragma unroll
                for (int n = 0; n < 2; ++n) acc[a][b][m][n] = (f32x4){0.f, 0.f, 0.f, 0.f};
    bf16x8 At[4][2], B0[2][2], B1[2][2];
    const char* cA = (const char*)g.A + (size_t)S.apm(cur) * tstep; const char* cB = (const char*)g.Bt + (size_t)S.bpn(cur) * tstep;
    S.a_ready(cur);
    if constexpr (SP2) {
        PG8_STAGE(PG8_SB(0, 0), cB, voffB); PG8_STAGE(PG8_SB(0, 1), cB + hstep, voffB); PG8_STAGE(PG8_SA(0, 0), cA, voffA); PG8_STAGE(PG8_SA(0, 1), cA + hstep, voffA);
        if (wr == 1) PG8_BAR;
        PG8_WAIT_V(2); PG8_BAR;
        PG8_STAGE(PG8_SB(1, 0), cB + kstep, voffB); PG8_STAGE(PG8_SA(1, 0), cA + kstep, voffA); PG8_STAGE(PG8_SB(1, 1), cB + hstep + kstep, voffB);
        PG8_WAIT_V(6); PG8_BAR;
    } else {
        PG8_STAGE(PG8_SB(0, 0), cB, voffB); PG8_STAGE(PG8_SA(0, 0), cA, voffA); PG8_STAGE(PG8_SB(0, 1), cB + hstep, voffB); PG8_STAGE(PG8_SA(0, 1), cA + hstep, voffA);
        if (wr == 1) PG8_BAR;
        PG8_WAIT_V(4); PG8_BAR;
        PG8_STAGE(PG8_SB(1, 0), cB + kstep, voffB); PG8_STAGE(PG8_SA(1, 0), cA + kstep, voffA); PG8_STAGE(PG8_SB(1, 1), cB + hstep + kstep, voffB);
        PG8_WAIT_V(6); PG8_BAR;
    }
    for (;;) {
        const bool has_next = S.next(ui + 1, nxt);
        const char* nA = has_next ? (const char*)g.A + (size_t)S.apm(nxt) * tstep : cA; const char* nB = has_next ? (const char*)g.Bt + (size_t)S.bpn(nxt) * tstep : cB;
        for (int t = 0; t < nt; t += 2) {
            const bool last = (t == nt - 2);
            const char* a1 = cA + (size_t)(t + 1) * kstep;
            const char* a2 = last ? nA : cA + (size_t)(t + 2) * kstep; const char* b2 = last ? nB : cB + (size_t)(t + 2) * kstep;
            const char* a3 = a2 + kstep; const char* b3 = b2 + kstep;
            if (last && has_next) S.a_ready(nxt);
            if constexpr (SP2) {
            PG8_LDB(B0, 0, 0); PG8_LDB(B1, 0, 1); PG8_SCHED; PG8_LDA(At, 0, 0); PG8_STAGE(PG8_SA(1, 1), a1 + hstep, voffA);
            PG8_WAIT_V(8); PG8_WAIT_L(0); PG8_BAR; PG8_MMA(0, 0, At, B0); PG8_MMA(0, 1, At, B1); PG8_BAR; PG8_SCHED;
            PG8_LDA(At, 0, 1); PG8_STAGE(PG8_SB(0, 0), b2, voffB); PG8_STAGE(PG8_SB(0, 1), b2 + hstep, voffB); PG8_STAGE(PG8_SA(0, 0), a2, voffA);
            PG8_WAIT_V(8); PG8_WAIT_L(0); PG8_BAR; PG8_MMA(1, 0, At, B0); PG8_MMA(1, 1, At, B1); PG8_BAR; PG8_SCHED;
            PG8_LDB(B0, 1, 0); PG8_LDB(B1, 1, 1); PG8_SCHED; PG8_LDA(At, 1, 0); PG8_STAGE(PG8_SA(0, 1), a2 + hstep, voffA);
            PG8_WAIT_V(8); PG8_WAIT_L(0); PG8_BAR; PG8_MMA(0, 0, At, B0); PG8_MMA(0, 1, At, B1); PG8_BAR; PG8_SCHED;
            PG8_LDA(At, 1, 1); PG8_STAGE(PG8_SB(1, 0), b3, voffB); PG8_STAGE(PG8_SB(1, 1), b3 + hstep, voffB); PG8_STAGE(PG8_SA(1, 0), a3, voffA);
            PG8_WAIT_V(8); PG8_WAIT_L(0); PG8_BAR; PG8_MMA(1, 0, At, B0); PG8_MMA(1, 1, At, B1); PG8_BAR; PG8_SCHED;
            } else {
            PG8_LDB(B0, 0, 0); PG8_SCHED; PG8_LDA(At, 0, 0); PG8_STAGE(PG8_SA(1, 1), a1 + hstep, voffA);
            PG8_WAIT_L(8); PG8_BAR; PG8_WAIT_L(0); PG8_MMA(0, 0, At, B0); PG8_BAR; PG8_SCHED;
            PG8_LDB(B1, 0, 1); PG8_STAGE(PG8_SB(0, 0), b2, voffB);
            PG8_BAR; PG8_WAIT_L(0); PG8_MMA(0, 1, At, B1); PG8_BAR;
            PG8_LDA(At, 0, 1); PG8_STAGE(PG8_SA(0, 0), a2, voffA);
            PG8_BAR; PG8_WAIT_L(0); PG8_MMA(1, 0, At, B0); PG8_BAR; PG8_SCHED;
            PG8_STAGE(PG8_SB(0, 1), b2 + hstep, voffB);
            PG8_WAIT_V(6); PG8_BAR; PG8_MMA(1, 1, At, B1); PG8_BAR;
            PG8_LDB(B0, 1, 0); PG8_SCHED; PG8_LDA(At, 1, 0); PG8_STAGE(PG8_SA(0, 1), a2 + hstep, voffA);
            PG8_WAIT_L(8); PG8_BAR; PG8_WAIT_L(0); PG8_MMA(0, 0, At, B0); PG8_BAR; PG8_SCHED;
            PG8_LDB(B1, 1, 1); PG8_STAGE(PG8_SB(1, 0), b3, voffB);
            PG8_BAR; PG8_WAIT_L(0); PG8_MMA(0, 1, At, B1); PG8_BAR;
            PG8_LDA(At, 1, 1); PG8_STAGE(PG8_SA(1, 0), a3, voffA);
            PG8_BAR; PG8_WAIT_L(0); PG8_MMA(1, 0, At, B0); PG8_BAR; PG8_SCHED;
            PG8_STAGE(PG8_SB(1, 1), b3 + hstep, voffB);
            PG8_WAIT_V(6); PG8_BAR; PG8_MMA(1, 1, At, B1); PG8_BAR;
            }
        }
        if constexpr (ALIGN_EPI) { if (wr == 0) PG8_BAR; }
        if constexpr (!Epi::AFTER_DRAIN) { E(acc, cur, wr, wc, fr, fq); S.done(cur); }
        if (!has_next) break;
#pragma unroll
        for (int a = 0; a < 2; ++a)
#pragma unroll
            for (int b = 0; b < 2; ++b)
#pragma unroll
                for (int m = 0; m < 4; ++m)
#pragma unroll
                    for (int n = 0; n < 2; ++n) acc[a][b][m][n] = (f32x4){0.f, 0.f, 0.f, 0.f};
        cur = nxt; cA = nA; cB = nB; ++ui;
        if constexpr (ALIGN_EPI) { if (wr == 1) PG8_BAR; }
    }
    PG8_WAIT_V(0);
    if constexpr (!ALIGN_EPI) { if (wr == 0) PG8_BAR; }
    PG8_BAR;
    if constexpr (Epi::AFTER_DRAIN) { E.fused(acc, cur, wr, wc, fr, fq, lds, wid, lane); S.done(cur); }
#undef PG8_SA
#undef PG8_SB
#undef PG8_STAGE
#undef PG8_LDA
#undef PG8_LDB
#undef PG8_MMA
#undef PG8_WAIT_V
#undef PG8_WAIT_L
#undef PG8_BAR
#undef PG8_SCHED
}
}

constexpr int SEQ = 16384, DM = 4096, DEPTH = 4, NMEM = 256, BRW = 3072, MEMW = 1024, NHEAD = 4, HDIM = 256;
constexpr int NIN_CONV = 14336, NIN_GMLP = 11264, NKV = 2048;
constexpr float RMS_EPS = 1e-6f, LNORM_EPS = 1e-5f;
constexpr int NWAVES = 8;
#ifndef MK_ONE_LAUNCH
#define MK_ONE_LAUNCH 1
#endif
constexpr int NPHASE = 2 + 4 * DEPTH;
#ifndef REP_P0
#define REP_P0 1
#endif
#ifndef REP_P1
#define REP_P1 1
#endif
#ifndef REP_P2
#define REP_P2 1
#endif
#ifndef REP_P3
#define REP_P3 1
#endif
#ifndef REP_P2G
#define REP_P2G 1
#endif
#ifndef REP_ATT
#define REP_ATT 1
#endif
#ifndef TLB_WARM
#define TLB_WARM 0
#endif
#ifndef REP_ALL
#define REP_ALL 1
#endif
#ifndef REP_P4
#define REP_P4 1
#endif
#ifndef REP_KV
#define REP_KV 1
#endif
#ifndef REP_BAR
#define REP_BAR 1
#endif
#ifndef GP_ALIGN
#define GP_ALIGN true
#endif
#ifndef GP_SP2
#define GP_SP2 true
#endif
#ifndef FAKE_P3
#define FAKE_P3 0
#endif
#ifndef REP_SYNC
#define REP_SYNC 0
#endif
#ifndef GRID_PER_LAYER
#define GRID_PER_LAYER 1
#endif

constexpr size_t MiB = 1u << 20;
constexpr size_t WS_CTL = 0, CTL_ZERO_BYTES = 1 * MiB;
constexpr size_t WS_WIN = 2 * MiB;
constexpr size_t WIN_OFF0 = 0, WIN_OFF1 = 112 * MiB, WIN_OFF2 = 200 * MiB, WIN_OFF3 = 312 * MiB;
constexpr size_t WS_WOUT = WS_WIN + 400 * MiB;
constexpr size_t WS_WKV = WS_WOUT + 128 * MiB;
constexpr size_t WS_MEMB = WS_WKV + 64 * MiB;
constexpr size_t WS_KV = WS_MEMB + 2 * MiB;
constexpr size_t WS_XB = WS_KV + 4 * MiB;
constexpr size_t WS_A1 = WS_XB + 128 * MiB;
constexpr size_t WS_A2 = WS_A1 + 96 * MiB;
constexpr size_t WS_Q = WS_A2 + 96 * MiB;
constexpr size_t WS_SZ = WS_Q + 32 * MiB;
constexpr size_t WS_Y = WS_SZ + 32 * MiB;
constexpr size_t WS_YO = WS_Y + 128 * MiB;
constexpr size_t WS_RSTD = WS_YO + 128 * MiB;
constexpr size_t WS_RSTDM = WS_RSTD + 1 * MiB;
constexpr size_t WS_VST = WS_RSTDM + 1 * MiB;
constexpr size_t WS_YSS = WS_VST + 6 * MiB;
constexpr size_t WS_HN = WS_YSS + 4 * MiB;
constexpr size_t WS_CHT = WS_HN + 128 * MiB;
constexpr size_t WS_GZH = WS_CHT + 12 * MiB;
constexpr size_t WS_END = WS_GZH + 12 * MiB;
static_assert(WS_A2 - WS_A1 == 2 * pg8::EpiProj::OFF_A2 && WS_Q - WS_A1 == 2 * pg8::EpiProj::OFF_Q && WS_SZ - WS_A1 == 2 * pg8::EpiProj::OFF_SZ, "EpiProj output offsets");
constexpr int CW_BAR = 4096;

constexpr int RING_BYTES = 131072;
constexpr int LDS_BYTES = 147456;
constexpr int MISC_OFF = LDS_BYTES - 128;

#define GAS __attribute__((address_space(1)))
#define LAS __attribute__((address_space(3)))
typedef unsigned short bf16;
typedef unsigned v4u __attribute__((ext_vector_type(4)));
typedef unsigned v2u __attribute__((ext_vector_type(2)));
typedef float f32x4 __attribute__((ext_vector_type(4)));
typedef short bf16x8 __attribute__((ext_vector_type(8)));
#define LDS_WAIT() asm volatile("s_waitcnt lgkmcnt(0)" ::: "memory")
__device__ __forceinline__ unsigned f2bf(float f) { unsigned u = __builtin_bit_cast(unsigned, f); return (u + 0x7fffu + ((u >> 16) & 1u)) >> 16; }
__device__ __forceinline__ unsigned pk2(float lo, float hi) { return pg8::cvt_pk_bf16(lo, hi); }
__device__ __forceinline__ float bflo(unsigned w) { return __builtin_bit_cast(float, w << 16); }
__device__ __forceinline__ float bfhi(unsigned w) { return __builtin_bit_cast(float, w & 0xffff0000u); }
__device__ __forceinline__ float wave_sum(float v) {
#pragma unroll
    for (int o = 1; o < 64; o <<= 1) v += __shfl_xor(v, o);
    return v;
}

#define XB_TMO      128
#define XB_XCNT(j)  (256  + 64 * (j))
#define XB_XSUB(j)  (1280 + 64 * (j))
#define XB_XGEN(j)  (2304 + 64 * (j))
#define XB_TOP      3328
#define XB_TOPGEN   3392
#define XCD_BAR_WORDS 3456
#define XB_SPIN_CAP (1u << 18)

__device__ __forceinline__ unsigned xb_ld(unsigned* p)              { return __hip_atomic_load(p, __ATOMIC_RELAXED, __HIP_MEMORY_SCOPE_AGENT); }
__device__ __forceinline__ unsigned xb_add(unsigned* p, unsigned v) { return __hip_atomic_fetch_add(p, v, __ATOMIC_RELAXED, __HIP_MEMORY_SCOPE_AGENT); }
__device__ __forceinline__ unsigned xb_xcc_id() { return (unsigned)__builtin_amdgcn_s_getreg((3 << 11) | 20) & 0xFu; }
#define XB_SPIN(cond, bar) do { unsigned _sp = 0; while (cond) { __builtin_amdgcn_s_sleep(1); \
    if ((++_sp & 255u) == 0u) { if (xb_ld(&(bar)[XB_TMO])) break; if (_sp > XB_SPIN_CAP) { atomicAdd(&(bar)[XB_TMO], 1u); break; } } } } while (0)

struct XcdBarrier {
    unsigned* bar; unsigned x;
    volatile LAS unsigned* st;
};
__device__ __forceinline__ XcdBarrier xcd_barrier_post(unsigned* bar, volatile LAS unsigned* st) {
    XcdBarrier b; b.bar = bar; b.x = xb_xcc_id(); b.st = st;
    if (threadIdx.x == 0) (void)xb_add(&bar[XB_XCNT(b.x)], 1u);
    return b;
}
__device__ __forceinline__ void xcd_barrier_complete(unsigned* bar, unsigned x, unsigned& nloc, unsigned& nx) {
    const unsigned G = gridDim.x * gridDim.y * gridDim.z;
    unsigned sum, cnt, mine, sp = 0u;
    for (;;) {
        sum = 0u; cnt = 0u; mine = 0u;
#pragma unroll
        for (unsigned j = 0; j < 16; ++j) { const unsigned c = xb_ld(&bar[XB_XCNT(j)]); sum += c; cnt += (c > 0u) ? 1u : 0u; mine = (j == x) ? c : mine; }
        if (sum == G) break;
        __builtin_amdgcn_s_sleep(1);
        if ((++sp & 255u) == 0u) { if (xb_ld(&bar[XB_TMO])) break; if (sp > XB_SPIN_CAP) { atomicAdd(&bar[XB_TMO], 1u); break; } }
    }
    nloc = mine > 0u ? mine : 1u; nx = cnt > 0u ? cnt : 1u;
}
__device__ __forceinline__ void xcd_barrier(const XcdBarrier& b) {
    asm volatile("s_waitcnt vmcnt(0)" ::: "memory");
    __syncthreads();
    if (threadIdx.x == 0) {
        unsigned* bar = b.bar;
        __builtin_amdgcn_s_waitcnt(0);
        unsigned nloc = b.st[0], nx = b.st[1];
        if (nloc == 0u) { xcd_barrier_complete(bar, b.x, nloc, nx); b.st[0] = nloc; b.st[1] = nx; }
        const unsigned old = xb_add(&bar[XB_XSUB(b.x)], 1u);
        const unsigned gen = old / nloc;
        if (old + 1u == (gen + 1u) * nloc) {
            __builtin_amdgcn_fence(__ATOMIC_RELEASE, "agent");
            asm volatile("s_waitcnt vmcnt(0)" ::: "memory");
            const unsigned og = xb_add(&bar[XB_TOP], 1u);
            const unsigned tg = og / nx;
            if (og + 1u == (tg + 1u) * nx) xb_add(&bar[XB_TOPGEN], 1u);
            else XB_SPIN(xb_ld(&bar[XB_TOPGEN]) == tg, bar);
            __builtin_amdgcn_fence(__ATOMIC_ACQUIRE, "agent");
            xb_add(&bar[XB_XGEN(b.x)], 1u);
            asm volatile("s_waitcnt vmcnt(0)" ::: "memory");
        } else {
            XB_SPIN(xb_ld(&bar[XB_XGEN(b.x)]) == gen, bar);
            __builtin_amdgcn_fence(__ATOMIC_ACQUIRE, "agent");
            asm volatile("s_waitcnt vmcnt(0)" ::: "memory");
        }
    }
    __syncthreads();
}

__device__ __forceinline__ void src_conv(int gi, int& sa, int& sb, bool& perm) { const int pn = gi >> 3, bj = (gi >> 2) & 1, wc = gi & 3;
    if (pn < 48) { sa = (bj ? 6144 : 0) + 64 * pn + 16 * wc; sb = (bj ? 10240 : 3072) + 64 * pn + 16 * wc; perm = false; return; }
    const int s32 = (pn < 52) ? 9216 + 256 * (pn - 48) + 128 * bj + 32 * wc : 13312 + 256 * (pn - 52) + 128 * bj + 32 * wc;
    sa = s32; sb = s32 + 16; perm = true; }
__device__ __forceinline__ int src32_gmlp(int gi) { const int pn = gi >> 3, bj = (gi >> 2) & 1, wc = gi & 3;
    if (pn < 24) return (bj ? 7168 : 0) + 128 * pn + 32 * wc;
    if (pn < 36) return 3072 + 256 * (pn - 24) + 128 * bj + 32 * wc;
    if (pn < 40) return 6144 + 256 * (pn - 36) + 128 * bj + 32 * wc;
    return 10240 + 256 * (pn - 40) + 128 * bj + 32 * wc; }
__device__ __forceinline__ void cvt_item(const float* W, int N, int sa, int sb, bool perm, const float* gk, bf16* WT, int slot0, int k0, LAS float* scr, int lane) {
    const int l31 = lane & 31, scol = (l31 < 16) ? sa + l31 : sb + l31 - 16;
#pragma unroll 8
    for (int i = 0; i < 32; ++i) { const int kk = 2 * i + (lane >> 5); scr[kk * 33 + l31] = W[(size_t)(k0 + kk) * N + scol]; }
    const int c = lane & 7;
    f32x4 g0 = (f32x4){1.f, 1.f, 1.f, 1.f}, g1 = g0;
    if (gk) { g0 = *(const f32x4*)(gk + k0 + 8 * c); g1 = *(const f32x4*)(gk + k0 + 8 * c + 4); }
    LDS_WAIT(); asm volatile("" ::: "memory");
#pragma unroll
    for (int j = 0; j < 4; ++j) { const int n = (lane >> 3) + 8 * j; const LAS float* s = scr + (8 * c) * 33 + (perm ? pg8::perm32(n) : n);
        v4u o; o.x = pk2(s[0 * 33] * g0[0], s[1 * 33] * g0[1]); o.y = pk2(s[2 * 33] * g0[2], s[3 * 33] * g0[3]); o.z = pk2(s[4 * 33] * g1[0], s[5 * 33] * g1[1]); o.w = pk2(s[6 * 33] * g1[2], s[7 * 33] * g1[3]);
        *(v4u*)(WT + (size_t)(slot0 + n) * DM + k0 + 8 * c) = o; }
    LDS_WAIT(); asm volatile("" ::: "memory");
}
__device__ __forceinline__ void row_to_bf16(const float* xr, float* rms_out  , bf16* nrow, int lane) {
    f32x4 v[16]; float ss = 0.f;
#pragma unroll
    for (int i = 0; i < 8; ++i) { const int col = 512 * i + 8 * lane; const f32x4 a = *(const f32x4*)(xr + col), b = *(const f32x4*)(xr + col + 4); v[2 * i] = a; v[2 * i + 1] = b;
        ss += (a[0] * a[0] + a[1] * a[1]) + (a[2] * a[2] + a[3] * a[3]) + (b[0] * b[0] + b[1] * b[1]) + (b[2] * b[2] + b[3] * b[3]); }
    ss = wave_sum(ss);
    const float rms = sqrtf(ss * (1.0f / DM) + RMS_EPS), rs = 1.0f / rms;
    if (rms_out && lane == 0) *rms_out = rms;
#pragma unroll
    for (int i = 0; i < 8; ++i) { const int col = 512 * i + 8 * lane; const f32x4 a = v[2 * i], b = v[2 * i + 1];
        v4u n; n.x = pk2(a[0] * rs, a[1] * rs); n.y = pk2(a[2] * rs, a[3] * rs); n.z = pk2(b[0] * rs, b[1] * rs); n.w = pk2(b[2] * rs, b[3] * rs); *(v4u*)(nrow + col) = n; }
}

struct Args { const float* in[14]; float* out; unsigned char* ws; int ph_lo, ph_hi; };

constexpr int I_KV = 64 * (NKV / 32), I_OUT = 64 * (DM / 32), I_CONV = 64 * (NIN_CONV / 32), I_GMLP = 64 * (NIN_GMLP / 32);
constexpr int NITEMS = 4 * I_KV + 4 * I_OUT + 2 * I_CONV + 2 * I_GMLP;
__device__ __forceinline__ void p0_item(const Args& a, unsigned char* ws, LAS float* scr, int it, int lane) {
    const float* pre_g = a.in[2]; const float* mem_g = a.in[4]; const float* w_kv = a.in[5]; const float* w_out = a.in[6]; const float* conv_w_in = a.in[7]; const float* gmlp_w_in = a.in[9];
    int r = it; const float* W; const float* gk; bf16* WT; int N, ng, type;
    if (r < 4 * I_KV) { const int l = r / I_KV; r -= l * I_KV; W = w_kv + (size_t)l * DM * NKV; N = NKV; ng = NKV / 32; type = 2; gk = mem_g + l * DM; WT = (bf16*)(ws + WS_WKV) + (size_t)l * NKV * DM; }
    else { r -= 4 * I_KV;
        if (r < 4 * I_OUT) { const int l = r / I_OUT; r -= l * I_OUT; W = w_out + (size_t)l * DM * DM; N = DM; ng = DM / 32; type = 2; gk = nullptr; WT = (bf16*)(ws + WS_WOUT) + (size_t)l * DM * DM; }
        else { r -= 4 * I_OUT;
            if (r < 2 * I_CONV) { const int j = r / I_CONV; r -= j * I_CONV; W = conv_w_in + (size_t)j * DM * NIN_CONV; N = NIN_CONV; ng = NIN_CONV / 32; type = 0; gk = pre_g + (2 * j) * DM; WT = (bf16*)(ws + WS_WIN + (j ? WIN_OFF2 : WIN_OFF0)); }
            else { r -= 2 * I_CONV; const int j = r / I_GMLP; r -= j * I_GMLP; W = gmlp_w_in + (size_t)j * DM * NIN_GMLP; N = NIN_GMLP; ng = NIN_GMLP / 32; type = 1; gk = pre_g + (2 * j + 1) * DM; WT = (bf16*)(ws + WS_WIN + (j ? WIN_OFF3 : WIN_OFF1)); } } }
    const int kb = r / ng, gi = r - kb * ng;
    int sa, sb; bool perm = true;
    if (type == 0) src_conv(gi, sa, sb, perm); else { sa = (type == 1) ? src32_gmlp(gi) : 32 * gi; sb = sa + 16; }
    cvt_item(W, N, sa, sb, perm, gk, WT, 32 * gi, 64 * kb, scr, lane);
}
__device__ __forceinline__ void p0a_convert(const Args& a, unsigned char* ws, LAS unsigned char* lds, int gw, int NGW, int wave, int lane) {
    LAS float* scr = (LAS float*)(lds + wave * 16384);
    for (int it = gw; it < 4 * I_KV; it += NGW) p0_item(a, ws, scr, it, lane);
    for (int m = gw; m < NMEM; m += NGW) row_to_bf16(a.in[1] + (size_t)m * DM, nullptr, (bf16*)(ws + WS_MEMB) + (size_t)m * DM, lane);
}
constexpr int CW_Q0 = 96;
__device__ __forceinline__ void p0b_convert(const Args& a, unsigned char* ws, LAS unsigned char* lds, int gw, int NGW, int wave, int lane) {
    LAS float* scr = (LAS float*)(lds + wave * 16384);
    unsigned* q = (unsigned*)(ws + WS_CTL) + CW_Q0;
    for (;;) { unsigned b = 0u; if (lane == 0) b = __hip_atomic_fetch_add(q, 16u, __ATOMIC_RELAXED, __HIP_MEMORY_SCOPE_AGENT);
        const int base = 4 * I_KV + (int)__builtin_amdgcn_readfirstlane(b); if (base >= NITEMS) break;
        for (int i = 0; i < 16; ++i) if (base + i < NITEMS) p0_item(a, ws, scr, base + i, lane); }
    for (int m = gw; m < SEQ; m += NGW) row_to_bf16(a.in[0] + (size_t)m * DM, (float*)(ws + WS_RSTD) + m, (bf16*)(ws + WS_HN) + (size_t)m * DM, lane);
}

constexpr int AT_LD = 264;
static_assert(256 * AT_LD * 2 <= MISC_OFF, "attention LDS map");
__device__ __forceinline__ void attn_stage(const bf16* src, size_t row_pitch, LAS unsigned char* lds, int tid_in) {
    int tid = tid_in; asm volatile("" : "+v"(tid));
    const bf16* g = src + (size_t)(tid >> 5) * row_pitch + 8 * (tid & 31);
    LAS unsigned char* l = lds + (tid >> 5) * (AT_LD * 2) + 16 * (tid & 31);
    v4u r[16];
#pragma unroll
    for (int it = 0; it < 16; ++it) r[it] = *(const v4u*)(g + (size_t)(16 * it) * row_pitch);
#pragma unroll
    for (int it = 0; it < 16; ++it) *(LAS v4u*)(l + it * (16 * AT_LD * 2)) = r[it];
}
__device__ __forceinline__ void attn_wg(const bf16* Q, const bf16* SZ, const bf16* Kl, const bf16* VTl, bf16* Y, int pb, int h, LAS unsigned char* lds, int tid) {
    const int lane = tid & 63, wave = __builtin_amdgcn_readfirstlane(tid >> 6), fr = lane & 15, fq = lane >> 4;
    const int t0 = 256 * pb + 32 * wave;
    attn_stage(Kl + HDIM * h, MEMW, lds, tid);
    const bf16* qp0 = Q + (size_t)(t0 + fr) * MEMW + HDIM * h + 8 * fq; const bf16* qp1 = qp0 + (size_t)16 * MEMW;
    bf16x8 qa = *(const bf16x8*)qp0, qb = *(const bf16x8*)qp1, qa1 = *(const bf16x8*)(qp0 + 32), qb1 = *(const bf16x8*)(qp1 + 32), qa2 = *(const bf16x8*)(qp0 + 64), qb2 = *(const bf16x8*)(qp1 + 64);
    __syncthreads();
    const LAS bf16* lrow = (const LAS bf16*)lds + (8 * (fr >> 2) + (fr & 3)) * AT_LD + 8 * fq;
    f32x4 s[2][16];
#pragma unroll
    for (int i = 0; i < 16; ++i) { s[0][i] = (f32x4){0.f, 0.f, 0.f, 0.f}; s[1][i] = s[0][i]; }
#pragma unroll 1
    for (int ks = 0; ks < 8; ++ks) {
        const int kn = (ks < 5) ? ks + 3 : 7; const bf16x8 qan = *(const bf16x8*)(qp0 + 32 * kn), qbn = *(const bf16x8*)(qp1 + 32 * kn);
#pragma unroll
        for (int g = 0; g < 8; ++g)
#pragma unroll
            for (int e = 0; e < 2; ++e) { const bf16x8 kf = *(const LAS bf16x8*)(lrow + (32 * g + 4 * e) * AT_LD + 32 * ks);
                s[0][2 * g + e] = __builtin_amdgcn_mfma_f32_16x16x32_bf16(kf, qa, s[0][2 * g + e], 0, 0, 0); s[1][2 * g + e] = __builtin_amdgcn_mfma_f32_16x16x32_bf16(kf, qb, s[1][2 * g + e], 0, 0, 0); }
        qa = qa1; qb = qb1; qa1 = qa2; qb1 = qb2; qa2 = qan; qb2 = qbn; }
    float inv[2]; bf16x8 pf[2][8];
#pragma unroll
    for (int tg = 0; tg < 2; ++tg) { float mx = s[tg][0][0];
#pragma unroll
        for (int i = 0; i < 16; ++i)
#pragma unroll
            for (int j = 0; j < 4; ++j) mx = fmaxf(mx, s[tg][i][j]);
        mx = fmaxf(mx, __shfl_xor(mx, 16)); mx = fmaxf(mx, __shfl_xor(mx, 32));
        float sum = 0.f; const float mxl = mx * 1.44269504f;
#pragma unroll
        for (int i = 0; i < 16; ++i)
#pragma unroll
            for (int j = 0; j < 4; ++j) { const float p = __builtin_amdgcn_exp2f(s[tg][i][j] * 1.44269504f - mxl); s[tg][i][j] = p; sum += p; }
        sum += __shfl_xor(sum, 16); sum += __shfl_xor(sum, 32); inv[tg] = 1.0f / sum;
#pragma unroll
        for (int g = 0; g < 8; ++g) { v4u w; w.x = pk2(s[tg][2 * g][0], s[tg][2 * g][1]); w.y = pk2(s[tg][2 * g][2], s[tg][2 * g][3]); w.z = pk2(s[tg][2 * g + 1][0], s[tg][2 * g + 1][1]); w.w = pk2(s[tg][2 * g + 1][2], s[tg][2 * g + 1][3]);
            pf[tg][g] = __builtin_bit_cast(bf16x8, w); } }
    __syncthreads();
    attn_stage(VTl + (size_t)HDIM * h * NMEM, NMEM, lds, tid);
    __syncthreads();
    const bf16* szp0 = SZ + (size_t)(t0 + fr) * MEMW + HDIM * h + 8 * fq; const bf16* szp1 = szp0 + (size_t)16 * MEMW;
    v4u z0 = *(const v4u*)szp0, z1 = *(const v4u*)szp1;
#pragma unroll 1
    for (int db2 = 0; db2 < 8; ++db2) { f32x4 o[2][2];
        const int dn = (db2 < 7) ? db2 + 1 : 7; const v4u z0n = *(const v4u*)(szp0 + 32 * dn), z1n = *(const v4u*)(szp1 + 32 * dn);
#pragma unroll
        for (int tg = 0; tg < 2; ++tg) { o[tg][0] = (f32x4){0.f, 0.f, 0.f, 0.f}; o[tg][1] = o[tg][0]; }
#pragma unroll
        for (int ks2 = 0; ks2 < 8; ++ks2)
#pragma unroll
            for (int e = 0; e < 2; ++e) { const bf16x8 vf = *(const LAS bf16x8*)(lrow + (32 * db2 + 4 * e) * AT_LD + 32 * ks2);
                o[0][e] = __builtin_amdgcn_mfma_f32_16x16x32_bf16(vf, pf[0][ks2], o[0][e], 0, 0, 0); o[1][e] = __builtin_amdgcn_mfma_f32_16x16x32_bf16(vf, pf[1][ks2], o[1][e], 0, 0, 0); }
#pragma unroll
        for (int tg = 0; tg < 2; ++tg) { const size_t t = (size_t)(t0 + 16 * tg + fr); const int col = HDIM * h + 32 * db2 + 8 * fq; const float iv = inv[tg];
            const v4u z = tg ? z1 : z0;
            v4u w; w.x = pk2(o[tg][0][0] * iv * bflo(z.x), o[tg][0][1] * iv * bfhi(z.x)); w.y = pk2(o[tg][0][2] * iv * bflo(z.y), o[tg][0][3] * iv * bfhi(z.y));
            w.z = pk2(o[tg][1][0] * iv * bflo(z.z), o[tg][1][1] * iv * bfhi(z.z)); w.w = pk2(o[tg][1][2] * iv * bflo(z.w), o[tg][1][3] * iv * bfhi(z.w));
            *(v4u*)(Y + t * DM + BRW + col) = w; }
        z0 = z0n; z1 = z1n; }
    __syncthreads();
}

constexpr int CONV_ROWS = 16;
__device__ __forceinline__ void conv_rows(const bf16* GZ, const bf16* CH, const float* cw  , bf16* Y, int t0, int cs, int lane) {
    const int c = 512 * cs + 8 * lane;
    const int th = (t0 >= 2) ? t0 - 2 : 0; const float hz = (t0 >= 2) ? 1.f : 0.f;
    v4u uc[CONV_ROWS + 2], ug[CONV_ROWS];
    uc[0] = *(const v4u*)(CH + (size_t)th * BRW + c); uc[1] = *(const v4u*)(CH + (size_t)(th + 1) * BRW + c);
#pragma unroll
    for (int r = 0; r < CONV_ROWS; ++r) { uc[r + 2] = *(const v4u*)(CH + (size_t)(t0 + r) * BRW + c); ug[r] = *(const v4u*)(GZ + (size_t)(t0 + r) * BRW + c); }
    float w0[8], w1[8], w2[8], p2[8], p1[8];
    { const f32x4 a = *(const f32x4*)(cw + c), b = *(const f32x4*)(cw + c + 4), d = *(const f32x4*)(cw + BRW + c), e = *(const f32x4*)(cw + BRW + c + 4), f = *(const f32x4*)(cw + 2 * BRW + c), g = *(const f32x4*)(cw + 2 * BRW + c + 4);
#pragma unroll
      for (int i = 0; i < 4; ++i) { w0[i] = a[i]; w0[4 + i] = b[i]; w1[i] = d[i]; w1[4 + i] = e[i]; w2[i] = f[i]; w2[4 + i] = g[i]; } }
    p2[0] = bflo(uc[0].x) * hz; p2[1] = bfhi(uc[0].x) * hz; p2[2] = bflo(uc[0].y) * hz; p2[3] = bfhi(uc[0].y) * hz; p2[4] = bflo(uc[0].z) * hz; p2[5] = bfhi(uc[0].z) * hz; p2[6] = bflo(uc[0].w) * hz; p2[7] = bfhi(uc[0].w) * hz;
    p1[0] = bflo(uc[1].x) * hz; p1[1] = bfhi(uc[1].x) * hz; p1[2] = bflo(uc[1].y) * hz; p1[3] = bfhi(uc[1].y) * hz; p1[4] = bflo(uc[1].z) * hz; p1[5] = bfhi(uc[1].z) * hz; p1[6] = bflo(uc[1].w) * hz; p1[7] = bfhi(uc[1].w) * hz;
#pragma unroll
    for (int r = 0; r < CONV_ROWS; ++r) { const v4u u = uc[r + 2], q = ug[r];
        float cu[8], gz[8], o[8];
        cu[0] = bflo(u.x); cu[1] = bfhi(u.x); cu[2] = bflo(u.y); cu[3] = bfhi(u.y); cu[4] = bflo(u.z); cu[5] = bfhi(u.z); cu[6] = bflo(u.w); cu[7] = bfhi(u.w);
        gz[0] = bflo(q.x); gz[1] = bfhi(q.x); gz[2] = bflo(q.y); gz[3] = bfhi(q.y); gz[4] = bflo(q.z); gz[5] = bfhi(q.z); gz[6] = bflo(q.w); gz[7] = bfhi(q.w);
#pragma unroll
        for (int i = 0; i < 8; ++i) { o[i] = gz[i] * (w0[i] * p2[i] + w1[i] * p1[i] + w2[i] * cu[i]); p2[i] = p1[i]; p1[i] = cu[i]; }
        v4u w; w.x = pk2(o[0], o[1]); w.y = pk2(o[2], o[3]); w.z = pk2(o[4], o[5]); w.w = pk2(o[6], o[7]);
        *(v4u*)(Y + (size_t)(t0 + r) * DM + c) = w; }
}

constexpr int SP_LD = 136;
constexpr int SP_WL = 0, SP_VTL = 128 * SP_LD * 2, SP_MU = SP_VTL + 384 * SP_LD * 2, SP_RS = SP_MU + 512, SP_END = SP_RS + 512;
static_assert(SP_END <= MISC_OFF, "spatial LDS map");
__device__ __forceinline__ void spatial_unit(const bf16* VG, const bf16* UZ, const float* vst, const float* Wg, const float* bsg, const float* lng, const float* lnb, bf16* Y, int nb, int g, LAS unsigned char* lds, int tid) {
    LAS bf16* WL = (LAS bf16*)(lds + SP_WL); LAS bf16* VTL = (LAS bf16*)(lds + SP_VTL); LAS float* MU = (LAS float*)(lds + SP_MU); LAS float* RS = (LAS float*)(lds + SP_RS);
    const int lane = tid & 63, wave = __builtin_amdgcn_readfirstlane(tid >> 6), fr = lane & 15, fq = lane >> 4;
    { const int row = tid >> 2, part = tid & 3; const float* q = vst + (size_t)(128 * nb + row) * 96 + 24 * part; float s1 = 0.f, s2 = 0.f;
        f32x4 pq[6];
#pragma unroll
        for (int k = 0; k < 6; ++k) pq[k] = *(const f32x4*)(q + 4 * k);
#pragma unroll
        for (int k = 0; k < 6; ++k) { s1 += pq[k][0] + pq[k][2]; s2 += pq[k][1] + pq[k][3]; }
        s1 += __shfl_xor(s1, 1); s1 += __shfl_xor(s1, 2); s2 += __shfl_xor(s2, 1); s2 += __shfl_xor(s2, 2);
        if (part == 0) { const float mu = s1 * (1.0f / BRW), var = s2 * (1.0f / BRW) - mu * mu; MU[row] = mu; RS[row] = 1.0f / sqrtf(var + LNORM_EPS); } }
    { const int t = tid >> 2, s0 = (tid & 3) * 32;
#pragma unroll
        for (int q = 0; q < 4; ++q) { const int sb = s0 + 8 * q; const f32x4 a = *(const f32x4*)(Wg + t * 128 + sb), b = *(const f32x4*)(Wg + t * 128 + sb + 4);
            float v[8] = {a[0], a[1], a[2], a[3], b[0], b[1], b[2], b[3]};
#pragma unroll
            for (int e = 0; e < 8; ++e) v[e] = (sb + e <= t) ? v[e] : 0.f;
            v4u o; o.x = pk2(v[0], v[1]); o.y = pk2(v[2], v[3]); o.z = pk2(v[4], v[5]); o.w = pk2(v[6], v[7]);
            *(LAS v4u*)(WL + t * SP_LD + sb) = o; } }
    __syncthreads();
    { const int s = (lane & 31) + 32 * (wave & 3); const float mu = MU[s], rs = RS[s];
#pragma unroll
        for (int it = 0; it < 12; ++it) { const int c = 8 * ((lane >> 5) + 2 * (wave >> 2) + 4 * it);
            const v4u u = *(const v4u*)(VG + (size_t)(128 * nb + s) * BRW + 384 * g + c);
            const f32x4 g0 = *(const f32x4*)(lng + 384 * g + c), g1 = *(const f32x4*)(lng + 384 * g + c + 4), b0 = *(const f32x4*)(lnb + 384 * g + c), b1 = *(const f32x4*)(lnb + 384 * g + c + 4);
            float v[8] = {bflo(u.x), bfhi(u.x), bflo(u.y), bfhi(u.y), bflo(u.z), bfhi(u.z), bflo(u.w), bfhi(u.w)};
#pragma unroll
            for (int e = 0; e < 8; ++e) { const float gg = e < 4 ? g0[e & 3] : g1[e & 3], bb = e < 4 ? b0[e & 3] : b1[e & 3]; VTL[(c + e) * SP_LD + s] = (bf16)f2bf((v[e] - mu) * rs * gg + bb); } } }
    __syncthreads();
    const int th = wave >> 2, d0w = 96 * (wave & 3);
    f32x4 acc[4][3][2];
#pragma unroll
    for (int i = 0; i < 4; ++i)
#pragma unroll
        for (int dp = 0; dp < 3; ++dp) { acc[i][dp][0] = (f32x4){0.f, 0.f, 0.f, 0.f}; acc[i][dp][1] = (f32x4){0.f, 0.f, 0.f, 0.f}; }
#pragma unroll
    for (int i = 0; i < 4; ++i) { const int tb = th ? ((i == 0) ? 1 : (i == 1) ? 2 : (i == 2) ? 5 : 6) : ((i == 0) ? 0 : (i == 1) ? 3 : (i == 2) ? 4 : 7); const int kmax = tb >> 1;
#pragma unroll
        for (int ks = 0; ks < 4; ++ks) if (ks <= kmax) {
            const bf16x8 bw = *(const LAS bf16x8*)(WL + (16 * tb + fr) * SP_LD + 32 * ks + 8 * fq);
#pragma unroll
            for (int dp = 0; dp < 3; ++dp)
#pragma unroll
                for (int e = 0; e < 2; ++e) { const bf16x8 av = *(const LAS bf16x8*)(VTL + (d0w + 32 * dp + 8 * (fr >> 2) + 4 * e + (fr & 3)) * SP_LD + 32 * ks + 8 * fq);
                    acc[i][dp][e] = __builtin_amdgcn_mfma_f32_16x16x32_bf16(av, bw, acc[i][dp][e], 0, 0, 0); } } }
#pragma unroll
    for (int i = 0; i < 4; ++i) { const int tb = th ? ((i == 0) ? 1 : (i == 1) ? 2 : (i == 2) ? 5 : 6) : ((i == 0) ? 0 : (i == 1) ? 3 : (i == 2) ? 4 : 7);
        const int tl = 16 * tb + fr; const float bs = bsg[tl]; const size_t row = (size_t)(128 * nb + tl);
#pragma unroll
        for (int dp = 0; dp < 3; ++dp) { const int d = 384 * g + d0w + 32 * dp + 8 * fq; const v4u u = *(const v4u*)(UZ + row * BRW + d);
            const f32x4 f0 = acc[i][dp][0] + bs, f1 = acc[i][dp][1] + bs;
            v4u w; w.x = pk2(bflo(u.x) * f0[0], bfhi(u.x) * f0[1]); w.y = pk2(bflo(u.y) * f0[2], bfhi(u.y) * f0[3]); w.z = pk2(bflo(u.z) * f1[0], bfhi(u.z) * f1[1]); w.w = pk2(bflo(u.w) * f1[2], bfhi(u.w) * f1[3]);
            *(v4u*)(Y + row * DM + d) = w; } }
    __syncthreads();
}

__device__ __forceinline__ void p4_rows(const bf16* YO, const float* yss, const float* gpost, bf16* HN, float* rmsv, bf16* HNw, float* rmsw, float* out, bool last, int m0, int nrows, int lane) {
    for (int m = m0; m < m0 + nrows; ++m) {
        const float tot = wave_sum(yss[(size_t)m * 64 + lane]); const float rsy = 1.0f / sqrtf(tot * (1.0f / DM) + RMS_EPS); const float rmo = rmsv[m];
        float ss = 0.f; float xn[8][8];
#pragma unroll
        for (int i = 0; i < 8; ++i) { const int col = 512 * i + 8 * lane;
            const v4u yo = *(const v4u*)(YO + (size_t)m * DM + col), hb = *(const v4u*)(HN + (size_t)m * DM + col); const f32x4 g0 = *(const f32x4*)(gpost + col) * rsy, g1 = *(const f32x4*)(gpost + col + 4) * rsy;
            xn[i][0] = bflo(hb.x) * rmo + bflo(yo.x) * g0[0]; xn[i][1] = bfhi(hb.x) * rmo + bfhi(yo.x) * g0[1]; xn[i][2] = bflo(hb.y) * rmo + bflo(yo.y) * g0[2]; xn[i][3] = bfhi(hb.y) * rmo + bfhi(yo.y) * g0[3];
            xn[i][4] = bflo(hb.z) * rmo + bflo(yo.z) * g1[0]; xn[i][5] = bfhi(hb.z) * rmo + bfhi(yo.z) * g1[1]; xn[i][6] = bflo(hb.w) * rmo + bflo(yo.w) * g1[2]; xn[i][7] = bfhi(hb.w) * rmo + bfhi(yo.w) * g1[3];
#pragma unroll
            for (int e = 0; e < 8; ++e) ss += xn[i][e] * xn[i][e];
            if (last) { *(f32x4*)(out + (size_t)m * DM + col) = (f32x4){xn[i][0], xn[i][1], xn[i][2], xn[i][3]}; *(f32x4*)(out + (size_t)m * DM + col + 4) = (f32x4){xn[i][4], xn[i][5], xn[i][6], xn[i][7]}; } }
        if (!last) { ss = wave_sum(ss); const float rmn = sqrtf(ss * (1.0f / DM) + RMS_EPS), rs = 1.0f / rmn;
            if (lane == 0) rmsw[m] = rmn;
#pragma unroll
            for (int i = 0; i < 8; ++i) { const int col = 512 * i + 8 * lane;
                v4u w; w.x = pk2(xn[i][0] * rs, xn[i][1] * rs); w.y = pk2(xn[i][2] * rs, xn[i][3] * rs); w.z = pk2(xn[i][4] * rs, xn[i][5] * rs); w.w = pk2(xn[i][6] * rs, xn[i][7] * rs); *(v4u*)(HNw + (size_t)m * DM + col) = w; } }
    }
}

constexpr int CW_TEAM = 8192;
constexpr int CW_TMO = 64;
__device__ __forceinline__ void team_barrier(unsigned* ctl, int tm, unsigned gen, int nbr) {
    asm volatile("s_waitcnt vmcnt(0)" ::: "memory");
    __syncthreads();
    if (threadIdx.x == 0) {
        __builtin_amdgcn_fence(__ATOMIC_RELEASE, "agent");
        asm volatile("s_waitcnt vmcnt(0)" ::: "memory");
        unsigned* mine = ctl + CW_TEAM + 64 * tm; unsigned* other = ctl + CW_TEAM + 64 * (nbr >= 0 ? nbr : tm);
        (void)xb_add(mine, 1u);
        const unsigned want = 4u * gen; unsigned sp = 0u;
        while (xb_ld(mine) < want || xb_ld(other) < want) { __builtin_amdgcn_s_sleep(1);
            if ((++sp & 255u) == 0u) { if (xb_ld(ctl + CW_TMO)) break; if (sp > XB_SPIN_CAP) { atomicAdd(ctl + CW_TMO, 1u); break; } } }
        __builtin_amdgcn_fence(__ATOMIC_ACQUIRE, "agent");
        asm volatile("s_waitcnt vmcnt(0)" ::: "memory");
    }
    __syncthreads();
}

__global__ void __launch_bounds__(NWAVES * 64, 2) mk_fwd(Args args) {
    extern __shared__ __attribute__((aligned(16))) unsigned char lds_raw[];
    LAS unsigned char* lds = (LAS unsigned char*)lds_raw;
    const int G = gridDim.x, NGW = G * NWAVES;
    unsigned char* ws = args.ws;
    const int lo = args.ph_lo, hi = args.ph_hi;
    if (threadIdx.x < 32) ((LAS unsigned*)(lds + MISC_OFF))[threadIdx.x] = 0u;
    __syncthreads();
    XcdBarrier bar; bar.bar = (unsigned*)(ws + WS_CTL) + CW_BAR; bar.x = 0; bar.st = (volatile LAS unsigned*)(lds + MISC_OFF);
    if (hi - lo > 1) bar = xcd_barrier_post((unsigned*)(ws + WS_CTL) + CW_BAR, (volatile LAS unsigned*)(lds + MISC_OFF));
#define IN(k) (lo <= (k) && (k) < hi)
#define OPAQUE_IDS() int tid_ = threadIdx.x; asm volatile("" : "+v"(tid_)); const int tid = tid_, lane = tid & 63, wave = __builtin_amdgcn_readfirstlane(tid >> 6); int bx_ = blockIdx.x; asm volatile("" : "+s"(bx_)); const int gw = bx_ * NWAVES + wave; (void)gw; (void)lane
#define SEAM(k) do { if (IN(k) && IN((k) + 1)) for (int rb_ = 0; rb_ < REP_BAR; ++rb_) xcd_barrier(bar); } while (0)

    bf16* const A1 = (bf16*)(ws + WS_A1); bf16* const A2 = (bf16*)(ws + WS_A2); bf16* const QB = (bf16*)(ws + WS_Q); bf16* const SZ = (bf16*)(ws + WS_SZ);
    bf16* const YB = (bf16*)(ws + WS_Y); bf16* const YO = (bf16*)(ws + WS_YO); bf16* const KVB = (bf16*)(ws + WS_KV);
    float* const VST = (float*)(ws + WS_VST); float* const YSS = (float*)(ws + WS_YSS); bf16* const HN = (bf16*)(ws + WS_HN);

    if (TLB_WARM) {
        const unsigned idx = (blockIdx.x >> 3) * (NWAVES * 64) + threadIdx.x, nthr = (G >> 3) * (NWAVES * 64); unsigned acc = 0u;
        const size_t szs[8] = {(size_t)SEQ * DM * 4, (size_t)DEPTH * DM * NKV * 4, (size_t)DEPTH * DM * DM * 4, (size_t)2 * DM * NIN_CONV * 4, (size_t)2 * DM * NIN_GMLP * 4, (size_t)WS_END, (size_t)SEQ * DM * 4, (size_t)NMEM * DM * 4};
        const unsigned char* ptrs[8] = {(const unsigned char*)args.in[0], (const unsigned char*)args.in[5], (const unsigned char*)args.in[6], (const unsigned char*)args.in[7], (const unsigned char*)args.in[9], (const unsigned char*)ws, (const unsigned char*)args.out, (const unsigned char*)args.in[1]};
#pragma unroll
        for (int r = 0; r < 8; ++r) for (size_t pg = idx; pg < (szs[r] >> 16); pg += nthr) acc += *(const volatile unsigned*)(ptrs[r] + (pg << 16));
        asm volatile("" :: "v"(acc));
    }
    for (int ra = 0; ra < REP_ALL; ++ra) {
    if (ra) xcd_barrier(bar);
    if (IN(0)) { for (int rep = 0; rep < REP_P0; ++rep) { OPAQUE_IDS(); p0a_convert(args, ws, lds, gw, NGW, wave, lane); } }
    SEAM(0);
    if (IN(1)) {
        for (int rep = 0; rep < REP_KV; ++rep) {
        pg8::Gemm g{(const bf16*)(ws + WS_MEMB), (const bf16*)(ws + WS_WKV), NMEM, DEPTH * NKV, DM}; pg8::StaticOrder S; S.init(NMEM, DEPTH * NKV, G, (int)blockIdx.x);
        pg8::EpiKV E{KVB};
        pg8::gemm_phase<pg8::EpiKV, pg8::StaticOrder, GP_ALIGN, GP_SP2>(lds, g, S, E); }
        { OPAQUE_IDS(); p0b_convert(args, ws, lds, gw, NGW, wave, lane); }
    }
    SEAM(1);
    unsigned* const ctl = (unsigned*)(ws + WS_CTL);
    for (int L = 0; L < DEPTH; ++L) {
        const int k0 = 2 + 4 * L, gm = L & 1, jj = L >> 1;
        if (IN(k0)) for (int rep = 0; rep < REP_P1; ++rep) {
            const size_t woff = (L == 0) ? WIN_OFF0 : (L == 1) ? WIN_OFF1 : (L == 2) ? WIN_OFF2 : WIN_OFF3; const int nin = gm ? NIN_GMLP : NIN_CONV;
            pg8::Gemm g{HN, (const bf16*)(ws + WS_WIN + woff), SEQ, nin, DM}; pg8::StaticOrder S; S.init(SEQ, nin, G, (int)blockIdx.x);
            pg8::EpiProj E{A1, VST, gm, YB, args.in[8] + (size_t)jj * 3 * BRW, (float*)(ws + WS_CHT) + (size_t)jj * 256 * 2 * BRW, (float*)(ws + WS_GZH) + (size_t)jj * 256 * 2 * BRW};
            pg8::gemm_phase<pg8::EpiProj, pg8::StaticOrder, GP_ALIGN, GP_SP2>(lds, g, S, E);
            if (REP_SYNC && rep + 1 < REP_P1) xcd_barrier(bar);
        }
        { OPAQUE_IDS(); const int tm = 8 * (bx_ & 7) + ((bx_ >> 3) & 7); team_barrier(ctl, tm, 15 * ra + 4 * L + 1, (gm == 0 && tm > 0) ? tm - 1 : -1); }
        if (IN(k0 + 1)) for (int rep = 0; rep < (gm ? REP_P2G : REP_P2); ++rep) { OPAQUE_IDS(); const int tm = 8 * (bx_ & 7) + ((bx_ >> 3) & 7), km = bx_ >> 6;
            const bf16* Kl = KVB + (size_t)L * (2 * 256 * 1024); const bf16* VTl = Kl + 256 * 1024;
            if (gm) {
                const float* ws_w = args.in[12] + (size_t)jj * 8 * 128 * 128; const float* bs = args.in[13] + (size_t)jj * 8 * 128; const float* lng = args.in[10] + (size_t)jj * BRW; const float* lnb = args.in[11] + (size_t)jj * BRW;
                for (int i = 0; i < 4; ++i) { const int un = 4 * km + i, nb = 2 * tm + (un >> 3), gg = un & 7;
                    spatial_unit(A2, A1, VST, ws_w + (size_t)gg * 128 * 128, bs + gg * 128, lng, lnb, YB, nb, gg, lds, tid); }
            } else {
                const float* cw = args.in[8] + (size_t)jj * 3 * BRW; const int gr = 4 * tm + km;
                if (gr > 0) { const float* cht = (const float*)(ws + WS_CHT) + ((size_t)jj * 256 + (gr - 1)) * 2 * BRW; const float* gzh = (const float*)(ws + WS_GZH) + ((size_t)jj * 256 + gr) * 2 * BRW;
                    for (int c = 4 * tid; c < BRW; c += 4 * NWAVES * 64) {
                        const f32x4 w0 = *(const f32x4*)(cw + c), w1 = *(const f32x4*)(cw + BRW + c), a0 = *(const f32x4*)(cht + c), a1 = *(const f32x4*)(cht + BRW + c), g0 = *(const f32x4*)(gzh + c), g1 = *(const f32x4*)(gzh + BRW + c);
                        bf16* y0 = YB + (size_t)(64 * gr) * DM + c; bf16* y1 = y0 + DM; const v2u u0 = *(const v2u*)y0, u1 = *(const v2u*)y1;
                        const f32x4 f0 = g0 * (w0 * a0 + w1 * a1), f1 = g1 * (w0 * a1);
                        v2u o0, o1; o0.x = pk2(bflo(u0.x) + f0[0], bfhi(u0.x) + f0[1]); o0.y = pk2(bflo(u0.y) + f0[2], bfhi(u0.y) + f0[3]); o1.x = pk2(bflo(u1.x) + f1[0], bfhi(u1.x) + f1[1]); o1.y = pk2(bflo(u1.y) + f1[2], bfhi(u1.y) + f1[3]);
                        *(v2u*)y0 = o0; *(v2u*)y1 = o1; } }
            }
            for (int ra2 = 0; ra2 < REP_ATT; ++ra2) attn_wg(QB, SZ, Kl, VTl, YB, tm, km, lds, tid);
        }
        { OPAQUE_IDS(); const int tm = 8 * (bx_ & 7) + ((bx_ >> 3) & 7); team_barrier(ctl, tm, 15 * ra + 4 * L + 2, -1); }
        if (IN(k0 + 2)) for (int rep = 0; rep < REP_P3; ++rep) {
            pg8::Gemm g{YB, (const bf16*)(ws + WS_WOUT) + (size_t)L * DM * DM, SEQ, DM, DM}; pg8::StaticOrder S; S.init(SEQ, DM, G, (int)blockIdx.x);
            pg8::EpiOut E{YO, YSS};
            if (FAKE_P3) { pg8::FakeOrder SF; SF.init(SEQ, DM, G, (int)blockIdx.x); pg8::gemm_phase<pg8::EpiOut, pg8::FakeOrder, GP_ALIGN, GP_SP2>(lds, g, SF, E); }
            pg8::gemm_phase<pg8::EpiOut, pg8::StaticOrder, GP_ALIGN, GP_SP2>(lds, g, S, E);
            if (REP_SYNC && rep + 1 < REP_P3) xcd_barrier(bar);
        }
        { OPAQUE_IDS(); const int tm = 8 * (bx_ & 7) + ((bx_ >> 3) & 7); team_barrier(ctl, tm, 15 * ra + 4 * L + 3, -1); }
        if (IN(k0 + 3)) { OPAQUE_IDS(); const int tm = 8 * (bx_ & 7) + ((bx_ >> 3) & 7), km = bx_ >> 6;
            for (int rep = 1; rep < REP_P4; ++rep) p4_rows(YO, YSS, args.in[3] + (size_t)L * DM, HN, (float*)(ws + WS_RSTD), YB, (float*)(ws + WS_RSTDM), args.out, L == DEPTH - 1, 256 * tm + 64 * km + 8 * wave, 8, lane);
            p4_rows(YO, YSS, args.in[3] + (size_t)L * DM, HN, (float*)(ws + WS_RSTD), HN, (float*)(ws + WS_RSTD), args.out, L == DEPTH - 1, 256 * tm + 64 * km + 8 * wave, 8, lane); }
        if (L < DEPTH - 1) { OPAQUE_IDS(); const int tm = 8 * (bx_ & 7) + ((bx_ >> 3) & 7); team_barrier(ctl, tm, 15 * ra + 4 * L + 4, -1); if (GRID_PER_LAYER) xcd_barrier(bar); }
    }
    }
#undef IN
#undef SEAM
}

extern "C" void kernel_launch(void* const* d_in, const int* in_sizes, int n_in, void* d_out, int out_size, void* d_ws, size_t ws_size, hipStream_t stream) {
    static int grid = 0;
    if (grid == 0) {
        if (n_in != 14 || in_sizes[0] != SEQ * DM || out_size != SEQ * DM || ws_size < WS_END) { fprintf(stderr, "kernel_launch: unexpected shapes / workspace (n_in %d, in0 %d, out %d, ws %zu, need %zu); nothing launched\n", n_in, n_in > 0 ? in_sizes[0] : -1, out_size, ws_size, (size_t)WS_END); grid = -1; return; }
        int dev = 0, cus = 0, per_cu = 0;
        if (hipGetDevice(&dev) != hipSuccess || hipDeviceGetAttribute(&cus, hipDeviceAttributeMultiprocessorCount, dev) != hipSuccess) { grid = -1; return; }
        if (hipFuncSetAttribute((const void*)mk_fwd, hipFuncAttributeMaxDynamicSharedMemorySize, LDS_BYTES) != hipSuccess) { fprintf(stderr, "kernel_launch: hipFuncSetAttribute failed\n"); grid = -1; return; }
        if (hipOccupancyMaxActiveBlocksPerMultiprocessor(&per_cu, (const void*)mk_fwd, NWAVES * 64, LDS_BYTES) != hipSuccess || per_cu < 1) { fprintf(stderr, "kernel_launch: occupancy query says %d\n", per_cu); }
        (void)hipGetLastError();
        grid = cus;
    }
    if (grid < 0) return;
    if (hipMemsetAsync((char*)d_ws + WS_CTL, 0, CTL_ZERO_BYTES, stream) != hipSuccess) return;
    Args a{};
    for (int i = 0; i < 14; ++i) a.in[i] = (const float*)d_in[i];
    a.out = (float*)d_out; a.ws = (unsigned char*)d_ws;
#if MK_ONE_LAUNCH
    a.ph_lo = 0; a.ph_hi = NPHASE;
    hipLaunchKernelGGL(mk_fwd, dim3(grid), dim3(NWAVES * 64), LDS_BYTES, stream, a);
#else
    for (int k = 0; k < NPHASE; ++k) { a.ph_lo = k; a.ph_hi = k + 1; hipLaunchKernelGGL(mk_fwd, dim3(grid), dim3(NWAVES * 64), LDS_BYTES, stream, a); }
#endif
}
```

```cpp
#include <hip/hip_runtime.h>
#include <cstdio>
#include <cstdint>
namespace pg8 {
#define PG8_LAS __attribute__((address_space(3)))
typedef unsigned short bf16_t;
typedef short bf16x8 __attribute__((ext_vector_type(8)));
typedef float f32x4 __attribute__((ext_vector_type(4)));
typedef unsigned u32x4 __attribute__((ext_vector_type(4)));
constexpr int BM = 256, BK = 64, HALF = 128, HTB = HALF * BK * 2  , STAGE_BYTES = 8 * HTB, NXCD = 8, WGM = 8;

__host__ __device__ __forceinline__ int lds_byte(int r, int c) { const int st = (r >> 4) * 2 + (c >> 5), rr = r & 15, cc = c & 31, ob = rr * 64 + cc * 2; return st * 1024 + (ob ^ (((ob >> 9) & 1) << 5)); }
__host__ __device__ __forceinline__ void stage_rc(int b, int& R, int& C) { const int st = b / 1024, sb = b % 1024, swz = sb ^ (((sb >> 9) & 1) << 5); R = (st >> 1) * 16 + swz / 64; C = (st & 1) * 32 + (swz % 64) / 2; }
__host__ __device__ __forceinline__ int perm32(int rho) { const int n = rho >> 4, i = rho & 15; return 8 * (i >> 2) + 4 * n + (i & 3); }

struct Unit { int pm, pn; };
struct Gemm { const bf16_t* A; const bf16_t* Bt; int M, N, K; };

struct StaticOrder {
    int nM, nN, nwg, G, c;
    __host__ __device__ void init(int M, int N, int G_, int c_) { nM = M / BM; nN = N / BM; nwg = nM * nN; G = G_; c = c_; }
    __host__ __device__ bool next(int i, Unit& u) const {
        const long L = (long)i * G + c; if (L >= nwg) return false;
        int wgid = (int)L; { const int q = nwg / NXCD, r = nwg % NXCD, xcd = wgid % NXCD, off = wgid / NXCD; wgid = (xcd < r ? xcd * (q + 1) : r * (q + 1) + (xcd - r) * q) + off; }
        const int nig = WGM * nN, gid = wgid / nig, fm = gid * WGM, gsz = (nM - fm) < WGM ? (nM - fm) : WGM;
        u.pm = fm + ((wgid % nig) % gsz); u.pn = (wgid % nig) / gsz; return true;
    }
    __device__ __forceinline__ void a_ready(const Unit&) const {}
    __device__ __forceinline__ void done(const Unit&) const {}
    __device__ __forceinline__ int apm(const Unit& u) const { return u.pm; }
    __device__ __forceinline__ int bpn(const Unit& u) const { return u.pn; }
};
struct FakeOrder : StaticOrder {
    __device__ __forceinline__ int apm(const Unit&) const { return 0; }
    __device__ __forceinline__ int bpn(const Unit&) const { return 0; }
};


__device__ __forceinline__ unsigned cvt_pk_bf16(float lo, float hi) { unsigned r; asm("v_cvt_pk_bf16_f32 %0, %1, %2" : "=v"(r) : "v"(lo), "v"(hi)); return r; }
__device__ __forceinline__ float silu_f(float z) { return z * __builtin_amdgcn_rcpf(1.0f + __builtin_amdgcn_exp2f(-1.44269504f * z)); }
__device__ __forceinline__ float gelu_f(float x) { const float u = x * (0.7978845608f + 0.0356774081f * x * x); return x * __builtin_amdgcn_rcpf(1.0f + __builtin_amdgcn_exp2f(-2.88539008f * u)); }
__device__ __forceinline__ unsigned short f2bf1(float f) { unsigned u = __builtin_bit_cast(unsigned, f); return (unsigned short)((u + 0x7fffu + ((u >> 16) & 1u)) >> 16); }

template <int CTRL> __device__ __forceinline__ float dpp_keep(float old, float src) {
    return __builtin_bit_cast(float, __builtin_amdgcn_update_dpp(__builtin_bit_cast(int, old), __builtin_bit_cast(int, src), CTRL, 0xf, 0xf, false)); }
struct EpiProj {
    static constexpr bool PERM = false, AFTER_DRAIN = false;
    bf16_t* base; float* vst; int gm; bf16_t* Y; const float* cw; float* cht; float* gzh;
    static constexpr size_t OFF_A2 = (size_t)48 << 20, OFF_Q = (size_t)96 << 20, OFF_SZ = (size_t)112 << 20;
    __device__ __forceinline__ void operator()(const f32x4 (&acc)[2][2][4][2], const Unit& u, int wr, int wc, int fr, int fq) const {
        asm volatile("" : "+v"(fr), "+v"(fq));
        const int pn = u.pn; int kind, p;
        if (gm == 0) { if (pn < 48) { kind = 6; p = pn; } else if (pn < 52) { kind = 3; p = pn - 48; } else { kind = 4; p = pn - 52; } }
        else         { if (pn < 24) { kind = 2; p = pn; } else if (pn < 36) { kind = 5; p = pn - 24; } else if (pn < 40) { kind = 3; p = pn - 36; } else { kind = 4; p = pn - 40; } }
        const int row0 = u.pm * BM + wr * 64 + fr;
        if (kind == 6) {
            const int c0 = 64 * p + 16 * wc + 4 * fq;
            const f32x4 w0 = *(const f32x4*)(cw + c0), w1 = *(const f32x4*)(cw + 3072 + c0), w2 = *(const f32x4*)(cw + 2 * 3072 + c0);
#pragma unroll
            for (int ai = 0; ai < 2; ++ai) { f32x4 chp = (f32x4){0.f, 0.f, 0.f, 0.f};
#pragma unroll
                for (int m = 0; m < 4; ++m) { const int r = row0 + ai * HALF + m * 16;
                    const f32x4 bv = acc[ai][0][m][0], cv = acc[ai][0][m][1], hv = acc[ai][1][m][0], zv = acc[ai][1][m][1];
                    f32x4 ch, gz, o;
#pragma unroll
                    for (int j = 0; j < 4; ++j) { ch[j] = cv[j] * hv[j]; gz[j] = bv[j] * silu_f(zv[j]); }
#pragma unroll
                    for (int j = 0; j < 4; ++j) {
                        const float p1 = dpp_keep<0x111>(dpp_keep<0x121>(0.f, chp[j]), ch[j]);
                        const float p2 = dpp_keep<0x112>(dpp_keep<0x122>(0.f, chp[j]), ch[j]);
                        o[j] = gz[j] * (w0[j] * p2 + w1[j] * p1 + w2[j] * ch[j]); }
                    typedef unsigned u32x2 __attribute__((ext_vector_type(2)));
                    u32x2 w; w.x = cvt_pk_bf16(o[0], o[1]); w.y = cvt_pk_bf16(o[2], o[3]);
                    *(u32x2*)(Y + (size_t)r * 4096 + c0) = w;
                    const int gr = (u.pm * 4 + ai * 2 + wr);
                    if (m == 0 && fr < 2) *(f32x4*)(gzh + ((size_t)gr * 2 + fr) * 3072 + c0) = gz;
                    if (m == 3 && fr >= 14) *(f32x4*)(cht + ((size_t)gr * 2 + (fr - 14)) * 3072 + c0) = ch;
                    chp = ch; } }
        } else if (kind <= 2) {
            bf16_t* O = base + ((kind == 1) ? OFF_A2 : (size_t)0); const int col0 = 128 * p + 32 * wc + 8 * fq;
#pragma unroll
            for (int ai = 0; ai < 2; ++ai)
#pragma unroll
                for (int m = 0; m < 4; ++m) { const int r = row0 + ai * HALF + m * 16;
                    f32x4 o[2];
#pragma unroll
                    for (int n = 0; n < 2; ++n) { const f32x4 a = acc[ai][0][m][n], b = acc[ai][1][m][n];
#pragma unroll
                        for (int j = 0; j < 4; ++j) o[n][j] = (kind == 0) ? a[j] * silu_f(b[j]) : (kind == 1) ? a[j] * b[j] : gelu_f(a[j]) * silu_f(b[j]); }
                    u32x4 w; w.x = cvt_pk_bf16(o[0][0], o[0][1]); w.y = cvt_pk_bf16(o[0][2], o[0][3]); w.z = cvt_pk_bf16(o[1][0], o[1][1]); w.w = cvt_pk_bf16(o[1][2], o[1][3]);
                    *(u32x4*)(O + (size_t)r * 3072 + col0) = w; }
        } else {
            bf16_t* O = base + ((kind == 3) ? OFF_Q : (kind == 4) ? OFF_SZ : OFF_A2); const int ldo = (kind == 5) ? 3072 : 1024; const int col0 = 256 * p + 32 * wc + 8 * fq;
#pragma unroll
            for (int ai = 0; ai < 2; ++ai)
#pragma unroll
                for (int m = 0; m < 4; ++m) { const int r = row0 + ai * HALF + m * 16; float s1 = 0.f, s2 = 0.f;
#pragma unroll
                    for (int bj = 0; bj < 2; ++bj) { f32x4 o[2];
#pragma unroll
                        for (int n = 0; n < 2; ++n) { const f32x4 a = acc[ai][bj][m][n];
#pragma unroll
                            for (int j = 0; j < 4; ++j) { const float v = (kind == 3) ? a[j] * 0.0625f : (kind == 4) ? silu_f(a[j]) : gelu_f(a[j]); o[n][j] = v; s1 += v; s2 += v * v; } }
                        u32x4 w; w.x = cvt_pk_bf16(o[0][0], o[0][1]); w.y = cvt_pk_bf16(o[0][2], o[0][3]); w.z = cvt_pk_bf16(o[1][0], o[1][1]); w.w = cvt_pk_bf16(o[1][2], o[1][3]);
                        *(u32x4*)(O + (size_t)r * ldo + col0 + bj * HALF) = w; }
                    if (kind == 5) { s1 += __shfl_xor(s1, 16); s1 += __shfl_xor(s1, 32); s2 += __shfl_xor(s2, 16); s2 += __shfl_xor(s2, 32);
                        if (fq == 0) { float* q = vst + ((size_t)r * 48 + p * 4 + wc) * 2; q[0] = s1; q[1] = s2; } } }
        }
    }
};
struct EpiOut {
    static constexpr bool PERM = false, AFTER_DRAIN = false;
    bf16_t* YO; float* yss;
    __device__ __forceinline__ void operator()(const f32x4 (&acc)[2][2][4][2], const Unit& u, int wr, int wc, int fr, int fq) const {
        asm volatile("" : "+v"(fr), "+v"(fq));
        const int row0 = u.pm * BM + wr * 64 + fr, col0 = 256 * u.pn + 32 * wc + 8 * fq;
#pragma unroll
        for (int ai = 0; ai < 2; ++ai)
#pragma unroll
            for (int m = 0; m < 4; ++m) { const int r = row0 + ai * HALF + m * 16; float ss = 0.f;
#pragma unroll
                for (int bj = 0; bj < 2; ++bj) { const f32x4 a = acc[ai][bj][m][0], b = acc[ai][bj][m][1];
                    ss += (a[0] * a[0] + a[1] * a[1]) + (a[2] * a[2] + a[3] * a[3]) + (b[0] * b[0] + b[1] * b[1]) + (b[2] * b[2] + b[3] * b[3]);
                    u32x4 w; w.x = cvt_pk_bf16(a[0], a[1]); w.y = cvt_pk_bf16(a[2], a[3]); w.z = cvt_pk_bf16(b[0], b[1]); w.w = cvt_pk_bf16(b[2], b[3]);
                    *(u32x4*)(YO + (size_t)r * 4096 + col0 + bj * HALF) = w; }
                ss += __shfl_xor(ss, 16); ss += __shfl_xor(ss, 32);
                if (fq == 0) yss[(size_t)r * 64 + u.pn * 4 + wc] = ss; }
    }
};
struct EpiKV {
    static constexpr bool PERM = false, AFTER_DRAIN = false;
    bf16_t* KV;
    __device__ __forceinline__ void operator()(const f32x4 (&acc)[2][2][4][2], const Unit& u, int wr, int wc, int fr, int fq) const {
        asm volatile("" : "+v"(fr), "+v"(fq));
        const int l = u.pn >> 3, t = u.pn & 7; bf16_t* base = KV + (size_t)l * (2 * 256 * 1024); const int row0 = wr * 64 + fr;
#pragma unroll
        for (int ai = 0; ai < 2; ++ai)
#pragma unroll
            for (int m = 0; m < 4; ++m) { const int r = row0 + ai * HALF + m * 16;
#pragma unroll
                for (int bj = 0; bj < 2; ++bj) { const f32x4 a = acc[ai][bj][m][0], b = acc[ai][bj][m][1];
                    if (t < 4) { u32x4 w; w.x = cvt_pk_bf16(a[0], a[1]); w.y = cvt_pk_bf16(a[2], a[3]); w.z = cvt_pk_bf16(b[0], b[1]); w.w = cvt_pk_bf16(b[2], b[3]);
                        *(u32x4*)(base + (size_t)r * 1024 + 256 * t + bj * HALF + 32 * wc + 8 * fq) = w; }
                    else { bf16_t* vt = base + 256 * 1024 + (size_t)(256 * (t - 4) + bj * HALF + 32 * wc + 8 * fq) * 256 + r;
#pragma unroll
                        for (int j = 0; j < 4; ++j) { vt[(size_t)j * 256] = f2bf1(a[j]); vt[(size_t)(4 + j) * 256] = f2bf1(b[j]); } } } }
    }
};
template <class Epi, class Sched, bool ALIGN_EPI = false, bool SP2 = false>
__device__ __forceinline__ void gemm_phase(PG8_LAS unsigned char* lds, const Gemm g, const Sched& S, const Epi& E) {
    int tid_ = threadIdx.x; asm volatile("" : "+v"(tid_));
    const int tid = tid_, wid = __builtin_amdgcn_readfirstlane(tid >> 6), lane = tid & 63, wr = wid >> 2, wc = wid & 3, fr = lane & 15, fq = lane >> 4;
    const int K = g.K, nt = K / BK;
    unsigned voffA[2], voffB[2];
#pragma unroll
    for (int i = 0; i < 2; ++i) { int R, C; stage_rc(tid * 16 + i * 8192, R, C); const int Rb = Epi::PERM ? ((R & ~31) + perm32(R & 31)) : R;
        voffA[i] = (unsigned)(R * K + C) * 2u; voffB[i] = (unsigned)(Rb * K + C) * 2u; }
    const size_t kstep = (size_t)(BK * 2);
    const size_t hstep = (size_t)HALF * K * 2;
    const size_t tstep = 2 * hstep;
    const unsigned ldsw = (unsigned)wid * 1024u;
    const int aoff = lds_byte(wr * 64 + fr, fq * 8), boff = lds_byte(wc * 32 + fr, fq * 8);
#define PG8_SA(b, h) (((b) * 2 + (h)) * HTB)
#define PG8_SB(b, h) ((4 + (b) * 2 + (h)) * HTB)
#define PG8_STAGE(bufoff, gbase, voff) do { _Pragma("unroll") for (int _i = 0; _i < 2; ++_i) \
        __builtin_amdgcn_global_load_lds((const unsigned*)((const char*)(gbase) + (voff)[_i]), (PG8_LAS unsigned*)(lds + (bufoff) + ldsw + _i * 8192), 16, 0, 0); } while (0)
#define PG8_LDA(dst, b, h) do { _Pragma("unroll") for (int m = 0; m < 4; ++m) _Pragma("unroll") for (int k = 0; k < 2; ++k) dst[m][k] = *(const PG8_LAS bf16x8*)(lds + PG8_SA(b, h) + aoff + m * 2048 + k * 1024); } while (0)
#define PG8_LDB(dst, b, h) do { _Pragma("unroll") for (int n = 0; n < 2; ++n) _Pragma("unroll") for (int k = 0; k < 2; ++k) dst[n][k] = *(const PG8_LAS bf16x8*)(lds + PG8_SB(b, h) + boff + n * 2048 + k * 1024); } while (0)
#define PG8_MMA(ai, bj, At, Bt) do { __builtin_amdgcn_s_setprio(1); _Pragma("unroll") for (int m = 0; m < 4; ++m) _Pragma("unroll") for (int n = 0; n < 2; ++n) _Pragma("unroll") for (int k = 0; k < 2; ++k) \
        acc[ai][bj][m][n] = __builtin_amdgcn_mfma_f32_16x16x32_bf16(Bt[n][k], At[m][k], acc[ai][bj][m][n], 0, 0, 0); __builtin_amdgcn_s_setprio(0); } while (0)
#define PG8_WAIT_V(n) asm volatile("s_waitcnt vmcnt(" #n ")" ::: "memory")
#define PG8_WAIT_L(n) asm volatile("s_waitcnt lgkmcnt(" #n ")" ::: "memory")
#define PG8_BAR __builtin_amdgcn_s_barrier()
#define PG8_SCHED __builtin_amdgcn_sched_barrier(0)
    Unit cur, nxt; int ui = 0;
    if (!S.next(0, cur)) return;
    f32x4 acc[2][2][4][2];
#pragma unroll
    for (int a = 0; a < 2; ++a)
#pragma unroll
        for (int b = 0; b < 2; ++b)
#pragma unroll
            for (int m = 0; m < 4; ++m)
#pragma unroll
                for (int n = 0; n < 2; ++n) acc[a][b][m][n] = (f32x4){0.f, 0.f, 0.f, 0.f};
    bf16x8 At[4][2], B0[2][2], B1[2][2];
    const char* cA = (const char*)g.A + (size_t)S.apm(cur) * tstep; const char* cB = (const char*)g.Bt + (size_t)S.bpn(cur) * tstep;
    S.a_ready(cur);
    if constexpr (SP2) {
        PG8_STAGE(PG8_SB(0, 0), cB, voffB); PG8_STAGE(PG8_SB(0, 1), cB + hstep, voffB); PG8_STAGE(PG8_SA(0, 0), cA, voffA); PG8_STAGE(PG8_SA(0, 1), cA + hstep, voffA);
        if (wr == 1) PG8_BAR;
        PG8_WAIT_V(2); PG8_BAR;
        PG8_STAGE(PG8_SB(1, 0), cB + kstep, voffB); PG8_STAGE(PG8_SA(1, 0), cA + kstep, voffA); PG8_STAGE(PG8_SB(1, 1), cB + hstep + kstep, voffB);
        PG8_WAIT_V(6); PG8_BAR;
    } else {
        PG8_STAGE(PG8_SB(0, 0), cB, voffB); PG8_STAGE(PG8_SA(0, 0), cA, voffA); PG8_STAGE(PG8_SB(0, 1), cB + hstep, voffB); PG8_STAGE(PG8_SA(0, 1), cA + hstep, voffA);
        if (wr == 1) PG8_BAR;
        PG8_WAIT_V(4); PG8_BAR;
        PG8_STAGE(PG8_SB(1, 0), cB + kstep, voffB); PG8_STAGE(PG8_SA(1, 0), cA + kstep, voffA); PG8_STAGE(PG8_SB(1, 1), cB + hstep + kstep, voffB);
        PG8_WAIT_V(6); PG8_BAR;
    }
    for (;;) {
        const bool has_next = S.next(ui + 1, nxt);
        const char* nA = has_next ? (const char*)g.A + (size_t)S.apm(nxt) * tstep : cA; const char* nB = has_next ? (const char*)g.Bt + (size_t)S.bpn(nxt) * tstep : cB;
        for (int t = 0; t < nt; t += 2) {
            const bool last = (t == nt - 2);
            const char* a1 = cA + (size_t)(t + 1) * kstep;
            const char* a2 = last ? nA : cA + (size_t)(t + 2) * kstep; const char* b2 = last ? nB : cB + (size_t)(t + 2) * kstep;
            const char* a3 = a2 + kstep; const char* b3 = b2 + kstep;
            if (last && has_next) S.a_ready(nxt);
            if constexpr (SP2) {
            PG8_LDB(B0, 0, 0); PG8_LDB(B1, 0, 1); PG8_SCHED; PG8_LDA(At, 0, 0); PG8_STAGE(PG8_SA(1, 1), a1 + hstep, voffA);
            PG8_WAIT_V(8); PG8_WAIT_L(0); PG8_BAR; PG8_MMA(0, 0, At, B0); PG8_MMA(0, 1, At, B1); PG8_BAR; PG8_SCHED;
            PG8_LDA(At, 0, 1); PG8_STAGE(PG8_SB(0, 0), b2, voffB); PG8_STAGE(PG8_SB(0, 1), b2 + hstep, voffB); PG8_STAGE(PG8_SA(0, 0), a2, voffA);
            PG8_WAIT_V(8); PG8_WAIT_L(0); PG8_BAR; PG8_MMA(1, 0, At, B0); PG8_MMA(1, 1, At, B1); PG8_BAR; PG8_SCHED;
            PG8_LDB(B0, 1, 0); PG8_LDB(B1, 1, 1); PG8_SCHED; PG8_LDA(At, 1, 0); PG8_STAGE(PG8_SA(0, 1), a2 + hstep, voffA);
            PG8_WAIT_V(8); PG8_WAIT_L(0); PG8_BAR; PG8_MMA(0, 0, At, B0); PG8_MMA(0, 1, At, B1); PG8_BAR; PG8_SCHED;
            PG8_LDA(At, 1, 1); PG8_STAGE(PG8_SB(1, 0), b3, voffB); PG8_STAGE(PG8_SB(1, 1), b3 + hstep, voffB); PG8_STAGE(PG8_SA(1, 0), a3, voffA);
            PG8_WAIT_V(8); PG8_WAIT_L(0); PG8_BAR; PG8_MMA(1, 0, At, B0); PG8_MMA(1, 1, At, B1); PG8_BAR; PG8_SCHED;
            } else {
            PG8_LDB(B0, 0, 0); PG8_SCHED; PG8_LDA(At, 0, 0); PG8_STAGE(PG8_SA(1, 1), a1 + hstep, voffA);
            PG8_WAIT_L(8); PG8_BAR; PG8_WAIT_L(0); PG8_MMA(0, 0, At, B0); PG8_BAR; PG8_SCHED;
            PG8_LDB(B1, 0, 1); PG8_STAGE(PG8_SB(0, 0), b2, voffB);
            PG8_BAR; PG8_WAIT_L(0); PG8_MMA(0, 1, At, B1); PG8_BAR;
            PG8_LDA(At, 0, 1); PG8_STAGE(PG8_SA(0, 0), a2, voffA);
            PG8_BAR; PG8_WAIT_L(0); PG8_MMA(1, 0, At, B0); PG8_BAR; PG8_SCHED;
            PG8_STAGE(PG8_SB(0, 1), b2 + hstep, voffB);
            PG8_WAIT_V(6); PG8_BAR; PG8_MMA(1, 1, At, B1); PG8_BAR;
            PG8_LDB(B0, 1, 0); PG8_SCHED; PG8_LDA(At, 1, 0); PG8_STAGE(PG8_SA(0, 1), a2 + hstep, voffA);
            PG8_WAIT_L(8); PG8_BAR; PG8_WAIT_L(0); PG8_MMA(0, 0, At, B0); PG8_BAR; PG8_SCHED;
            PG8_LDB(B1, 1, 1); PG8_STAGE(PG8_SB(1, 0), b3, voffB);
            PG8_BAR; PG8_WAIT_L(0); PG8_MMA(0, 1, At, B1); PG8_BAR;
            PG8_LDA(At, 1, 1); PG8_STAGE(PG8_SA(1, 0), a3, voffA);
            PG8_BAR; PG8_WAIT_L(0); PG8_MMA(1, 0, At, B0); PG8_BAR; PG8_SCHED;
            PG8_STAGE(PG8_SB(1, 1), b3 + hstep, voffB);
            PG8_WAIT_V(6); PG8_BAR; PG8_MMA(1, 1, At, B1); PG8_BAR;
            }
        }
        if constexpr (ALIGN_EPI) { if (wr == 0) PG8_BAR; }
        if constexpr (!Epi::AFTER_DRAIN) { E(acc, cur, wr, wc, fr, fq); S.done(cur); }
        if (!has_next) break;
#pragma unroll
        for (int a = 0; a < 2; ++a)
#pragma unroll
            for (int b = 0; b < 2; ++b)
#pragma unroll
                for (int m = 0; m < 4; ++m)
#pragma unroll
                    for (int n = 0; n < 2; ++n) acc[a][b][m][n] = (f32x4){0.f, 0.f, 0.f, 0.f};
        cur = nxt; cA = nA; cB = nB; ++ui;
        if constexpr (ALIGN_EPI) { if (wr == 1) PG8_BAR; }
    }
    PG8_WAIT_V(0);
    if constexpr (!ALIGN_EPI) { if (wr == 0) PG8_BAR; }
    PG8_BAR;
    if constexpr (Epi::AFTER_DRAIN) { E.fused(acc, cur, wr, wc, fr, fq, lds, wid, lane); S.done(cur); }
#undef PG8_SA
#undef PG8_SB
#undef PG8_STAGE
#undef PG8_LDA
#undef PG8_LDB
#undef PG8_MMA
#undef PG8_WAIT_V
#undef PG8_WAIT_L
#undef PG8_BAR
#undef PG8_SCHED
}
}

constexpr int SEQ = 16384, DM = 4096, DEPTH = 4, NMEM = 256, BRW = 3072, MEMW = 1024, NHEAD = 4, HDIM = 256;
constexpr int NIN_CONV = 14336, NIN_GMLP = 11264, NKV = 2048;
constexpr float RMS_EPS = 1e-6f, LNORM_EPS = 1e-5f;
constexpr int NWAVES = 8;
#ifndef MK_ONE_LAUNCH
#define MK_ONE_LAUNCH 1
#endif
constexpr int NPHASE = 2 + 4 * DEPTH;
#ifndef REP_P0
#define REP_P0 1
#endif
#ifndef REP_P1
#define REP_P1 1
#endif
#ifndef REP_P2
#define REP_P2 1
#endif
#ifndef REP_P3
#define REP_P3 1
#endif
#ifndef REP_P2G
#define REP_P2G 1
#endif
#ifndef REP_ATT
#define REP_ATT 1
#endif
#ifndef TLB_WARM
#define TLB_WARM 0
#endif
#ifndef REP_ALL
#define REP_ALL 1
#endif
#ifndef REP_P4
#define REP_P4 1
#endif
#ifndef REP_KV
#define REP_KV 1
#endif
#ifndef REP_BAR
#define REP_BAR 1
#endif
#ifndef GP_ALIGN
#define GP_ALIGN true
#endif
#ifndef GP_SP2
#define GP_SP2 true
#endif
#ifndef FAKE_P3
#define FAKE_P3 0
#endif
#ifndef REP_SYNC
#define REP_SYNC 0
#endif
#ifndef GRID_PER_LAYER
#define GRID_PER_LAYER 1
#endif

constexpr size_t MiB = 1u << 20;
constexpr size_t WS_CTL = 0, CTL_ZERO_BYTES = 1 * MiB;
constexpr size_t WS_WIN = 2 * MiB;
constexpr size_t WIN_OFF0 = 0, WIN_OFF1 = 112 * MiB, WIN_OFF2 = 200 * MiB, WIN_OFF3 = 312 * MiB;
constexpr size_t WS_WOUT = WS_WIN + 400 * MiB;
constexpr size_t WS_WKV = WS_WOUT + 128 * MiB;
constexpr size_t WS_MEMB = WS_WKV + 64 * MiB;
constexpr size_t WS_KV = WS_MEMB + 2 * MiB;
constexpr size_t WS_XB = WS_KV + 4 * MiB;
constexpr size_t WS_A1 = WS_XB + 128 * MiB;
constexpr size_t WS_A2 = WS_A1 + 96 * MiB;
constexpr size_t WS_Q = WS_A2 + 96 * MiB;
constexpr size_t WS_SZ = WS_Q + 32 * MiB;
constexpr size_t WS_Y = WS_SZ + 32 * MiB;
constexpr size_t WS_YO = WS_Y + 128 * MiB;
constexpr size_t WS_RSTD = WS_YO + 128 * MiB;
constexpr size_t WS_RSTDM = WS_RSTD + 1 * MiB;
constexpr size_t WS_VST = WS_RSTDM + 1 * MiB;
constexpr size_t WS_YSS = WS_VST + 6 * MiB;
constexpr size_t WS_HN = WS_YSS + 4 * MiB;
constexpr size_t WS_CHT = WS_HN + 128 * MiB;
constexpr size_t WS_GZH = WS_CHT + 12 * MiB;
constexpr size_t WS_END = WS_GZH + 12 * MiB;
static_assert(WS_A2 - WS_A1 == 2 * pg8::EpiProj::OFF_A2 && WS_Q - WS_A1 == 2 * pg8::EpiProj::OFF_Q && WS_SZ - WS_A1 == 2 * pg8::EpiProj::OFF_SZ, "EpiProj output offsets");
constexpr int CW_BAR = 4096;

constexpr int RING_BYTES = 131072;
constexpr int LDS_BYTES = 147456;
constexpr int MISC_OFF = LDS_BYTES - 128;

#define GAS __attribute__((address_space(1)))
#define LAS __attribute__((address_space(3)))
typedef unsigned short bf16;
typedef unsigned v4u __attribute__((ext_vector_type(4)));
typedef unsigned v2u __attribute__((ext_vector_type(2)));
typedef float f32x4 __attribute__((ext_vector_type(4)));
typedef short bf16x8 __attribute__((ext_vector_type(8)));
#define LDS_WAIT() asm volatile("s_waitcnt lgkmcnt(0)" ::: "memory")
__device__ __forceinline__ unsigned f2bf(float f) { unsigned u = __builtin_bit_cast(unsigned, f); return (u + 0x7fffu + ((u >> 16) & 1u)) >> 16; }
__device__ __forceinline__ unsigned pk2(float lo, float hi) { return pg8::cvt_pk_bf16(lo, hi); }
__device__ __forceinline__ float bflo(unsigned w) { return __builtin_bit_cast(float, w << 16); }
__device__ __forceinline__ float bfhi(unsigned w) { return __builtin_bit_cast(float, w & 0xffff0000u); }
__device__ __forceinline__ float wave_sum(float v) {
#pragma unroll
    for (int o = 1; o < 64; o <<= 1) v += __shfl_xor(v, o);
    return v;
}

#define XB_TMO      128
#define XB_XCNT(j)  (256  + 64 * (j))
#define XB_XSUB(j)  (1280 + 64 * (j))
#define XB_XGEN(j)  (2304 + 64 * (j))
#define XB_TOP      3328
#define XB_TOPGEN   3392
#define XCD_BAR_WORDS 3456
#define XB_SPIN_CAP (1u << 18)

__device__ __forceinline__ unsigned xb_ld(unsigned* p)              { return __hip_atomic_load(p, __ATOMIC_RELAXED, __HIP_MEMORY_SCOPE_AGENT); }
__device__ __forceinline__ unsigned xb_add(unsigned* p, unsigned v) { return __hip_atomic_fetch_add(p, v, __ATOMIC_RELAXED, __HIP_MEMORY_SCOPE_AGENT); }
__device__ __forceinline__ unsigned xb_xcc_id() { return (unsigned)__builtin_amdgcn_s_getreg((3 << 11) | 20) & 0xFu; }
#define XB_SPIN(cond, bar) do { unsigned _sp = 0; while (cond) { __builtin_amdgcn_s_sleep(1); \
    if ((++_sp & 255u) == 0u) { if (xb_ld(&(bar)[XB_TMO])) break; if (_sp > XB_SPIN_CAP) { atomicAdd(&(bar)[XB_TMO], 1u); break; } } } } while (0)

struct XcdBarrier {
    unsigned* bar; unsigned x;
    volatile LAS unsigned* st;
};
__device__ __forceinline__ XcdBarrier xcd_barrier_post(unsigned* bar, volatile LAS unsigned* st) {
    XcdBarrier b; b.bar = bar; b.x = xb_xcc_id(); b.st = st;
    if (threadIdx.x == 0) (void)xb_add(&bar[XB_XCNT(b.x)], 1u);
    return b;
}
__device__ __forceinline__ void xcd_barrier_complete(unsigned* bar, unsigned x, unsigned& nloc, unsigned& nx) {
    const unsigned G = gridDim.x * gridDim.y * gridDim.z;
    unsigned sum, cnt, mine, sp = 0u;
    for (;;) {
        sum = 0u; cnt = 0u; mine = 0u;
#pragma unroll
        for (unsigned j = 0; j < 16; ++j) { const unsigned c = xb_ld(&bar[XB_XCNT(j)]); sum += c; cnt += (c > 0u) ? 1u : 0u; mine = (j == x) ? c : mine; }
        if (sum == G) break;
        __builtin_amdgcn_s_sleep(1);
        if ((++sp & 255u) == 0u) { if (xb_ld(&bar[XB_TMO])) break; if (sp > XB_SPIN_CAP) { atomicAdd(&bar[XB_TMO], 1u); break; } }
    }
    nloc = mine > 0u ? mine : 1u; nx = cnt > 0u ? cnt : 1u;
}
__device__ __forceinline__ void xcd_barrier(const XcdBarrier& b) {
    asm volatile("s_waitcnt vmcnt(0)" ::: "memory");
    __syncthreads();
    if (threadIdx.x == 0) {
        unsigned* bar = b.bar;
        __builtin_amdgcn_s_waitcnt(0);
        unsigned nloc = b.st[0], nx = b.st[1];
        if (nloc == 0u) { xcd_barrier_complete(bar, b.x, nloc, nx); b.st[0] = nloc; b.st[1] = nx; }
        const unsigned old = xb_add(&bar[XB_XSUB(b.x)], 1u);
        const unsigned gen = old / nloc;
        if (old + 1u == (gen + 1u) * nloc) {
            __builtin_amdgcn_fence(__ATOMIC_RELEASE, "agent");
            asm volatile("s_waitcnt vmcnt(0)" ::: "memory");
            const unsigned og = xb_add(&bar[XB_TOP], 1u);
            const unsigned tg = og / nx;
            if (og + 1u == (tg + 1u) * nx) xb_add(&bar[XB_TOPGEN], 1u);
            else XB_SPIN(xb_ld(&bar[XB_TOPGEN]) == tg, bar);
            __builtin_amdgcn_fence(__ATOMIC_ACQUIRE, "agent");
            xb_add(&bar[XB_XGEN(b.x)], 1u);
            asm volatile("s_waitcnt vmcnt(0)" ::: "memory");
        } else {
            XB_SPIN(xb_ld(&bar[XB_XGEN(b.x)]) == gen, bar);
            __builtin_amdgcn_fence(__ATOMIC_ACQUIRE, "agent");
            asm volatile("s_waitcnt vmcnt(0)" ::: "memory");
        }
    }
    __syncthreads();
}

__device__ __forceinline__ void src_conv(int gi, int& sa, int& sb, bool& perm) { const int pn = gi >> 3, bj = (gi >> 2) & 1, wc = gi & 3;
    if (pn < 48) { sa = (bj ? 6144 : 0) + 64 * pn + 16 * wc; sb = (bj ? 10240 : 3072) + 64 * pn + 16 * wc; perm = false; return; }
    const int s32 = (pn < 52) ? 9216 + 256 * (pn - 48) + 128 * bj + 32 * wc : 13312 + 256 * (pn - 52) + 128 * bj + 32 * wc;
    sa = s32; sb = s32 + 16; perm = true; }
__device__ __forceinline__ int src32_gmlp(int gi) { const int pn = gi >> 3, bj = (gi >> 2) & 1, wc = gi & 3;
    if (pn < 24) return (bj ? 7168 : 0) + 128 * pn + 32 * wc;
    if (pn < 36) return 3072 + 256 * (pn - 24) + 128 * bj + 32 * wc;
    if (pn < 40) return 6144 + 256 * (pn - 36) + 128 * bj + 32 * wc;
    return 10240 + 256 * (pn - 40) + 128 * bj + 32 * wc; }
__device__ __forceinline__ void cvt_item(const float* W, int N, int sa, int sb, bool perm, const float* gk, bf16* WT, int slot0, int k0, LAS float* scr, int lane) {
    const int l31 = lane & 31, scol = (l31 < 16) ? sa + l31 : sb + l31 - 16;
#pragma unroll 8
    for (int i = 0; i < 32; ++i) { const int kk = 2 * i + (lane >> 5); scr[kk * 33 + l31] = W[(size_t)(k0 + kk) * N + scol]; }
    const int c = lane & 7;
    f32x4 g0 = (f32x4){1.f, 1.f, 1.f, 1.f}, g1 = g0;
    if (gk) { g0 = *(const f32x4*)(gk + k0 + 8 * c); g1 = *(const f32x4*)(gk + k0 + 8 * c + 4); }
    LDS_WAIT(); asm volatile("" ::: "memory");
#pragma unroll
    for (int j = 0; j < 4; ++j) { const int n = (lane >> 3) + 8 * j; const LAS float* s = scr + (8 * c) * 33 + (perm ? pg8::perm32(n) : n);
        v4u o; o.x = pk2(s[0 * 33] * g0[0], s[1 * 33] * g0[1]); o.y = pk2(s[2 * 33] * g0[2], s[3 * 33] * g0[3]); o.z = pk2(s[4 * 33] * g1[0], s[5 * 33] * g1[1]); o.w = pk2(s[6 * 33] * g1[2], s[7 * 33] * g1[3]);
        *(v4u*)(WT + (size_t)(slot0 + n) * DM + k0 + 8 * c) = o; }
    LDS_WAIT(); asm volatile("" ::: "memory");
}
__device__ __forceinline__ void row_to_bf16(const float* xr, float* rms_out  , bf16* nrow, int lane) {
    f32x4 v[16]; float ss = 0.f;
#pragma unroll
    for (int i = 0; i < 8; ++i) { const int col = 512 * i + 8 * lane; const f32x4 a = *(const f32x4*)(xr + col), b = *(const f32x4*)(xr + col + 4); v[2 * i] = a; v[2 * i + 1] = b;
        ss += (a[0] * a[0] + a[1] * a[1]) + (a[2] * a[2] + a[3] * a[3]) + (b[0] * b[0] + b[1] * b[1]) + (b[2] * b[2] + b[3] * b[3]); }
    ss = wave_sum(ss);
    const float rms = sqrtf(ss * (1.0f / DM) + RMS_EPS), rs = 1.0f / rms;
    if (rms_out && lane == 0) *rms_out = rms;
#pragma unroll
    for (int i = 0; i < 8; ++i) { const int col = 512 * i + 8 * lane; const f32x4 a = v[2 * i], b = v[2 * i + 1];
        v4u n; n.x = pk2(a[0] * rs, a[1] * rs); n.y = pk2(a[2] * rs, a[3] * rs); n.z = pk2(b[0] * rs, b[1] * rs); n.w = pk2(b[2] * rs, b[3] * rs); *(v4u*)(nrow + col) = n; }
}

struct Args { const float* in[14]; float* out; unsigned char* ws; int ph_lo, ph_hi; };

constexpr int I_KV = 64 * (NKV / 32), I_OUT = 64 * (DM / 32), I_CONV = 64 * (NIN_CONV / 32), I_GMLP = 64 * (NIN_GMLP / 32);
constexpr int NITEMS = 4 * I_KV + 4 * I_OUT + 2 * I_CONV + 2 * I_GMLP;
__device__ __forceinline__ void p0_item(const Args& a, unsigned char* ws, LAS float* scr, int it, int lane) {
    const float* pre_g = a.in[2]; const float* mem_g = a.in[4]; const float* w_kv = a.in[5]; const float* w_out = a.in[6]; const float* conv_w_in = a.in[7]; const float* gmlp_w_in = a.in[9];
    int r = it; const float* W; const float* gk; bf16* WT; int N, ng, type;
    if (r < 4 * I_KV) { const int l = r / I_KV; r -= l * I_KV; W = w_kv + (size_t)l * DM * NKV; N = NKV; ng = NKV / 32; type = 2; gk = mem_g + l * DM; WT = (bf16*)(ws + WS_WKV) + (size_t)l * NKV * DM; }
    else { r -= 4 * I_KV;
        if (r < 4 * I_OUT) { const int l = r / I_OUT; r -= l * I_OUT; W = w_out + (size_t)l * DM * DM; N = DM; ng = DM / 32; type = 2; gk = nullptr; WT = (bf16*)(ws + WS_WOUT) + (size_t)l * DM * DM; }
        else { r -= 4 * I_OUT;
            if (r < 2 * I_CONV) { const int j = r / I_CONV; r -= j * I_CONV; W = conv_w_in + (size_t)j * DM * NIN_CONV; N = NIN_CONV; ng = NIN_CONV / 32; type = 0; gk = pre_g + (2 * j) * DM; WT = (bf16*)(ws + WS_WIN + (j ? WIN_OFF2 : WIN_OFF0)); }
            else { r -= 2 * I_CONV; const int j = r / I_GMLP; r -= j * I_GMLP; W = gmlp_w_in + (size_t)j * DM * NIN_GMLP; N = NIN_GMLP; ng = NIN_GMLP / 32; type = 1; gk = pre_g + (2 * j + 1) * DM; WT = (bf16*)(ws + WS_WIN + (j ? WIN_OFF3 : WIN_OFF1)); } } }
    const int kb = r / ng, gi = r - kb * ng;
    int sa, sb; bool perm = true;
    if (type == 0) src_conv(gi, sa, sb, perm); else { sa = (type == 1) ? src32_gmlp(gi) : 32 * gi; sb = sa + 16; }
    cvt_item(W, N, sa, sb, perm, gk, WT, 32 * gi, 64 * kb, scr, lane);
}
__device__ __forceinline__ void p0a_convert(const Args& a, unsigned char* ws, LAS unsigned char* lds, int gw, int NGW, int wave, int lane) {
    LAS float* scr = (LAS float*)(lds + wave * 16384);
    for (int it = gw; it < 4 * I_KV; it += NGW) p0_item(a, ws, scr, it, lane);
    for (int m = gw; m < NMEM; m += NGW) row_to_bf16(a.in[1] + (size_t)m * DM, nullptr, (bf16*)(ws + WS_MEMB) + (size_t)m * DM, lane);
}
constexpr int CW_Q0 = 96;
__device__ __forceinline__ void p0b_convert(const Args& a, unsigned char* ws, LAS unsigned char* lds, int gw, int NGW, int wave, int lane) {
    LAS float* scr = (LAS float*)(lds + wave * 16384);
    unsigned* q = (unsigned*)(ws + WS_CTL) + CW_Q0;
    for (;;) { unsigned b = 0u; if (lane == 0) b = __hip_atomic_fetch_add(q, 16u, __ATOMIC_RELAXED, __HIP_MEMORY_SCOPE_AGENT);
        const int base = 4 * I_KV + (int)__builtin_amdgcn_readfirstlane(b); if (base >= NITEMS) break;
        for (int i = 0; i < 16; ++i) if (base + i < NITEMS) p0_item(a, ws, scr, base + i, lane); }
    for (int m = gw; m < SEQ; m += NGW) row_to_bf16(a.in[0] + (size_t)m * DM, (float*)(ws + WS_RSTD) + m, (bf16*)(ws + WS_HN) + (size_t)m * DM, lane);
}

constexpr int AT_LD = 264;
static_assert(256 * AT_LD * 2 <= MISC_OFF, "attention LDS map");
__device__ __forceinline__ void attn_stage(const bf16* src, size_t row_pitch, LAS unsigned char* lds, int tid_in) {
    int tid = tid_in; asm volatile("" : "+v"(tid));
    const bf16* g = src + (size_t)(tid >> 5) * row_pitch + 8 * (tid & 31);
    LAS unsigned char* l = lds + (tid >> 5) * (AT_LD * 2) + 16 * (tid & 31);
    v4u r[16];
#pragma unroll
    for (int it = 0; it < 16; ++it) r[it] = *(const v4u*)(g + (size_t)(16 * it) * row_pitch);
#pragma unroll
    for (int it = 0; it < 16; ++it) *(LAS v4u*)(l + it * (16 * AT_LD * 2)) = r[it];
}
__device__ __forceinline__ void attn_wg(const bf16* Q, const bf16* SZ, const bf16* Kl, const bf16* VTl, bf16* Y, int pb, int h, LAS unsigned char* lds, int tid) {
    const int lane = tid & 63, wave = __builtin_amdgcn_readfirstlane(tid >> 6), fr = lane & 15, fq = lane >> 4;
    const int t0 = 256 * pb + 32 * wave;
    attn_stage(Kl + HDIM * h, MEMW, lds, tid);
    const bf16* qp0 = Q + (size_t)(t0 + fr) * MEMW + HDIM * h + 8 * fq; const bf16* qp1 = qp0 + (size_t)16 * MEMW;
    bf16x8 qa = *(const bf16x8*)qp0, qb = *(const bf16x8*)qp1, qa1 = *(const bf16x8*)(qp0 + 32), qb1 = *(const bf16x8*)(qp1 + 32), qa2 = *(const bf16x8*)(qp0 + 64), qb2 = *(const bf16x8*)(qp1 + 64);
    __syncthreads();
    const LAS bf16* lrow = (const LAS bf16*)lds + (8 * (fr >> 2) + (fr & 3)) * AT_LD + 8 * fq;
    f32x4 s[2][16];
#pragma unroll
    for (int i = 0; i < 16; ++i) { s[0][i] = (f32x4){0.f, 0.f, 0.f, 0.f}; s[1][i] = s[0][i]; }
#pragma unroll 1
    for (int ks = 0; ks < 8; ++ks) {
        const int kn = (ks < 5) ? ks + 3 : 7; const bf16x8 qan = *(const bf16x8*)(qp0 + 32 * kn), qbn = *(const bf16x8*)(qp1 + 32 * kn);
#pragma unroll
        for (int g = 0; g < 8; ++g)
#pragma unroll
            for (int e = 0; e < 2; ++e) { const bf16x8 kf = *(const LAS bf16x8*)(lrow + (32 * g + 4 * e) * AT_LD + 32 * ks);
                s[0][2 * g + e] = __builtin_amdgcn_mfma_f32_16x16x32_bf16(kf, qa, s[0][2 * g + e], 0, 0, 0); s[1][2 * g + e] = __builtin_amdgcn_mfma_f32_16x16x32_bf16(kf, qb, s[1][2 * g + e], 0, 0, 0); }
        qa = qa1; qb = qb1; qa1 = qa2; qb1 = qb2; qa2 = qan; qb2 = qbn; }
    float inv[2]; bf16x8 pf[2][8];
#pragma unroll
    for (int tg = 0; tg < 2; ++tg) { float mx = s[tg][0][0];
#pragma unroll
        for (int i = 0; i < 16; ++i)
#pragma unroll
            for (int j = 0; j < 4; ++j) mx = fmaxf(mx, s[tg][i][j]);
        mx = fmaxf(mx, __shfl_xor(mx, 16)); mx = fmaxf(mx, __shfl_xor(mx, 32));
        float sum = 0.f; const float mxl = mx * 1.44269504f;
#pragma unroll
        for (int i = 0; i < 16; ++i)
#pragma unroll
            for (int j = 0; j < 4; ++j) { const float p = __builtin_amdgcn_exp2f(s[tg][i][j] * 1.44269504f - mxl); s[tg][i][j] = p; sum += p; }
        sum += __shfl_xor(sum, 16); sum += __shfl_xor(sum, 32); inv[tg] = 1.0f / sum;
#pragma unroll
        for (int g = 0; g < 8; ++g) { v4u w; w.x = pk2(s[tg][2 * g][0], s[tg][2 * g][1]); w.y = pk2(s[tg][2 * g][2], s[tg][2 * g][3]); w.z = pk2(s[tg][2 * g + 1][0], s[tg][2 * g + 1][1]); w.w = pk2(s[tg][2 * g + 1][2], s[tg][2 * g + 1][3]);
            pf[tg][g] = __builtin_bit_cast(bf16x8, w); } }
    __syncthreads();
    attn_stage(VTl + (size_t)HDIM * h * NMEM, NMEM, lds, tid);
    __syncthreads();
    const bf16* szp0 = SZ + (size_t)(t0 + fr) * MEMW + HDIM * h + 8 * fq; const bf16* szp1 = szp0 + (size_t)16 * MEMW;
    v4u z0 = *(const v4u*)szp0, z1 = *(const v4u*)szp1;
#pragma unroll 1
    for (int db2 = 0; db2 < 8; ++db2) { f32x4 o[2][2];
        const int dn = (db2 < 7) ? db2 + 1 : 7; const v4u z0n = *(const v4u*)(szp0 + 32 * dn), z1n = *(const v4u*)(szp1 + 32 * dn);
#pragma unroll
        for (int tg = 0; tg < 2; ++tg) { o[tg][0] = (f32x4){0.f, 0.f, 0.f, 0.f}; o[tg][1] = o[tg][0]; }
#pragma unroll
        for (int ks2 = 0; ks2 < 8; ++ks2)
#pragma unroll
            for (int e = 0; e < 2; ++e) { const bf16x8 vf = *(const LAS bf16x8*)(lrow + (32 * db2 + 4 * e) * AT_LD + 32 * ks2);
                o[0][e] = __builtin_amdgcn_mfma_f32_16x16x32_bf16(vf, pf[0][ks2], o[0][e], 0, 0, 0); o[1][e] = __builtin_amdgcn_mfma_f32_16x16x32_bf16(vf, pf[1][ks2], o[1][e], 0, 0, 0); }
#pragma unroll
        for (int tg = 0; tg < 2; ++tg) { const size_t t = (size_t)(t0 + 16 * tg + fr); const int col = HDIM * h + 32 * db2 + 8 * fq; const float iv = inv[tg];
            const v4u z = tg ? z1 : z0;
            v4u w; w.x = pk2(o[tg][0][0] * iv * bflo(z.x), o[tg][0][1] * iv * bfhi(z.x)); w.y = pk2(o[tg][0][2] * iv * bflo(z.y), o[tg][0][3] * iv * bfhi(z.y));
            w.z = pk2(o[tg][1][0] * iv * bflo(z.z), o[tg][1][1] * iv * bfhi(z.z)); w.w = pk2(o[tg][1][2] * iv * bflo(z.w), o[tg][1][3] * iv * bfhi(z.w));
            *(v4u*)(Y + t * DM + BRW + col) = w; }
        z0 = z0n; z1 = z1n; }
    __syncthreads();
}

constexpr int CONV_ROWS = 16;
__device__ __forceinline__ void conv_rows(const bf16* GZ, const bf16* CH, const float* cw  , bf16* Y, int t0, int cs, int lane) {
    const int c = 512 * cs + 8 * lane;
    const int th = (t0 >= 2) ? t0 - 2 : 0; const float hz = (t0 >= 2) ? 1.f : 0.f;
    v4u uc[CONV_ROWS + 2], ug[CONV_ROWS];
    uc[0] = *(const v4u*)(CH + (size_t)th * BRW + c); uc[1] = *(const v4u*)(CH + (size_t)(th + 1) * BRW + c);
#pragma unroll
    for (int r = 0; r < CONV_ROWS; ++r) { uc[r + 2] = *(const v4u*)(CH + (size_t)(t0 + r) * BRW + c); ug[r] = *(const v4u*)(GZ + (size_t)(t0 + r) * BRW + c); }
    float w0[8], w1[8], w2[8], p2[8], p1[8];
    { const f32x4 a = *(const f32x4*)(cw + c), b = *(const f32x4*)(cw + c + 4), d = *(const f32x4*)(cw + BRW + c), e = *(const f32x4*)(cw + BRW + c + 4), f = *(const f32x4*)(cw + 2 * BRW + c), g = *(const f32x4*)(cw + 2 * BRW + c + 4);
#pragma unroll
      for (int i = 0; i < 4; ++i) { w0[i] = a[i]; w0[4 + i] = b[i]; w1[i] = d[i]; w1[4 + i] = e[i]; w2[i] = f[i]; w2[4 + i] = g[i]; } }
    p2[0] = bflo(uc[0].x) * hz; p2[1] = bfhi(uc[0].x) * hz; p2[2] = bflo(uc[0].y) * hz; p2[3] = bfhi(uc[0].y) * hz; p2[4] = bflo(uc[0].z) * hz; p2[5] = bfhi(uc[0].z) * hz; p2[6] = bflo(uc[0].w) * hz; p2[7] = bfhi(uc[0].w) * hz;
    p1[0] = bflo(uc[1].x) * hz; p1[1] = bfhi(uc[1].x) * hz; p1[2] = bflo(uc[1].y) * hz; p1[3] = bfhi(uc[1].y) * hz; p1[4] = bflo(uc[1].z) * hz; p1[5] = bfhi(uc[1].z) * hz; p1[6] = bflo(uc[1].w) * hz; p1[7] = bfhi(uc[1].w) * hz;
#pragma unroll
    for (int r = 0; r < CONV_ROWS; ++r) { const v4u u = uc[r + 2], q = ug[r];
        float cu[8], gz[8], o[8];
        cu[0] = bflo(u.x); cu[1] = bfhi(u.x); cu[2] = bflo(u.y); cu[3] = bfhi(u.y); cu[4] = bflo(u.z); cu[5] = bfhi(u.z); cu[6] = bflo(u.w); cu[7] = bfhi(u.w);
        gz[0] = bflo(q.x); gz[1] = bfhi(q.x); gz[2] = bflo(q.y); gz[3] = bfhi(q.y); gz[4] = bflo(q.z); gz[5] = bfhi(q.z); gz[6] = bflo(q.w); gz[7] = bfhi(q.w);
#pragma unroll
        for (int i = 0; i < 8; ++i) { o[i] = gz[i] * (w0[i] * p2[i] + w1[i] * p1[i] + w2[i] * cu[i]); p2[i] = p1[i]; p1[i] = cu[i]; }
        v4u w; w.x = pk2(o[0], o[1]); w.y = pk2(o[2], o[3]); w.z = pk2(o[4], o[5]); w.w = pk2(o[6], o[7]);
        *(v4u*)(Y + (size_t)(t0 + r) * DM + c) = w; }
}

constexpr int SP_LD = 136;
constexpr int SP_WL = 0, SP_VTL = 128 * SP_LD * 2, SP_MU = SP_VTL + 384 * SP_LD * 2, SP_RS = SP_MU + 512, SP_END = SP_RS + 512;
static_assert(SP_END <= MISC_OFF, "spatial LDS map");
__device__ __forceinline__ void spatial_member(const bf16* VG, const bf16* UZ, const float* vst, const float* Wl  , const float* bsl  , const float* lng, const float* lnb, bf16* Y, int nb, int g0, LAS unsigned char* lds, int tid) {
    LAS bf16* WL = (LAS bf16*)(lds + SP_WL); LAS bf16* VTL = (LAS bf16*)(lds + SP_VTL); LAS float* MU = (LAS float*)(lds + SP_MU); LAS float* RS = (LAS float*)(lds + SP_RS);
    const int lane = tid & 63, wave = __builtin_amdgcn_readfirstlane(tid >> 6), fr = lane & 15, fq = lane >> 4;
    const int sv = (lane & 31) + 32 * (wave & 3), cv0 = 8 * ((lane >> 5) + 2 * (wave >> 2));
    const bf16* vrow = VG + (size_t)(128 * nb + sv) * BRW + cv0;
    v4u vr[12];
#pragma unroll
    for (int it = 0; it < 12; ++it) vr[it] = *(const v4u*)(vrow + 384 * g0 + 32 * it);
    { const int row = tid >> 2, part = tid & 3; const float* q = vst + (size_t)(128 * nb + row) * 96 + 24 * part; float s1 = 0.f, s2 = 0.f;
        f32x4 pq[6];
#pragma unroll
        for (int k = 0; k < 6; ++k) pq[k] = *(const f32x4*)(q + 4 * k);
#pragma unroll
        for (int k = 0; k < 6; ++k) { s1 += pq[k][0] + pq[k][2]; s2 += pq[k][1] + pq[k][3]; }
        s1 += __shfl_xor(s1, 1); s1 += __shfl_xor(s1, 2); s2 += __shfl_xor(s2, 1); s2 += __shfl_xor(s2, 2);
        if (part == 0) { const float mu = s1 * (1.0f / BRW), var = s2 * (1.0f / BRW) - mu * mu; MU[row] = mu; RS[row] = 1.0f / sqrtf(var + LNORM_EPS); } }
    __syncthreads();
    const float mu = MU[sv], rs = RS[sv];
    const int th = wave >> 2, d0w = 96 * (wave & 3);
#pragma unroll
    for (int iu = 0; iu < 4; ++iu) { const int g = g0 + iu; const float* Wg = Wl + (size_t)g * 128 * 128; const float* bsg = bsl + g * 128;
        f32x4 wa[4], wb[4]; const int tw = tid >> 2, s0 = (tid & 3) * 32;
#pragma unroll
        for (int q = 0; q < 4; ++q) { wa[q] = *(const f32x4*)(Wg + tw * 128 + s0 + 8 * q); wb[q] = *(const f32x4*)(Wg + tw * 128 + s0 + 8 * q + 4); }
#pragma unroll
        for (int it = 0; it < 12; ++it) { const int c = cv0 + 32 * it; const v4u u = vr[it];
            const f32x4 ga = *(const f32x4*)(lng + 384 * g + c), gb = *(const f32x4*)(lng + 384 * g + c + 4), ba = *(const f32x4*)(lnb + 384 * g + c), bb = *(const f32x4*)(lnb + 384 * g + c + 4);
            float v[8] = {bflo(u.x), bfhi(u.x), bflo(u.y), bfhi(u.y), bflo(u.z), bfhi(u.z), bflo(u.w), bfhi(u.w)};
#pragma unroll
            for (int e = 0; e < 8; ++e) { const float gg = e < 4 ? ga[e & 3] : gb[e & 3], bq = e < 4 ? ba[e & 3] : bb[e & 3]; VTL[(c + e) * SP_LD + sv] = (bf16)f2bf((v[e] - mu) * rs * gg + bq); } }
#pragma unroll
        for (int q = 0; q < 4; ++q) { const int sb = s0 + 8 * q; float v[8] = {wa[q][0], wa[q][1], wa[q][2], wa[q][3], wb[q][0], wb[q][1], wb[q][2], wb[q][3]};
#pragma unroll
            for (int e = 0; e < 8; ++e) v[e] = (sb + e <= tw) ? v[e] : 0.f;
            v4u o; o.x = pk2(v[0], v[1]); o.y = pk2(v[2], v[3]); o.z = pk2(v[4], v[5]); o.w = pk2(v[6], v[7]);
            *(LAS v4u*)(WL + tw * SP_LD + sb) = o; }
        if (iu < 3) {
#pragma unroll
            for (int it = 0; it < 12; ++it) vr[it] = *(const v4u*)(vrow + 384 * (g + 1) + 32 * it); }
        __syncthreads();
#pragma unroll
        for (int hf = 0; hf < 2; ++hf) {
            v4u uz[2][3]; f32x4 acc[2][3][2];
#pragma unroll
            for (int i2 = 0; i2 < 2; ++i2) { const int i = 2 * hf + i2; const int tb = th ? ((i == 0) ? 1 : (i == 1) ? 2 : (i == 2) ? 5 : 6) : ((i == 0) ? 0 : (i == 1) ? 3 : (i == 2) ? 4 : 7);
#pragma unroll
                for (int dp = 0; dp < 3; ++dp) { uz[i2][dp] = *(const v4u*)(UZ + (size_t)(128 * nb + 16 * tb + fr) * BRW + 384 * g + d0w + 32 * dp + 8 * fq); acc[i2][dp][0] = (f32x4){0.f, 0.f, 0.f, 0.f}; acc[i2][dp][1] = (f32x4){0.f, 0.f, 0.f, 0.f}; } }
#pragma unroll
            for (int i2 = 0; i2 < 2; ++i2) { const int i = 2 * hf + i2; const int tb = th ? ((i == 0) ? 1 : (i == 1) ? 2 : (i == 2) ? 5 : 6) : ((i == 0) ? 0 : (i == 1) ? 3 : (i == 2) ? 4 : 7); const int kmax = tb >> 1;
#pragma unroll
                for (int ks = 0; ks < 4; ++ks) if (ks <= kmax) {
                    const bf16x8 bw = *(const LAS bf16x8*)(WL + (16 * tb + fr) * SP_LD + 32 * ks + 8 * fq);
#pragma unroll
                    for (int dp = 0; dp < 3; ++dp)
#pragma unroll
                        for (int e = 0; e < 2; ++e) { const bf16x8 av = *(const LAS bf16x8*)(VTL + (d0w + 32 * dp + 8 * (fr >> 2) + 4 * e + (fr & 3)) * SP_LD + 32 * ks + 8 * fq);
                            acc[i2][dp][e] = __builtin_amdgcn_mfma_f32_16x16x32_bf16(av, bw, acc[i2][dp][e], 0, 0, 0); } } }
#pragma unroll
            for (int i2 = 0; i2 < 2; ++i2) { const int i = 2 * hf + i2; const int tb = th ? ((i == 0) ? 1 : (i == 1) ? 2 : (i == 2) ? 5 : 6) : ((i == 0) ? 0 : (i == 1) ? 3 : (i == 2) ? 4 : 7);
                const int tl = 16 * tb + fr; const float bs = bsg[tl]; const size_t row = (size_t)(128 * nb + tl);
#pragma unroll
                for (int dp = 0; dp < 3; ++dp) { const int d = 384 * g + d0w + 32 * dp + 8 * fq; const v4u u = uz[i2][dp];
                    const f32x4 f0 = acc[i2][dp][0] + bs, f1 = acc[i2][dp][1] + bs;
                    v4u w; w.x = pk2(bflo(u.x) * f0[0], bfhi(u.x) * f0[1]); w.y = pk2(bflo(u.y) * f0[2], bfhi(u.y) * f0[3]); w.z = pk2(bflo(u.z) * f1[0], bfhi(u.z) * f1[1]); w.w = pk2(bflo(u.w) * f1[2], bfhi(u.w) * f1[3]);
                    *(v4u*)(Y + row * DM + d) = w; } } }
        __syncthreads(); }
}

__device__ __forceinline__ void p4_rows(const bf16* YO, const float* yss, const float* gpost, bf16* HN, float* rmsv, bf16* HNw, float* rmsw, float* out, bool last, int m0, int nrows, int lane) {
    for (int m = m0; m < m0 + nrows; ++m) {
        const float tot = wave_sum(yss[(size_t)m * 64 + lane]); const float rsy = 1.0f / sqrtf(tot * (1.0f / DM) + RMS_EPS); const float rmo = rmsv[m];
        float ss = 0.f; float xn[8][8];
#pragma unroll
        for (int i = 0; i < 8; ++i) { const int col = 512 * i + 8 * lane;
            const v4u yo = *(const v4u*)(YO + (size_t)m * DM + col), hb = *(const v4u*)(HN + (size_t)m * DM + col); const f32x4 g0 = *(const f32x4*)(gpost + col) * rsy, g1 = *(const f32x4*)(gpost + col + 4) * rsy;
            xn[i][0] = bflo(hb.x) * rmo + bflo(yo.x) * g0[0]; xn[i][1] = bfhi(hb.x) * rmo + bfhi(yo.x) * g0[1]; xn[i][2] = bflo(hb.y) * rmo + bflo(yo.y) * g0[2]; xn[i][3] = bfhi(hb.y) * rmo + bfhi(yo.y) * g0[3];
            xn[i][4] = bflo(hb.z) * rmo + bflo(yo.z) * g1[0]; xn[i][5] = bfhi(hb.z) * rmo + bfhi(yo.z) * g1[1]; xn[i][6] = bflo(hb.w) * rmo + bflo(yo.w) * g1[2]; xn[i][7] = bfhi(hb.w) * rmo + bfhi(yo.w) * g1[3];
#pragma unroll
            for (int e = 0; e < 8; ++e) ss += xn[i][e] * xn[i][e];
            if (last) { *(f32x4*)(out + (size_t)m * DM + col) = (f32x4){xn[i][0], xn[i][1], xn[i][2], xn[i][3]}; *(f32x4*)(out + (size_t)m * DM + col + 4) = (f32x4){xn[i][4], xn[i][5], xn[i][6], xn[i][7]}; } }
        if (!last) { ss = wave_sum(ss); const float rmn = sqrtf(ss * (1.0f / DM) + RMS_EPS), rs = 1.0f / rmn;
            if (lane == 0) rmsw[m] = rmn;
#pragma unroll
            for (int i = 0; i < 8; ++i) { const int col = 512 * i + 8 * lane;
                v4u w; w.x = pk2(xn[i][0] * rs, xn[i][1] * rs); w.y = pk2(xn[i][2] * rs, xn[i][3] * rs); w.z = pk2(xn[i][4] * rs, xn[i][5] * rs); w.w = pk2(xn[i][6] * rs, xn[i][7] * rs); *(v4u*)(HNw + (size_t)m * DM + col) = w; } }
    }
}

constexpr int CW_TEAM = 8192;
constexpr int CW_TMO = 64;
__device__ __forceinline__ void team_barrier(unsigned* ctl, int tm, unsigned gen, int nbr) {
    asm volatile("s_waitcnt vmcnt(0)" ::: "memory");
    __syncthreads();
    if (threadIdx.x == 0) {
        __builtin_amdgcn_fence(__ATOMIC_RELEASE, "agent");
        asm volatile("s_waitcnt vmcnt(0)" ::: "memory");
        unsigned* mine = ctl + CW_TEAM + 64 * tm; unsigned* other = ctl + CW_TEAM + 64 * (nbr >= 0 ? nbr : tm);
        (void)xb_add(mine, 1u);
        const unsigned want = 4u * gen; unsigned sp = 0u;
        while (xb_ld(mine) < want || xb_ld(other) < want) { __builtin_amdgcn_s_sleep(1);
            if ((++sp & 255u) == 0u) { if (xb_ld(ctl + CW_TMO)) break; if (sp > XB_SPIN_CAP) { atomicAdd(ctl + CW_TMO, 1u); break; } } }
        __builtin_amdgcn_fence(__ATOMIC_ACQUIRE, "agent");
        asm volatile("s_waitcnt vmcnt(0)" ::: "memory");
    }
    __syncthreads();
}

__global__ void __launch_bounds__(NWAVES * 64, 2) mk_fwd(Args args) {
    extern __shared__ __attribute__((aligned(16))) unsigned char lds_raw[];
    LAS unsigned char* lds = (LAS unsigned char*)lds_raw;
    const int G = gridDim.x, NGW = G * NWAVES;
    unsigned char* ws = args.ws;
    const int lo = args.ph_lo, hi = args.ph_hi;
    if (threadIdx.x < 32) ((LAS unsigned*)(lds + MISC_OFF))[threadIdx.x] = 0u;
    __syncthreads();
    XcdBarrier bar; bar.bar = (unsigned*)(ws + WS_CTL) + CW_BAR; bar.x = 0; bar.st = (volatile LAS unsigned*)(lds + MISC_OFF);
    if (hi - lo > 1) bar = xcd_barrier_post((unsigned*)(ws + WS_CTL) + CW_BAR, (volatile LAS unsigned*)(lds + MISC_OFF));
#define IN(k) (lo <= (k) && (k) < hi)
#define OPAQUE_IDS() int tid_ = threadIdx.x; asm volatile("" : "+v"(tid_)); const int tid = tid_, lane = tid & 63, wave = __builtin_amdgcn_readfirstlane(tid >> 6); int bx_ = blockIdx.x; asm volatile("" : "+s"(bx_)); const int gw = bx_ * NWAVES + wave; (void)gw; (void)lane
#define SEAM(k) do { if (IN(k) && IN((k) + 1)) for (int rb_ = 0; rb_ < REP_BAR; ++rb_) xcd_barrier(bar); } while (0)

    bf16* const A1 = (bf16*)(ws + WS_A1); bf16* const A2 = (bf16*)(ws + WS_A2); bf16* const QB = (bf16*)(ws + WS_Q); bf16* const SZ = (bf16*)(ws + WS_SZ);
    bf16* const YB = (bf16*)(ws + WS_Y); bf16* const YO = (bf16*)(ws + WS_YO); bf16* const KVB = (bf16*)(ws + WS_KV);
    float* const VST = (float*)(ws + WS_VST); float* const YSS = (float*)(ws + WS_YSS); bf16* const HN = (bf16*)(ws + WS_HN);

    if (TLB_WARM) {
        const unsigned idx = (blockIdx.x >> 3) * (NWAVES * 64) + threadIdx.x, nthr = (G >> 3) * (NWAVES * 64); unsigned acc = 0u;
        const size_t szs[8] = {(size_t)SEQ * DM * 4, (size_t)DEPTH * DM * NKV * 4, (size_t)DEPTH * DM * DM * 4, (size_t)2 * DM * NIN_CONV * 4, (size_t)2 * DM * NIN_GMLP * 4, (size_t)WS_END, (size_t)SEQ * DM * 4, (size_t)NMEM * DM * 4};
        const unsigned char* ptrs[8] = {(const unsigned char*)args.in[0], (const unsigned char*)args.in[5], (const unsigned char*)args.in[6], (const unsigned char*)args.in[7], (const unsigned char*)args.in[9], (const unsigned char*)ws, (const unsigned char*)args.out, (const unsigned char*)args.in[1]};
#pragma unroll
        for (int r = 0; r < 8; ++r) for (size_t pg = idx; pg < (szs[r] >> 16); pg += nthr) acc += *(const volatile unsigned*)(ptrs[r] + (pg << 16));
        asm volatile("" :: "v"(acc));
    }
    for (int ra = 0; ra < REP_ALL; ++ra) {
    if (ra) xcd_barrier(bar);
    if (IN(0)) { for (int rep = 0; rep < REP_P0; ++rep) { OPAQUE_IDS(); p0a_convert(args, ws, lds, gw, NGW, wave, lane); } }
    SEAM(0);
    if (IN(1)) {
        for (int rep = 0; rep < REP_KV; ++rep) {
        pg8::Gemm g{(const bf16*)(ws + WS_MEMB), (const bf16*)(ws + WS_WKV), NMEM, DEPTH * NKV, DM}; pg8::StaticOrder S; S.init(NMEM, DEPTH * NKV, G, (int)blockIdx.x);
        pg8::EpiKV E{KVB};
        pg8::gemm_phase<pg8::EpiKV, pg8::StaticOrder, GP_ALIGN, GP_SP2>(lds, g, S, E); }
        { OPAQUE_IDS(); p0b_convert(args, ws, lds, gw, NGW, wave, lane); }
    }
    SEAM(1);
    unsigned* const ctl = (unsigned*)(ws + WS_CTL);
    for (int L = 0; L < DEPTH; ++L) {
        const int k0 = 2 + 4 * L, gm = L & 1, jj = L >> 1;
        if (IN(k0)) for (int rep = 0; rep < REP_P1; ++rep) {
            const size_t woff = (L == 0) ? WIN_OFF0 : (L == 1) ? WIN_OFF1 : (L == 2) ? WIN_OFF2 : WIN_OFF3; const int nin = gm ? NIN_GMLP : NIN_CONV;
            pg8::Gemm g{HN, (const bf16*)(ws + WS_WIN + woff), SEQ, nin, DM}; pg8::StaticOrder S; S.init(SEQ, nin, G, (int)blockIdx.x);
            pg8::EpiProj E{A1, VST, gm, YB, args.in[8] + (size_t)jj * 3 * BRW, (float*)(ws + WS_CHT) + (size_t)jj * 256 * 2 * BRW, (float*)(ws + WS_GZH) + (size_t)jj * 256 * 2 * BRW};
            pg8::gemm_phase<pg8::EpiProj, pg8::StaticOrder, GP_ALIGN, GP_SP2>(lds, g, S, E);
            if (REP_SYNC && rep + 1 < REP_P1) xcd_barrier(bar);
        }
        { OPAQUE_IDS(); const int tm = 8 * (bx_ & 7) + ((bx_ >> 3) & 7); team_barrier(ctl, tm, 15 * ra + 4 * L + 1, (gm == 0 && tm > 0) ? tm - 1 : -1); }
        if (IN(k0 + 1)) for (int rep = 0; rep < (gm ? REP_P2G : REP_P2); ++rep) { OPAQUE_IDS(); const int tm = 8 * (bx_ & 7) + ((bx_ >> 3) & 7), km = bx_ >> 6;
            const bf16* Kl = KVB + (size_t)L * (2 * 256 * 1024); const bf16* VTl = Kl + 256 * 1024;
            if (gm) {
                const float* ws_w = args.in[12] + (size_t)jj * 8 * 128 * 128; const float* bs = args.in[13] + (size_t)jj * 8 * 128; const float* lng = args.in[10] + (size_t)jj * BRW; const float* lnb = args.in[11] + (size_t)jj * BRW;
                spatial_member(A2, A1, VST, ws_w, bs, lng, lnb, YB, 2 * tm + (km >> 1), 4 * (km & 1), lds, tid);
            } else {
                const float* cw = args.in[8] + (size_t)jj * 3 * BRW; const int gr = 4 * tm + km;
                if (gr > 0) { const float* cht = (const float*)(ws + WS_CHT) + ((size_t)jj * 256 + (gr - 1)) * 2 * BRW; const float* gzh = (const float*)(ws + WS_GZH) + ((size_t)jj * 256 + gr) * 2 * BRW;
                    for (int c = 4 * tid; c < BRW; c += 4 * NWAVES * 64) {
                        const f32x4 w0 = *(const f32x4*)(cw + c), w1 = *(const f32x4*)(cw + BRW + c), a0 = *(const f32x4*)(cht + c), a1 = *(const f32x4*)(cht + BRW + c), g0 = *(const f32x4*)(gzh + c), g1 = *(const f32x4*)(gzh + BRW + c);
                        bf16* y0 = YB + (size_t)(64 * gr) * DM + c; bf16* y1 = y0 + DM; const v2u u0 = *(const v2u*)y0, u1 = *(const v2u*)y1;
                        const f32x4 f0 = g0 * (w0 * a0 + w1 * a1), f1 = g1 * (w0 * a1);
                        v2u o0, o1; o0.x = pk2(bflo(u0.x) + f0[0], bfhi(u0.x) + f0[1]); o0.y = pk2(bflo(u0.y) + f0[2], bfhi(u0.y) + f0[3]); o1.x = pk2(bflo(u1.x) + f1[0], bfhi(u1.x) + f1[1]); o1.y = pk2(bflo(u1.y) + f1[2], bfhi(u1.y) + f1[3]);
                        *(v2u*)y0 = o0; *(v2u*)y1 = o1; } }
            }
            for (int ra2 = 0; ra2 < REP_ATT; ++ra2) attn_wg(QB, SZ, Kl, VTl, YB, tm, km, lds, tid);
        }
        { OPAQUE_IDS(); const int tm = 8 * (bx_ & 7) + ((bx_ >> 3) & 7); team_barrier(ctl, tm, 15 * ra + 4 * L + 2, -1); }
        if (IN(k0 + 2)) for (int rep = 0; rep < REP_P3; ++rep) {
            pg8::Gemm g{YB, (const bf16*)(ws + WS_WOUT) + (size_t)L * DM * DM, SEQ, DM, DM}; pg8::StaticOrder S; S.init(SEQ, DM, G, (int)blockIdx.x);
            pg8::EpiOut E{YO, YSS};
            if (FAKE_P3) { pg8::FakeOrder SF; SF.init(SEQ, DM, G, (int)blockIdx.x); pg8::gemm_phase<pg8::EpiOut, pg8::FakeOrder, GP_ALIGN, GP_SP2>(lds, g, SF, E); }
            pg8::gemm_phase<pg8::EpiOut, pg8::StaticOrder, GP_ALIGN, GP_SP2>(lds, g, S, E);
            if (REP_SYNC && rep + 1 < REP_P3) xcd_barrier(bar);
        }
        { OPAQUE_IDS(); const int tm = 8 * (bx_ & 7) + ((bx_ >> 3) & 7); team_barrier(ctl, tm, 15 * ra + 4 * L + 3, -1); }
        if (IN(k0 + 3)) { OPAQUE_IDS(); const int tm = 8 * (bx_ & 7) + ((bx_ >> 3) & 7), km = bx_ >> 6;
            for (int rep = 1; rep < REP_P4; ++rep) p4_rows(YO, YSS, args.in[3] + (size_t)L * DM, HN, (float*)(ws + WS_RSTD), YB, (float*)(ws + WS_RSTDM), args.out, L == DEPTH - 1, 256 * tm + 64 * km + 8 * wave, 8, lane);
            p4_rows(YO, YSS, args.in[3] + (size_t)L * DM, HN, (float*)(ws + WS_RSTD), HN, (float*)(ws + WS_RSTD), args.out, L == DEPTH - 1, 256 * tm + 64 * km + 8 * wave, 8, lane); }
        if (L < DEPTH - 1) { OPAQUE_IDS(); const int tm = 8 * (bx_ & 7) + ((bx_ >> 3) & 7); team_barrier(ctl, tm, 15 * ra + 4 * L + 4, -1); if (GRID_PER_LAYER) xcd_barrier(bar); }
    }
    }
#undef IN
#undef SEAM
}

extern "C" void kernel_launch(void* const* d_in, const int* in_sizes, int n_in, void* d_out, int out_size, void* d_ws, size_t ws_size, hipStream_t stream) {
    static int grid = 0;
    if (grid == 0) {
        if (n_in != 14 || in_sizes[0] != SEQ * DM || out_size != SEQ * DM || ws_size < WS_END) { fprintf(stderr, "kernel_launch: unexpected shapes / workspace (n_in %d, in0 %d, out %d, ws %zu, need %zu); nothing launched\n", n_in, n_in > 0 ? in_sizes[0] : -1, out_size, ws_size, (size_t)WS_END); grid = -1; return; }
        int dev = 0, cus = 0, per_cu = 0;
        if (hipGetDevice(&dev) != hipSuccess || hipDeviceGetAttribute(&cus, hipDeviceAttributeMultiprocessorCount, dev) != hipSuccess) { grid = -1; return; }
        if (hipFuncSetAttribute((const void*)mk_fwd, hipFuncAttributeMaxDynamicSharedMemorySize, LDS_BYTES) != hipSuccess) { fprintf(stderr, "kernel_launch: hipFuncSetAttribute failed\n"); grid = -1; return; }
        if (hipOccupancyMaxActiveBlocksPerMultiprocessor(&per_cu, (const void*)mk_fwd, NWAVES * 64, LDS_BYTES) != hipSuccess || per_cu < 1) { fprintf(stderr, "kernel_launch: occupancy query says %d\n", per_cu); }
        (void)hipGetLastError();
        grid = cus;
    }
    if (grid < 0) return;
    if (hipMemsetAsync((char*)d_ws + WS_CTL, 0, CTL_ZERO_BYTES, stream) != hipSuccess) return;
    Args a{};
    for (int i = 0; i < 14; ++i) a.in[i] = (const float*)d_in[i];
    a.out = (float*)d_out; a.ws = (unsigned char*)d_ws;
#if MK_ONE_LAUNCH
    a.ph_lo = 0; a.ph_hi = NPHASE;
    hipLaunchKernelGGL(mk_fwd, dim3(grid), dim3(NWAVES * 64), LDS_BYTES, stream, a);
#else
    for (int k = 0; k < NPHASE; ++k) { a.ph_lo = k; a.ph_hi = k + 1; hipLaunchKernelGGL(mk_fwd, dim3(grid), dim3(NWAVES * 64), LDS_BYTES, stream, a); }
#endif
}
```

```cpp
#include <hip/hip_runtime.h>
#include <cstdio>
#include <cstdint>
#ifndef EPI_REP
#define EPI_REP 1
#endif
#ifndef NT_STORES
#define NT_STORES 0
#endif
namespace pg8 {
#define PG8_LAS __attribute__((address_space(3)))
typedef unsigned short bf16_t;
typedef short bf16x8 __attribute__((ext_vector_type(8)));
typedef float f32x4 __attribute__((ext_vector_type(4)));
typedef unsigned u32x4 __attribute__((ext_vector_type(4)));
constexpr int BM = 256, BK = 64, HALF = 128, HTB = HALF * BK * 2  , STAGE_BYTES = 8 * HTB, NXCD = 8, WGM = 8;

__host__ __device__ __forceinline__ int lds_byte(int r, int c) { const int st = (r >> 4) * 2 + (c >> 5), rr = r & 15, cc = c & 31, ob = rr * 64 + cc * 2; return st * 1024 + (ob ^ (((ob >> 9) & 1) << 5)); }
__host__ __device__ __forceinline__ void stage_rc(int b, int& R, int& C) { const int st = b / 1024, sb = b % 1024, swz = sb ^ (((sb >> 9) & 1) << 5); R = (st >> 1) * 16 + swz / 64; C = (st & 1) * 32 + (swz % 64) / 2; }
__host__ __device__ __forceinline__ int perm32(int rho) { const int n = rho >> 4, i = rho & 15; return 8 * (i >> 2) + 4 * n + (i & 3); }

struct Unit { int pm, pn; };
struct Gemm { const bf16_t* A; const bf16_t* Bt; int M, N, K; };

struct StaticOrder {
    int nM, nN, nwg, G, c;
    __host__ __device__ void init(int M, int N, int G_, int c_) { nM = M / BM; nN = N / BM; nwg = nM * nN; G = G_; c = c_; }
    __host__ __device__ bool next(int i, Unit& u) const {
        const long L = (long)i * G + c; if (L >= nwg) return false;
        int wgid = (int)L; { const int q = nwg / NXCD, r = nwg % NXCD, xcd = wgid % NXCD, off = wgid / NXCD; wgid = (xcd < r ? xcd * (q + 1) : r * (q + 1) + (xcd - r) * q) + off; }
        const int nig = WGM * nN, gid = wgid / nig, fm = gid * WGM, gsz = (nM - fm) < WGM ? (nM - fm) : WGM;
        u.pm = fm + ((wgid % nig) % gsz); u.pn = (wgid % nig) / gsz; return true;
    }
    __device__ __forceinline__ void a_ready(const Unit&) const {}
    __device__ __forceinline__ void done(const Unit&) const {}
    __device__ __forceinline__ int apm(const Unit& u) const { return u.pm; }
    __device__ __forceinline__ int bpn(const Unit& u) const { return u.pn; }
};
struct FakeOrder : StaticOrder {
    __device__ __forceinline__ int apm(const Unit&) const { return 0; }
    __device__ __forceinline__ int bpn(const Unit&) const { return 0; }
};


__device__ __forceinline__ unsigned cvt_pk_bf16(float lo, float hi) { unsigned r; asm("v_cvt_pk_bf16_f32 %0, %1, %2" : "=v"(r) : "v"(lo), "v"(hi)); return r; }
__device__ __forceinline__ float silu_f(float z) { return z * __builtin_amdgcn_rcpf(1.0f + __builtin_amdgcn_exp2f(-1.44269504f * z)); }
__device__ __forceinline__ float gelu_f(float x) { const float u = x * (0.7978845608f + 0.0356774081f * x * x); return x * __builtin_amdgcn_rcpf(1.0f + __builtin_amdgcn_exp2f(-2.88539008f * u)); }
__device__ __forceinline__ unsigned short f2bf1(float f) { unsigned u = __builtin_bit_cast(unsigned, f); return (unsigned short)((u + 0x7fffu + ((u >> 16) & 1u)) >> 16); }

template <int CTRL> __device__ __forceinline__ float dpp_keep(float old, float src) {
    return __builtin_bit_cast(float, __builtin_amdgcn_update_dpp(__builtin_bit_cast(int, old), __builtin_bit_cast(int, src), CTRL, 0xf, 0xf, false)); }
#if NT_STORES
#define ST_OUT(p, v) __builtin_nontemporal_store((v), (p))
#else
#define ST_OUT(p, v) (*(p) = (v))
#endif
typedef float f32x2 __attribute__((ext_vector_type(2)));
typedef unsigned u32x2 __attribute__((ext_vector_type(2)));
__device__ __forceinline__ f32x2 exp2n(f32x2 t) { f32x2 e; e.x = __builtin_amdgcn_exp2f(t.x); e.y = __builtin_amdgcn_exp2f(t.y); return e; }
__device__ __forceinline__ f32x2 rcp2(f32x2 d) { f32x2 r; r.x = __builtin_amdgcn_rcpf(d.x); r.y = __builtin_amdgcn_rcpf(d.y); return r; }
__device__ __forceinline__ f32x2 silu2(f32x2 z) { return z * rcp2(exp2n(z * (-1.44269504f)) + 1.0f); }
__device__ __forceinline__ f32x2 gelu_arg2(f32x2 x) { return x * ((x * x) * (-2.88539008f * 0.0356774081f) + (-2.88539008f * 0.7978845608f)); }
__device__ __forceinline__ f32x2 gelu2(f32x2 x) { return x * rcp2(exp2n(gelu_arg2(x)) + 1.0f); }
__device__ __forceinline__ f32x2 gelu_silu2(f32x2 u, f32x2 z) { return (u * z) * rcp2((exp2n(gelu_arg2(u)) + 1.0f) * (exp2n(z * (-1.44269504f)) + 1.0f)); }
struct EpiProj {
    static constexpr bool PERM = false, AFTER_DRAIN = false;
    bf16_t* base; float* vst; int gm; bf16_t* Y; const float* cw; float* cht; float* gzh;
    static constexpr size_t OFF_A2 = (size_t)48 << 20, OFF_Q = (size_t)96 << 20, OFF_SZ = (size_t)112 << 20;
    enum { K_UZ = 2, K_Q = 3, K_ZM = 4, K_V = 5, K_BR = 6 };
    __device__ __forceinline__ void branch_tile(const f32x4 (&acc)[2][2][4][2], int pm, int p, int row0, int wr, int wc, int fr, int fq) const {
        const int c0 = 64 * p + 16 * wc + 4 * fq;
        const f32x4 w0 = *(const f32x4*)(cw + c0), w1 = *(const f32x4*)(cw + 3072 + c0), w2 = *(const f32x4*)(cw + 2 * 3072 + c0);
#pragma unroll
        for (int ai = 0; ai < 2; ++ai) { f32x4 chp = (f32x4){0.f, 0.f, 0.f, 0.f};
#pragma unroll
            for (int m = 0; m < 4; ++m) { const int r = row0 + ai * HALF + m * 16;
                const f32x4 bv = acc[ai][0][m][0], cv = acc[ai][0][m][1], hv = acc[ai][1][m][0], zv = acc[ai][1][m][1];
                const f32x4 ch = cv * hv; const f32x2 g01 = (f32x2){bv[0], bv[1]} * silu2((f32x2){zv[0], zv[1]}), g23 = (f32x2){bv[2], bv[3]} * silu2((f32x2){zv[2], zv[3]});
                const f32x4 gz = (f32x4){g01.x, g01.y, g23.x, g23.y}; f32x4 p1, p2;
#pragma unroll
                for (int j = 0; j < 4; ++j) {
                    p1[j] = dpp_keep<0x111>(dpp_keep<0x121>(0.f, chp[j]), ch[j]);
                    p2[j] = dpp_keep<0x112>(dpp_keep<0x122>(0.f, chp[j]), ch[j]); }
                const f32x4 o = gz * (w0 * p2 + w1 * p1 + w2 * ch);
                u32x2 w; w.x = cvt_pk_bf16(o[0], o[1]); w.y = cvt_pk_bf16(o[2], o[3]);
                ST_OUT((u32x2*)(Y + (size_t)r * 4096 + c0), w);
                const int gr = (pm * 4 + ai * 2 + wr);
                if (m == 0 && fr < 2) *(f32x4*)(gzh + ((size_t)gr * 2 + fr) * 3072 + c0) = gz;
                if (m == 3 && fr >= 14) *(f32x4*)(cht + ((size_t)gr * 2 + (fr - 14)) * 3072 + c0) = ch;
                chp = ch; } }
    }
    __device__ __forceinline__ void uz_tile(const f32x4 (&acc)[2][2][4][2], int p, int row0, int wc, int fq) const {
        bf16_t* O = base; const int col0 = 128 * p + 32 * wc + 8 * fq;
#pragma unroll
        for (int ai = 0; ai < 2; ++ai)
#pragma unroll
            for (int m = 0; m < 4; ++m) { const int r = row0 + ai * HALF + m * 16; u32x4 w;
#pragma unroll
                for (int n = 0; n < 2; ++n) { const f32x4 a = acc[ai][0][m][n], b = acc[ai][1][m][n];
                    const f32x2 lo = gelu_silu2((f32x2){a[0], a[1]}, (f32x2){b[0], b[1]}), hi = gelu_silu2((f32x2){a[2], a[3]}, (f32x2){b[2], b[3]});
                    if (n == 0) { w.x = cvt_pk_bf16(lo.x, lo.y); w.y = cvt_pk_bf16(hi.x, hi.y); } else { w.z = cvt_pk_bf16(lo.x, lo.y); w.w = cvt_pk_bf16(hi.x, hi.y); } }
                ST_OUT((u32x4*)(O + (size_t)r * 3072 + col0), w); }
    }
    template <int KIND> __device__ __forceinline__ void plain_tile(const f32x4 (&acc)[2][2][4][2], int p, int row0, int wc, int fq) const {
        bf16_t* O = base + ((KIND == K_Q) ? OFF_Q : (KIND == K_ZM) ? OFF_SZ : OFF_A2); constexpr int ldo = (KIND == K_V) ? 3072 : 1024; const int col0 = 256 * p + 32 * wc + 8 * fq;
#pragma unroll
        for (int ai = 0; ai < 2; ++ai)
#pragma unroll
            for (int m = 0; m < 4; ++m) { const int r = row0 + ai * HALF + m * 16; f32x2 s1 = (f32x2){0.f, 0.f}, s2 = s1;
#pragma unroll
                for (int bj = 0; bj < 2; ++bj) { u32x4 w;
#pragma unroll
                    for (int n = 0; n < 2; ++n) { const f32x4 a = acc[ai][bj][m][n]; f32x2 lo = (f32x2){a[0], a[1]}, hi = (f32x2){a[2], a[3]};
                        if (KIND == K_Q) { lo = lo * 0.0625f; hi = hi * 0.0625f; } else if (KIND == K_ZM) { lo = silu2(lo); hi = silu2(hi); } else { lo = gelu2(lo); hi = gelu2(hi); s1 += lo + hi; s2 += lo * lo + hi * hi; }
                        if (n == 0) { w.x = cvt_pk_bf16(lo.x, lo.y); w.y = cvt_pk_bf16(hi.x, hi.y); } else { w.z = cvt_pk_bf16(lo.x, lo.y); w.w = cvt_pk_bf16(hi.x, hi.y); } }
                    ST_OUT((u32x4*)(O + (size_t)r * ldo + col0 + bj * HALF), w); }
                if (KIND == K_V) { float t1 = s1.x + s1.y, t2 = s2.x + s2.y; t1 += __shfl_xor(t1, 16); t1 += __shfl_xor(t1, 32); t2 += __shfl_xor(t2, 16); t2 += __shfl_xor(t2, 32);
                    if (fq == 0) { float* q = vst + ((size_t)r * 48 + p * 4 + wc) * 2; q[0] = t1; q[1] = t2; } } }
    }
    __device__ __forceinline__ void operator()(const f32x4 (&acc)[2][2][4][2], const Unit& u, int wr, int wc, int fr, int fq) const {
        asm volatile("" : "+v"(fr), "+v"(fq));
        const int pn = u.pn, row0 = u.pm * BM + wr * 64 + fr;
        if (gm == 0) { if (pn < 48) branch_tile(acc, u.pm, pn, row0, wr, wc, fr, fq); else if (pn < 52) plain_tile<K_Q>(acc, pn - 48, row0, wc, fq); else plain_tile<K_ZM>(acc, pn - 52, row0, wc, fq); }
        else { if (pn < 24) uz_tile(acc, pn, row0, wc, fq); else if (pn < 36) plain_tile<K_V>(acc, pn - 24, row0, wc, fq); else if (pn < 40) plain_tile<K_Q>(acc, pn - 36, row0, wc, fq); else plain_tile<K_ZM>(acc, pn - 40, row0, wc, fq); }
    }
};
struct EpiOut {
    static constexpr bool PERM = false, AFTER_DRAIN = false;
    bf16_t* YO; float* yss;
    __device__ __forceinline__ void operator()(const f32x4 (&acc)[2][2][4][2], const Unit& u, int wr, int wc, int fr, int fq) const {
        asm volatile("" : "+v"(fr), "+v"(fq));
        const int row0 = u.pm * BM + wr * 64 + fr, col0 = 256 * u.pn + 32 * wc + 8 * fq;
#pragma unroll
        for (int ai = 0; ai < 2; ++ai)
#pragma unroll
            for (int m = 0; m < 4; ++m) { const int r = row0 + ai * HALF + m * 16; float ss = 0.f;
#pragma unroll
                for (int bj = 0; bj < 2; ++bj) { const f32x4 a = acc[ai][bj][m][0], b = acc[ai][bj][m][1];
                    ss += (a[0] * a[0] + a[1] * a[1]) + (a[2] * a[2] + a[3] * a[3]) + (b[0] * b[0] + b[1] * b[1]) + (b[2] * b[2] + b[3] * b[3]);
                    u32x4 w; w.x = cvt_pk_bf16(a[0], a[1]); w.y = cvt_pk_bf16(a[2], a[3]); w.z = cvt_pk_bf16(b[0], b[1]); w.w = cvt_pk_bf16(b[2], b[3]);
                    ST_OUT((u32x4*)(YO + (size_t)r * 4096 + col0 + bj * HALF), w); }
                ss += __shfl_xor(ss, 16); ss += __shfl_xor(ss, 32);
                if (fq == 0) yss[(size_t)r * 64 + u.pn * 4 + wc] = ss; }
    }
};
struct EpiKV {
    static constexpr bool PERM = false, AFTER_DRAIN = false;
    bf16_t* KV;
    __device__ __forceinline__ void operator()(const f32x4 (&acc)[2][2][4][2], const Unit& u, int wr, int wc, int fr, int fq) const {
        asm volatile("" : "+v"(fr), "+v"(fq));
        const int l = u.pn >> 3, t = u.pn & 7; bf16_t* base = KV + (size_t)l * (2 * 256 * 1024); const int row0 = wr * 64 + fr;
#pragma unroll
        for (int ai = 0; ai < 2; ++ai)
#pragma unroll
            for (int m = 0; m < 4; ++m) { const int r = row0 + ai * HALF + m * 16;
#pragma unroll
                for (int bj = 0; bj < 2; ++bj) { const f32x4 a = acc[ai][bj][m][0], b = acc[ai][bj][m][1];
                    if (t < 4) { u32x4 w; w.x = cvt_pk_bf16(a[0], a[1]); w.y = cvt_pk_bf16(a[2], a[3]); w.z = cvt_pk_bf16(b[0], b[1]); w.w = cvt_pk_bf16(b[2], b[3]);
                        ST_OUT((u32x4*)(base + (size_t)r * 1024 + 256 * t + bj * HALF + 32 * wc + 8 * fq), w); }
                    else { bf16_t* vt = base + 256 * 1024 + (size_t)(256 * (t - 4) + bj * HALF + 32 * wc + 8 * fq) * 256 + r;
#pragma unroll
                        for (int j = 0; j < 4; ++j) { vt[(size_t)j * 256] = f2bf1(a[j]); vt[(size_t)(4 + j) * 256] = f2bf1(b[j]); } } } }
    }
};
template <class Epi, class Sched, bool ALIGN_EPI = false, bool SP2 = false>
__device__ __forceinline__ void gemm_phase(PG8_LAS unsigned char* lds, const Gemm g, const Sched& S, const Epi& E) {
    int tid_ = threadIdx.x; asm volatile("" : "+v"(tid_));
    const int tid = tid_, wid = __builtin_amdgcn_readfirstlane(tid >> 6), lane = tid & 63, wr = wid >> 2, wc = wid & 3, fr = lane & 15, fq = lane >> 4;
    const int K = g.K, nt = K / BK;
    unsigned voffA[2], voffB[2];
#pragma unroll
    for (int i = 0; i < 2; ++i) { int R, C; stage_rc(tid * 16 + i * 8192, R, C); const int Rb = Epi::PERM ? ((R & ~31) + perm32(R & 31)) : R;
        voffA[i] = (unsigned)(R * K + C) * 2u; voffB[i] = (unsigned)(Rb * K + C) * 2u; }
    const size_t kstep = (size_t)(BK * 2);
    const size_t hstep = (size_t)HALF * K * 2;
    const size_t tstep = 2 * hstep;
    const unsigned ldsw = (unsigned)wid * 1024u;
    const int aoff = lds_byte(wr * 64 + fr, fq * 8), boff = lds_byte(wc * 32 + fr, fq * 8);
#define PG8_SA(b, h) (((b) * 2 + (h)) * HTB)
#define PG8_SB(b, h) ((4 + (b) * 2 + (h)) * HTB)
#define PG8_STAGE(bufoff, gbase, voff) do { _Pragma("unroll") for (int _i = 0; _i < 2; ++_i) \
        __builtin_amdgcn_global_load_lds((const unsigned*)((const char*)(gbase) + (voff)[_i]), (PG8_LAS unsigned*)(lds + (bufoff) + ldsw + _i * 8192), 16, 0, 0); } while (0)
#define PG8_LDA(dst, b, h) do { _Pragma("unroll") for (int m = 0; m < 4; ++m) _Pragma("unroll") for (int k = 0; k < 2; ++k) dst[m][k] = *(const PG8_LAS bf16x8*)(lds + PG8_SA(b, h) + aoff + m * 2048 + k * 1024); } while (0)
#define PG8_LDB(dst, b, h) do { _Pragma("unroll") for (int n = 0; n < 2; ++n) _Pragma("unroll") for (int k = 0; k < 2; ++k) dst[n][k] = *(const PG8_LAS bf16x8*)(lds + PG8_SB(b, h) + boff + n * 2048 + k * 1024); } while (0)
#define PG8_MMA(ai, bj, At, Bt) do { __builtin_amdgcn_s_setprio(1); _Pragma("unroll") for (int m = 0; m < 4; ++m) _Pragma("unroll") for (int n = 0; n < 2; ++n) _Pragma("unroll") for (int k = 0; k < 2; ++k) \
        acc[ai][bj][m][n] = __builtin_amdgcn_mfma_f32_16x16x32_bf16(Bt[n][k], At[m][k], acc[ai][bj][m][n], 0, 0, 0); __builtin_amdgcn_s_setprio(0); } while (0)
#define PG8_WAIT_V(n) asm volatile("s_waitcnt vmcnt(" #n ")" ::: "memory")
#define PG8_WAIT_L(n) asm volatile("s_waitcnt lgkmcnt(" #n ")" ::: "memory")
#define PG8_BAR __builtin_amdgcn_s_barrier()
#define PG8_SCHED __builtin_amdgcn_sched_barrier(0)
    Unit cur, nxt; int ui = 0;
    if (!S.next(0, cur)) return;
    f32x4 acc[2][2][4][2];
#pragma unroll
    for (int a = 0; a < 2; ++a)
#pragma unroll
        for (int b = 0; b < 2; ++b)
#pragma unroll
            for (int m = 0; m < 4; ++m)
#pragma unroll
                for (int n = 0; n < 2; ++n) acc[a][b][m][n] = (f32x4){0.f, 0.f, 0.f, 0.f};
    bf16x8 At[4][2], B0[2][2], B1[2][2];
    const char* cA = (const char*)g.A + (size_t)S.apm(cur) * tstep; const char* cB = (const char*)g.Bt + (size_t)S.bpn(cur) * tstep;
    S.a_ready(cur);
    if constexpr (SP2) {
        PG8_STAGE(PG8_SB(0, 0), cB, voffB); PG8_STAGE(PG8_SB(0, 1), cB + hstep, voffB); PG8_STAGE(PG8_SA(0, 0), cA, voffA); PG8_STAGE(PG8_SA(0, 1), cA + hstep, voffA);
        if (wr == 1) PG8_BAR;
        PG8_WAIT_V(2); PG8_BAR;
        PG8_STAGE(PG8_SB(1, 0), cB + kstep, voffB); PG8_STAGE(PG8_SA(1, 0), cA + kstep, voffA); PG8_STAGE(PG8_SB(1, 1), cB + hstep + kstep, voffB);
        PG8_WAIT_V(6); PG8_BAR;
    } else {
        PG8_STAGE(PG8_SB(0, 0), cB, voffB); PG8_STAGE(PG8_SA(0, 0), cA, voffA); PG8_STAGE(PG8_SB(0, 1), cB + hstep, voffB); PG8_STAGE(PG8_SA(0, 1), cA + hstep, voffA);
        if (wr == 1) PG8_BAR;
        PG8_WAIT_V(4); PG8_BAR;
        PG8_STAGE(PG8_SB(1, 0), cB + kstep, voffB); PG8_STAGE(PG8_SA(1, 0), cA + kstep, voffA); PG8_STAGE(PG8_SB(1, 1), cB + hstep + kstep, voffB);
        PG8_WAIT_V(6); PG8_BAR;
    }
    for (;;) {
        const bool has_next = S.next(ui + 1, nxt);
        const char* nA = has_next ? (const char*)g.A + (size_t)S.apm(nxt) * tstep : cA; const char* nB = has_next ? (const char*)g.Bt + (size_t)S.bpn(nxt) * tstep : cB;
        for (int t = 0; t < nt; t += 2) {
            const bool last = (t == nt - 2);
            const char* a1 = cA + (size_t)(t + 1) * kstep;
            const char* a2 = last ? nA : cA + (size_t)(t + 2) * kstep; const char* b2 = last ? nB : cB + (size_t)(t + 2) * kstep;
            const char* a3 = a2 + kstep; const char* b3 = b2 + kstep;
            if (last && has_next) S.a_ready(nxt);
            if constexpr (SP2) {
            PG8_LDB(B0, 0, 0); PG8_LDB(B1, 0, 1); PG8_SCHED; PG8_LDA(At, 0, 0); PG8_STAGE(PG8_SA(1, 1), a1 + hstep, voffA);
            PG8_WAIT_V(8); PG8_WAIT_L(0); PG8_BAR; PG8_MMA(0, 0, At, B0); PG8_MMA(0, 1, At, B1); PG8_BAR; PG8_SCHED;
            PG8_LDA(At, 0, 1); PG8_STAGE(PG8_SB(0, 0), b2, voffB); PG8_STAGE(PG8_SB(0, 1), b2 + hstep, voffB); PG8_STAGE(PG8_SA(0, 0), a2, voffA);
            PG8_WAIT_V(8); PG8_WAIT_L(0); PG8_BAR; PG8_MMA(1, 0, At, B0); PG8_MMA(1, 1, At, B1); PG8_BAR; PG8_SCHED;
            PG8_LDB(B0, 1, 0); PG8_LDB(B1, 1, 1); PG8_SCHED; PG8_LDA(At, 1, 0); PG8_STAGE(PG8_SA(0, 1), a2 + hstep, voffA);
            PG8_WAIT_V(8); PG8_WAIT_L(0); PG8_BAR; PG8_MMA(0, 0, At, B0); PG8_MMA(0, 1, At, B1); PG8_BAR; PG8_SCHED;
            PG8_LDA(At, 1, 1); PG8_STAGE(PG8_SB(1, 0), b3, voffB); PG8_STAGE(PG8_SB(1, 1), b3 + hstep, voffB); PG8_STAGE(PG8_SA(1, 0), a3, voffA);
            PG8_WAIT_V(8); PG8_WAIT_L(0); PG8_BAR; PG8_MMA(1, 0, At, B0); PG8_MMA(1, 1, At, B1); PG8_BAR; PG8_SCHED;
            } else {
            PG8_LDB(B0, 0, 0); PG8_SCHED; PG8_LDA(At, 0, 0); PG8_STAGE(PG8_SA(1, 1), a1 + hstep, voffA);
            PG8_WAIT_L(8); PG8_BAR; PG8_WAIT_L(0); PG8_MMA(0, 0, At, B0); PG8_BAR; PG8_SCHED;
            PG8_LDB(B1, 0, 1); PG8_STAGE(PG8_SB(0, 0), b2, voffB);
            PG8_BAR; PG8_WAIT_L(0); PG8_MMA(0, 1, At, B1); PG8_BAR;
            PG8_LDA(At, 0, 1); PG8_STAGE(PG8_SA(0, 0), a2, voffA);
            PG8_BAR; PG8_WAIT_L(0); PG8_MMA(1, 0, At, B0); PG8_BAR; PG8_SCHED;
            PG8_STAGE(PG8_SB(0, 1), b2 + hstep, voffB);
            PG8_WAIT_V(6); PG8_BAR; PG8_MMA(1, 1, At, B1); PG8_BAR;
            PG8_LDB(B0, 1, 0); PG8_SCHED; PG8_LDA(At, 1, 0); PG8_STAGE(PG8_SA(0, 1), a2 + hstep, voffA);
            PG8_WAIT_L(8); PG8_BAR; PG8_WAIT_L(0); PG8_MMA(0, 0, At, B0); PG8_BAR; PG8_SCHED;
            PG8_LDB(B1, 1, 1); PG8_STAGE(PG8_SB(1, 0), b3, voffB);
            PG8_BAR; PG8_WAIT_L(0); PG8_MMA(0, 1, At, B1); PG8_BAR;
            PG8_LDA(At, 1, 1); PG8_STAGE(PG8_SA(1, 0), a3, voffA);
            PG8_BAR; PG8_WAIT_L(0); PG8_MMA(1, 0, At, B0); PG8_BAR; PG8_SCHED;
            PG8_STAGE(PG8_SB(1, 1), b3 + hstep, voffB);
            PG8_WAIT_V(6); PG8_BAR; PG8_MMA(1, 1, At, B1); PG8_BAR;
            }
        }
        if constexpr (ALIGN_EPI) { if (wr == 0) PG8_BAR; }
        if constexpr (!Epi::AFTER_DRAIN) { E(acc, cur, wr, wc, fr, fq); S.done(cur); }
        if (!has_next) break;
#pragma unroll
        for (int a = 0; a < 2; ++a)
#pragma unroll
            for (int b = 0; b < 2; ++b)
#pragma unroll
                for (int m = 0; m < 4; ++m)
#pragma unroll
                    for (int n = 0; n < 2; ++n) acc[a][b][m][n] = (f32x4){0.f, 0.f, 0.f, 0.f};
        cur = nxt; cA = nA; cB = nB; ++ui;
        if constexpr (ALIGN_EPI) { if (wr == 1) PG8_BAR; }
    }
    PG8_WAIT_V(0);
    if constexpr (!ALIGN_EPI) { if (wr == 0) PG8_BAR; }
    PG8_BAR;
    if constexpr (Epi::AFTER_DRAIN) { E.fused(acc, cur, wr, wc, fr, fq, lds, wid, lane); S.done(cur); }
#undef PG8_SA
#undef PG8_SB
#undef PG8_STAGE
#undef PG8_LDA
#undef PG8_LDB
#undef PG8_MMA
#undef PG8_WAIT_V
#undef PG8_WAIT_L
#undef PG8_BAR
#undef PG8_SCHED
}
}

constexpr int SEQ = 16384, DM = 4096, DEPTH = 4, NMEM = 256, BRW = 3072, MEMW = 1024, NHEAD = 4, HDIM = 256;
constexpr int NIN_CONV = 14336, NIN_GMLP = 11264, NKV = 2048;
constexpr float RMS_EPS = 1e-6f, LNORM_EPS = 1e-5f;
constexpr int NWAVES = 8;
#ifndef MK_ONE_LAUNCH
#define MK_ONE_LAUNCH 1
#endif
constexpr int NPHASE = 2 + 4 * DEPTH;
#ifndef REP_P0
#define REP_P0 1
#endif
#ifndef REP_P1
#define REP_P1 1
#endif
#ifndef REP_P2
#define REP_P2 1
#endif
#ifndef REP_P3
#define REP_P3 1
#endif
#ifndef REP_P2G
#define REP_P2G 1
#endif
#ifndef REP_ATT
#define REP_ATT 1
#endif
#ifndef REP_P1G
#define REP_P1G 1
#endif
#ifndef BURN_P0
#define BURN_P0 0
#endif
#ifndef TLB_WARM
#define TLB_WARM 0
#endif
#ifndef REP_ALL
#define REP_ALL 1
#endif
#ifndef REP_P4
#define REP_P4 1
#endif
#ifndef REP_KV
#define REP_KV 1
#endif
#ifndef REP_BAR
#define REP_BAR 1
#endif
#ifndef GP_ALIGN
#define GP_ALIGN true
#endif
#ifndef GP_SP2
#define GP_SP2 true
#endif
#ifndef FAKE_P3
#define FAKE_P3 0
#endif
#ifndef REP_SYNC
#define REP_SYNC 0
#endif
#ifndef GRID_PER_LAYER
#define GRID_PER_LAYER 1
#endif

constexpr size_t MiB = 1u << 20;
constexpr size_t WS_CTL = 0, CTL_ZERO_BYTES = 1 * MiB;
constexpr size_t WS_WIN = 2 * MiB;
constexpr size_t WIN_OFF0 = 0, WIN_OFF1 = 112 * MiB, WIN_OFF2 = 200 * MiB, WIN_OFF3 = 312 * MiB;
constexpr size_t WS_WOUT = WS_WIN + 400 * MiB;
constexpr size_t WS_WKV = WS_WOUT + 128 * MiB;
constexpr size_t WS_MEMB = WS_WKV + 64 * MiB;
constexpr size_t WS_KV = WS_MEMB + 2 * MiB;
constexpr size_t WS_XB = WS_KV + 4 * MiB;
constexpr size_t WS_A1 = WS_XB + 128 * MiB;
constexpr size_t WS_A2 = WS_A1 + 96 * MiB;
constexpr size_t WS_Q = WS_A2 + 96 * MiB;
constexpr size_t WS_SZ = WS_Q + 32 * MiB;
constexpr size_t WS_Y = WS_SZ + 32 * MiB;
constexpr size_t WS_YO = WS_Y + 128 * MiB;
constexpr size_t WS_RSTD = WS_YO + 128 * MiB;
constexpr size_t WS_RSTDM = WS_RSTD + 1 * MiB;
constexpr size_t WS_VST = WS_RSTDM + 1 * MiB;
constexpr size_t WS_YSS = WS_VST + 6 * MiB;
constexpr size_t WS_HN = WS_YSS + 4 * MiB;
constexpr size_t WS_CHT = WS_HN + 128 * MiB;
constexpr size_t WS_GZH = WS_CHT + 12 * MiB;
constexpr size_t WS_END = WS_GZH + 12 * MiB;
static_assert(WS_A2 - WS_A1 == 2 * pg8::EpiProj::OFF_A2 && WS_Q - WS_A1 == 2 * pg8::EpiProj::OFF_Q && WS_SZ - WS_A1 == 2 * pg8::EpiProj::OFF_SZ, "EpiProj output offsets");
constexpr int CW_BAR = 4096;

constexpr int RING_BYTES = 131072;
constexpr int LDS_BYTES = 147456;
constexpr int MISC_OFF = LDS_BYTES - 128;

#define GAS __attribute__((address_space(1)))
#define LAS __attribute__((address_space(3)))
typedef unsigned short bf16;
typedef unsigned v4u __attribute__((ext_vector_type(4)));
typedef unsigned v2u __attribute__((ext_vector_type(2)));
typedef float f32x4 __attribute__((ext_vector_type(4)));
typedef short bf16x8 __attribute__((ext_vector_type(8)));
#define LDS_WAIT() asm volatile("s_waitcnt lgkmcnt(0)" ::: "memory")
__device__ __forceinline__ unsigned f2bf(float f) { unsigned u = __builtin_bit_cast(unsigned, f); return (u + 0x7fffu + ((u >> 16) & 1u)) >> 16; }
__device__ __forceinline__ unsigned pk2(float lo, float hi) { return pg8::cvt_pk_bf16(lo, hi); }
__device__ __forceinline__ float bflo(unsigned w) { return __builtin_bit_cast(float, w << 16); }
__device__ __forceinline__ float bfhi(unsigned w) { return __builtin_bit_cast(float, w & 0xffff0000u); }
__device__ __forceinline__ float wave_sum(float v) {
#pragma unroll
    for (int o = 1; o < 64; o <<= 1) v += __shfl_xor(v, o);
    return v;
}

#define XB_TMO      128
#define XB_XCNT(j)  (256  + 64 * (j))
#define XB_XSUB(j)  (1280 + 64 * (j))
#define XB_XGEN(j)  (2304 + 64 * (j))
#define XB_TOP      3328
#define XB_TOPGEN   3392
#define XCD_BAR_WORDS 3456
#define XB_SPIN_CAP (1u << 18)

__device__ __forceinline__ unsigned xb_ld(unsigned* p)              { return __hip_atomic_load(p, __ATOMIC_RELAXED, __HIP_MEMORY_SCOPE_AGENT); }
__device__ __forceinline__ unsigned xb_add(unsigned* p, unsigned v) { return __hip_atomic_fetch_add(p, v, __ATOMIC_RELAXED, __HIP_MEMORY_SCOPE_AGENT); }
__device__ __forceinline__ unsigned xb_xcc_id() { return (unsigned)__builtin_amdgcn_s_getreg((3 << 11) | 20) & 0xFu; }
#define XB_SPIN(cond, bar) do { unsigned _sp = 0; while (cond) { __builtin_amdgcn_s_sleep(1); \
    if ((++_sp & 255u) == 0u) { if (xb_ld(&(bar)[XB_TMO])) break; if (_sp > XB_SPIN_CAP) { atomicAdd(&(bar)[XB_TMO], 1u); break; } } } } while (0)

struct XcdBarrier {
    unsigned* bar; unsigned x;
    volatile LAS unsigned* st;
};
__device__ __forceinline__ XcdBarrier xcd_barrier_post(unsigned* bar, volatile LAS unsigned* st) {
    XcdBarrier b; b.bar = bar; b.x = xb_xcc_id(); b.st = st;
    if (threadIdx.x == 0) (void)xb_add(&bar[XB_XCNT(b.x)], 1u);
    return b;
}
__device__ __forceinline__ void xcd_barrier_complete(unsigned* bar, unsigned x, unsigned& nloc, unsigned& nx) {
    const unsigned G = gridDim.x * gridDim.y * gridDim.z;
    unsigned sum, cnt, mine, sp = 0u;
    for (;;) {
        sum = 0u; cnt = 0u; mine = 0u;
#pragma unroll
        for (unsigned j = 0; j < 16; ++j) { const unsigned c = xb_ld(&bar[XB_XCNT(j)]); sum += c; cnt += (c > 0u) ? 1u : 0u; mine = (j == x) ? c : mine; }
        if (sum == G) break;
        __builtin_amdgcn_s_sleep(1);
        if ((++sp & 255u) == 0u) { if (xb_ld(&bar[XB_TMO])) break; if (sp > XB_SPIN_CAP) { atomicAdd(&bar[XB_TMO], 1u); break; } }
    }
    nloc = mine > 0u ? mine : 1u; nx = cnt > 0u ? cnt : 1u;
}
__device__ __forceinline__ void xcd_barrier(const XcdBarrier& b) {
    asm volatile("s_waitcnt vmcnt(0)" ::: "memory");
    __syncthreads();
    if (threadIdx.x == 0) {
        unsigned* bar = b.bar;
        __builtin_amdgcn_s_waitcnt(0);
        unsigned nloc = b.st[0], nx = b.st[1];
        if (nloc == 0u) { xcd_barrier_complete(bar, b.x, nloc, nx); b.st[0] = nloc; b.st[1] = nx; }
        const unsigned old = xb_add(&bar[XB_XSUB(b.x)], 1u);
        const unsigned gen = old / nloc;
        if (old + 1u == (gen + 1u) * nloc) {
            __builtin_amdgcn_fence(__ATOMIC_RELEASE, "agent");
            asm volatile("s_waitcnt vmcnt(0)" ::: "memory");
            const unsigned og = xb_add(&bar[XB_TOP], 1u);
            const unsigned tg = og / nx;
            if (og + 1u == (tg + 1u) * nx) xb_add(&bar[XB_TOPGEN], 1u);
            else XB_SPIN(xb_ld(&bar[XB_TOPGEN]) == tg, bar);
            __builtin_amdgcn_fence(__ATOMIC_ACQUIRE, "agent");
            xb_add(&bar[XB_XGEN(b.x)], 1u);
            asm volatile("s_waitcnt vmcnt(0)" ::: "memory");
        } else {
            XB_SPIN(xb_ld(&bar[XB_XGEN(b.x)]) == gen, bar);
            __builtin_amdgcn_fence(__ATOMIC_ACQUIRE, "agent");
            asm volatile("s_waitcnt vmcnt(0)" ::: "memory");
        }
    }
    __syncthreads();
}

__device__ __forceinline__ void src_conv(int gi, int& sa, int& sb, bool& perm) { const int pn = gi >> 3, bj = (gi >> 2) & 1, wc = gi & 3;
    if (pn < 48) { sa = (bj ? 6144 : 0) + 64 * pn + 16 * wc; sb = (bj ? 10240 : 3072) + 64 * pn + 16 * wc; perm = false; return; }
    const int s32 = (pn < 52) ? 9216 + 256 * (pn - 48) + 128 * bj + 32 * wc : 13312 + 256 * (pn - 52) + 128 * bj + 32 * wc;
    sa = s32; sb = s32 + 16; perm = true; }
__device__ __forceinline__ int src32_gmlp(int gi) { const int pn = gi >> 3, bj = (gi >> 2) & 1, wc = gi & 3;
    if (pn < 24) return (bj ? 7168 : 0) + 128 * pn + 32 * wc;
    if (pn < 36) return 3072 + 256 * (pn - 24) + 128 * bj + 32 * wc;
    if (pn < 40) return 6144 + 256 * (pn - 36) + 128 * bj + 32 * wc;
    return 10240 + 256 * (pn - 40) + 128 * bj + 32 * wc; }
__device__ __forceinline__ void cvt_item(const float* W, int N, int sa, int sb, bool perm, const float* gk, bf16* WT, int slot0, int k0, LAS float* scr, int lane) {
    const int l31 = lane & 31, scol = (l31 < 16) ? sa + l31 : sb + l31 - 16;
#pragma unroll 8
    for (int i = 0; i < 32; ++i) { const int kk = 2 * i + (lane >> 5); scr[kk * 33 + l31] = W[(size_t)(k0 + kk) * N + scol]; }
    const int c = lane & 7;
    f32x4 g0 = (f32x4){1.f, 1.f, 1.f, 1.f}, g1 = g0;
    if (gk) { g0 = *(const f32x4*)(gk + k0 + 8 * c); g1 = *(const f32x4*)(gk + k0 + 8 * c + 4); }
    LDS_WAIT(); asm volatile("" ::: "memory");
#pragma unroll
    for (int j = 0; j < 4; ++j) { const int n = (lane >> 3) + 8 * j; const LAS float* s = scr + (8 * c) * 33 + (perm ? pg8::perm32(n) : n);
        v4u o; o.x = pk2(s[0 * 33] * g0[0], s[1 * 33] * g0[1]); o.y = pk2(s[2 * 33] * g0[2], s[3 * 33] * g0[3]); o.z = pk2(s[4 * 33] * g1[0], s[5 * 33] * g1[1]); o.w = pk2(s[6 * 33] * g1[2], s[7 * 33] * g1[3]);
        *(v4u*)(WT + (size_t)(slot0 + n) * DM + k0 + 8 * c) = o; }
    LDS_WAIT(); asm volatile("" ::: "memory");
}
__device__ __forceinline__ void row_to_bf16(const float* xr, float* rms_out  , bf16* nrow, int lane) {
    f32x4 v[16]; float ss = 0.f;
#pragma unroll
    for (int i = 0; i < 8; ++i) { const int col = 512 * i + 8 * lane; const f32x4 a = *(const f32x4*)(xr + col), b = *(const f32x4*)(xr + col + 4); v[2 * i] = a; v[2 * i + 1] = b;
        ss += (a[0] * a[0] + a[1] * a[1]) + (a[2] * a[2] + a[3] * a[3]) + (b[0] * b[0] + b[1] * b[1]) + (b[2] * b[2] + b[3] * b[3]); }
    ss = wave_sum(ss);
    const float rms = sqrtf(ss * (1.0f / DM) + RMS_EPS), rs = 1.0f / rms;
    if (rms_out && lane == 0) *rms_out = rms;
#pragma unroll
    for (int i = 0; i < 8; ++i) { const int col = 512 * i + 8 * lane; const f32x4 a = v[2 * i], b = v[2 * i + 1];
        v4u n; n.x = pk2(a[0] * rs, a[1] * rs); n.y = pk2(a[2] * rs, a[3] * rs); n.z = pk2(b[0] * rs, b[1] * rs); n.w = pk2(b[2] * rs, b[3] * rs); *(v4u*)(nrow + col) = n; }
}

struct Args { const float* in[14]; float* out; unsigned char* ws; int ph_lo, ph_hi; };

constexpr int I_KV = 64 * (NKV / 32), I_OUT = 64 * (DM / 32), I_CONV = 64 * (NIN_CONV / 32), I_GMLP = 64 * (NIN_GMLP / 32);
constexpr int NITEMS = 4 * I_KV + 4 * I_OUT + 2 * I_CONV + 2 * I_GMLP;
__device__ __forceinline__ void p0_item(const Args& a, unsigned char* ws, LAS float* scr, int it, int lane) {
    const float* pre_g = a.in[2]; const float* mem_g = a.in[4]; const float* w_kv = a.in[5]; const float* w_out = a.in[6]; const float* conv_w_in = a.in[7]; const float* gmlp_w_in = a.in[9];
    int r = it; const float* W; const float* gk; bf16* WT; int N, ng, type;
    if (r < 4 * I_KV) { const int l = r / I_KV; r -= l * I_KV; W = w_kv + (size_t)l * DM * NKV; N = NKV; ng = NKV / 32; type = 2; gk = mem_g + l * DM; WT = (bf16*)(ws + WS_WKV) + (size_t)l * NKV * DM; }
    else { r -= 4 * I_KV;
        if (r < 4 * I_OUT) { const int l = r / I_OUT; r -= l * I_OUT; W = w_out + (size_t)l * DM * DM; N = DM; ng = DM / 32; type = 2; gk = nullptr; WT = (bf16*)(ws + WS_WOUT) + (size_t)l * DM * DM; }
        else { r -= 4 * I_OUT;
            if (r < 2 * I_CONV) { const int j = r / I_CONV; r -= j * I_CONV; W = conv_w_in + (size_t)j * DM * NIN_CONV; N = NIN_CONV; ng = NIN_CONV / 32; type = 0; gk = pre_g + (2 * j) * DM; WT = (bf16*)(ws + WS_WIN + (j ? WIN_OFF2 : WIN_OFF0)); }
            else { r -= 2 * I_CONV; const int j = r / I_GMLP; r -= j * I_GMLP; W = gmlp_w_in + (size_t)j * DM * NIN_GMLP; N = NIN_GMLP; ng = NIN_GMLP / 32; type = 1; gk = pre_g + (2 * j + 1) * DM; WT = (bf16*)(ws + WS_WIN + (j ? WIN_OFF3 : WIN_OFF1)); } } }
    const int kb = r / ng, gi = r - kb * ng;
    int sa, sb; bool perm = true;
    if (type == 0) src_conv(gi, sa, sb, perm); else { sa = (type == 1) ? src32_gmlp(gi) : 32 * gi; sb = sa + 16; }
    cvt_item(W, N, sa, sb, perm, gk, WT, 32 * gi, 64 * kb, scr, lane);
}
__device__ __forceinline__ void p0a_convert(const Args& a, unsigned char* ws, LAS unsigned char* lds, int gw, int NGW, int wave, int lane) {
    LAS float* scr = (LAS float*)(lds + wave * 16384);
    for (int it = gw; it < 4 * I_KV; it += NGW) p0_item(a, ws, scr, it, lane);
    for (int m = gw; m < NMEM; m += NGW) row_to_bf16(a.in[1] + (size_t)m * DM, nullptr, (bf16*)(ws + WS_MEMB) + (size_t)m * DM, lane);
}
constexpr int CW_Q0 = 96;
__device__ __forceinline__ void p0b_convert(const Args& a, unsigned char* ws, LAS unsigned char* lds, int gw, int NGW, int wave, int lane) {
    LAS float* scr = (LAS float*)(lds + wave * 16384);
    unsigned* q = (unsigned*)(ws + WS_CTL) + CW_Q0;
    for (;;) { unsigned b = 0u; if (lane == 0) b = __hip_atomic_fetch_add(q, 16u, __ATOMIC_RELAXED, __HIP_MEMORY_SCOPE_AGENT);
        const int base = 4 * I_KV + (int)__builtin_amdgcn_readfirstlane(b); if (base >= NITEMS) break;
        for (int i = 0; i < 16; ++i) if (base + i < NITEMS) { p0_item(a, ws, scr, base + i, lane);
            if (BURN_P0) { f32x4 d = (f32x4){0.f, 0.f, 0.f, 0.f}; v4u pa; pa.x = 0x3f803f80u + lane * 0x00030005u; pa.y = pa.x * 7u; pa.z = pa.x ^ 0x01230123u; pa.w = pa.x + 0x00110011u; const bf16x8 fa = __builtin_bit_cast(bf16x8, pa);
#pragma unroll 8
                for (int q = 0; q < BURN_P0; ++q) d = __builtin_amdgcn_mfma_f32_16x16x32_bf16(fa, fa, d, 0, 0, 0);
                asm volatile("" :: "v"(d)); } } }
    for (int m = gw; m < SEQ; m += NGW) row_to_bf16(a.in[0] + (size_t)m * DM, (float*)(ws + WS_RSTD) + m, (bf16*)(ws + WS_HN) + (size_t)m * DM, lane);
}

constexpr int AT_LD = 264;
static_assert(256 * AT_LD * 2 <= MISC_OFF, "attention LDS map");
__device__ __forceinline__ void attn_stage(const bf16* src, size_t row_pitch, LAS unsigned char* lds, int tid_in) {
    int tid = tid_in; asm volatile("" : "+v"(tid));
    const bf16* g = src + (size_t)(tid >> 5) * row_pitch + 8 * (tid & 31);
    LAS unsigned char* l = lds + (tid >> 5) * (AT_LD * 2) + 16 * (tid & 31);
    v4u r[16];
#pragma unroll
    for (int it = 0; it < 16; ++it) r[it] = *(const v4u*)(g + (size_t)(16 * it) * row_pitch);
#pragma unroll
    for (int it = 0; it < 16; ++it) *(LAS v4u*)(l + it * (16 * AT_LD * 2)) = r[it];
}
__device__ __forceinline__ void attn_wg(const bf16* Q, const bf16* SZ, const bf16* Kl, const bf16* VTl, bf16* Y, int pb, int h, LAS unsigned char* lds, int tid) {
    const int lane = tid & 63, wave = __builtin_amdgcn_readfirstlane(tid >> 6), fr = lane & 15, fq = lane >> 4;
    const int t0 = 256 * pb + 32 * wave;
    attn_stage(Kl + HDIM * h, MEMW, lds, tid);
    const bf16* qp0 = Q + (size_t)(t0 + fr) * MEMW + HDIM * h + 8 * fq; const bf16* qp1 = qp0 + (size_t)16 * MEMW;
    bf16x8 qa = *(const bf16x8*)qp0, qb = *(const bf16x8*)qp1, qa1 = *(const bf16x8*)(qp0 + 32), qb1 = *(const bf16x8*)(qp1 + 32), qa2 = *(const bf16x8*)(qp0 + 64), qb2 = *(const bf16x8*)(qp1 + 64);
    __syncthreads();
    const LAS bf16* lrow = (const LAS bf16*)lds + (8 * (fr >> 2) + (fr & 3)) * AT_LD + 8 * fq;
    f32x4 s[2][16];
#pragma unroll
    for (int i = 0; i < 16; ++i) { s[0][i] = (f32x4){0.f, 0.f, 0.f, 0.f}; s[1][i] = s[0][i]; }
#pragma unroll 1
    for (int ks = 0; ks < 8; ++ks) {
        const int kn = (ks < 5) ? ks + 3 : 7; const bf16x8 qan = *(const bf16x8*)(qp0 + 32 * kn), qbn = *(const bf16x8*)(qp1 + 32 * kn);
#pragma unroll
        for (int g = 0; g < 8; ++g)
#pragma unroll
            for (int e = 0; e < 2; ++e) { const bf16x8 kf = *(const LAS bf16x8*)(lrow + (32 * g + 4 * e) * AT_LD + 32 * ks);
                s[0][2 * g + e] = __builtin_amdgcn_mfma_f32_16x16x32_bf16(kf, qa, s[0][2 * g + e], 0, 0, 0); s[1][2 * g + e] = __builtin_amdgcn_mfma_f32_16x16x32_bf16(kf, qb, s[1][2 * g + e], 0, 0, 0); }
        qa = qa1; qb = qb1; qa1 = qa2; qb1 = qb2; qa2 = qan; qb2 = qbn; }
    float inv[2]; bf16x8 pf[2][8];
#pragma unroll
    for (int tg = 0; tg < 2; ++tg) { float mx = s[tg][0][0];
#pragma unroll
        for (int i = 0; i < 16; ++i)
#pragma unroll
            for (int j = 0; j < 4; ++j) mx = fmaxf(mx, s[tg][i][j]);
        mx = fmaxf(mx, __shfl_xor(mx, 16)); mx = fmaxf(mx, __shfl_xor(mx, 32));
        float sum = 0.f; const float mxl = mx * 1.44269504f;
#pragma unroll
        for (int i = 0; i < 16; ++i)
#pragma unroll
            for (int j = 0; j < 4; ++j) { const float p = __builtin_amdgcn_exp2f(s[tg][i][j] * 1.44269504f - mxl); s[tg][i][j] = p; sum += p; }
        sum += __shfl_xor(sum, 16); sum += __shfl_xor(sum, 32); inv[tg] = 1.0f / sum;
#pragma unroll
        for (int g = 0; g < 8; ++g) { v4u w; w.x = pk2(s[tg][2 * g][0], s[tg][2 * g][1]); w.y = pk2(s[tg][2 * g][2], s[tg][2 * g][3]); w.z = pk2(s[tg][2 * g + 1][0], s[tg][2 * g + 1][1]); w.w = pk2(s[tg][2 * g + 1][2], s[tg][2 * g + 1][3]);
            pf[tg][g] = __builtin_bit_cast(bf16x8, w); } }
    __syncthreads();
    attn_stage(VTl + (size_t)HDIM * h * NMEM, NMEM, lds, tid);
    __syncthreads();
    const bf16* szp0 = SZ + (size_t)(t0 + fr) * MEMW + HDIM * h + 8 * fq; const bf16* szp1 = szp0 + (size_t)16 * MEMW;
    v4u z0 = *(const v4u*)szp0, z1 = *(const v4u*)szp1;
#pragma unroll 1
    for (int db2 = 0; db2 < 8; ++db2) { f32x4 o[2][2];
        const int dn = (db2 < 7) ? db2 + 1 : 7; const v4u z0n = *(const v4u*)(szp0 + 32 * dn), z1n = *(const v4u*)(szp1 + 32 * dn);
#pragma unroll
        for (int tg = 0; tg < 2; ++tg) { o[tg][0] = (f32x4){0.f, 0.f, 0.f, 0.f}; o[tg][1] = o[tg][0]; }
#pragma unroll
        for (int ks2 = 0; ks2 < 8; ++ks2)
#pragma unroll
            for (int e = 0; e < 2; ++e) { const bf16x8 vf = *(const LAS bf16x8*)(lrow + (32 * db2 + 4 * e) * AT_LD + 32 * ks2);
                o[0][e] = __builtin_amdgcn_mfma_f32_16x16x32_bf16(vf, pf[0][ks2], o[0][e], 0, 0, 0); o[1][e] = __builtin_amdgcn_mfma_f32_16x16x32_bf16(vf, pf[1][ks2], o[1][e], 0, 0, 0); }
#pragma unroll
        for (int tg = 0; tg < 2; ++tg) { const size_t t = (size_t)(t0 + 16 * tg + fr); const int col = HDIM * h + 32 * db2 + 8 * fq; const float iv = inv[tg];
            const v4u z = tg ? z1 : z0;
            v4u w; w.x = pk2(o[tg][0][0] * iv * bflo(z.x), o[tg][0][1] * iv * bfhi(z.x)); w.y = pk2(o[tg][0][2] * iv * bflo(z.y), o[tg][0][3] * iv * bfhi(z.y));
            w.z = pk2(o[tg][1][0] * iv * bflo(z.z), o[tg][1][1] * iv * bfhi(z.z)); w.w = pk2(o[tg][1][2] * iv * bflo(z.w), o[tg][1][3] * iv * bfhi(z.w));
            *(v4u*)(Y + t * DM + BRW + col) = w; }
        z0 = z0n; z1 = z1n; }
    __syncthreads();
}

constexpr int CONV_ROWS = 16;
__device__ __forceinline__ void conv_rows(const bf16* GZ, const bf16* CH, const float* cw  , bf16* Y, int t0, int cs, int lane) {
    const int c = 512 * cs + 8 * lane;
    const int th = (t0 >= 2) ? t0 - 2 : 0; const float hz = (t0 >= 2) ? 1.f : 0.f;
    v4u uc[CONV_ROWS + 2], ug[CONV_ROWS];
    uc[0] = *(const v4u*)(CH + (size_t)th * BRW + c); uc[1] = *(const v4u*)(CH + (size_t)(th + 1) * BRW + c);
#pragma unroll
    for (int r = 0; r < CONV_ROWS; ++r) { uc[r + 2] = *(const v4u*)(CH + (size_t)(t0 + r) * BRW + c); ug[r] = *(const v4u*)(GZ + (size_t)(t0 + r) * BRW + c); }
    float w0[8], w1[8], w2[8], p2[8], p1[8];
    { const f32x4 a = *(const f32x4*)(cw + c), b = *(const f32x4*)(cw + c + 4), d = *(const f32x4*)(cw + BRW + c), e = *(const f32x4*)(cw + BRW + c + 4), f = *(const f32x4*)(cw + 2 * BRW + c), g = *(const f32x4*)(cw + 2 * BRW + c + 4);
#pragma unroll
      for (int i = 0; i < 4; ++i) { w0[i] = a[i]; w0[4 + i] = b[i]; w1[i] = d[i]; w1[4 + i] = e[i]; w2[i] = f[i]; w2[4 + i] = g[i]; } }
    p2[0] = bflo(uc[0].x) * hz; p2[1] = bfhi(uc[0].x) * hz; p2[2] = bflo(uc[0].y) * hz; p2[3] = bfhi(uc[0].y) * hz; p2[4] = bflo(uc[0].z) * hz; p2[5] = bfhi(uc[0].z) * hz; p2[6] = bflo(uc[0].w) * hz; p2[7] = bfhi(uc[0].w) * hz;
    p1[0] = bflo(uc[1].x) * hz; p1[1] = bfhi(uc[1].x) * hz; p1[2] = bflo(uc[1].y) * hz; p1[3] = bfhi(uc[1].y) * hz; p1[4] = bflo(uc[1].z) * hz; p1[5] = bfhi(uc[1].z) * hz; p1[6] = bflo(uc[1].w) * hz; p1[7] = bfhi(uc[1].w) * hz;
#pragma unroll
    for (int r = 0; r < CONV_ROWS; ++r) { const v4u u = uc[r + 2], q = ug[r];
        float cu[8], gz[8], o[8];
        cu[0] = bflo(u.x); cu[1] = bfhi(u.x); cu[2] = bflo(u.y); cu[3] = bfhi(u.y); cu[4] = bflo(u.z); cu[5] = bfhi(u.z); cu[6] = bflo(u.w); cu[7] = bfhi(u.w);
        gz[0] = bflo(q.x); gz[1] = bfhi(q.x); gz[2] = bflo(q.y); gz[3] = bfhi(q.y); gz[4] = bflo(q.z); gz[5] = bfhi(q.z); gz[6] = bflo(q.w); gz[7] = bfhi(q.w);
#pragma unroll
        for (int i = 0; i < 8; ++i) { o[i] = gz[i] * (w0[i] * p2[i] + w1[i] * p1[i] + w2[i] * cu[i]); p2[i] = p1[i]; p1[i] = cu[i]; }
        v4u w; w.x = pk2(o[0], o[1]); w.y = pk2(o[2], o[3]); w.z = pk2(o[4], o[5]); w.w = pk2(o[6], o[7]);
        *(v4u*)(Y + (size_t)(t0 + r) * DM + c) = w; }
}

constexpr int SP_LD = 136;
constexpr int SP_WL = 0, SP_VTL = 128 * SP_LD * 2, SP_MU = SP_VTL + 384 * SP_LD * 2, SP_RS = SP_MU + 512, SP_END = SP_RS + 512;
static_assert(SP_END <= MISC_OFF, "spatial LDS map");
__device__ __forceinline__ void spatial_member(const bf16* VG, const bf16* UZ, const float* vst, const float* Wl  , const float* bsl  , const float* lng, const float* lnb, bf16* Y, int nb, int g0, LAS unsigned char* lds, int tid) {
    LAS bf16* WL = (LAS bf16*)(lds + SP_WL); LAS bf16* VTL = (LAS bf16*)(lds + SP_VTL); LAS float* MU = (LAS float*)(lds + SP_MU); LAS float* RS = (LAS float*)(lds + SP_RS);
    const int lane = tid & 63, wave = __builtin_amdgcn_readfirstlane(tid >> 6), fr = lane & 15, fq = lane >> 4;
    const int sv = (lane & 31) + 32 * (wave & 3), cv0 = 8 * ((lane >> 5) + 2 * (wave >> 2));
    const bf16* vrow = VG + (size_t)(128 * nb + sv) * BRW + cv0;
    v4u vr[12];
#pragma unroll
    for (int it = 0; it < 12; ++it) vr[it] = *(const v4u*)(vrow + 384 * g0 + 32 * it);
    { const int row = tid >> 2, part = tid & 3; const float* q = vst + (size_t)(128 * nb + row) * 96 + 24 * part; float s1 = 0.f, s2 = 0.f;
        f32x4 pq[6];
#pragma unroll
        for (int k = 0; k < 6; ++k) pq[k] = *(const f32x4*)(q + 4 * k);
#pragma unroll
        for (int k = 0; k < 6; ++k) { s1 += pq[k][0] + pq[k][2]; s2 += pq[k][1] + pq[k][3]; }
        s1 += __shfl_xor(s1, 1); s1 += __shfl_xor(s1, 2); s2 += __shfl_xor(s2, 1); s2 += __shfl_xor(s2, 2);
        if (part == 0) { const float mu = s1 * (1.0f / BRW), var = s2 * (1.0f / BRW) - mu * mu; MU[row] = mu; RS[row] = 1.0f / sqrtf(var + LNORM_EPS); } }
    __syncthreads();
    const float mu = MU[sv], rs = RS[sv];
    const int th = wave >> 2, d0w = 96 * (wave & 3);
#pragma unroll
    for (int iu = 0; iu < 4; ++iu) { const int g = g0 + iu; const float* Wg = Wl + (size_t)g * 128 * 128; const float* bsg = bsl + g * 128;
        f32x4 wa[4], wb[4]; const int tw = tid >> 2, s0 = (tid & 3) * 32;
#pragma unroll
        for (int q = 0; q < 4; ++q) { wa[q] = *(const f32x4*)(Wg + tw * 128 + s0 + 8 * q); wb[q] = *(const f32x4*)(Wg + tw * 128 + s0 + 8 * q + 4); }
#pragma unroll
        for (int it = 0; it < 12; ++it) { const int c = cv0 + 32 * it; const v4u u = vr[it];
            const f32x4 ga = *(const f32x4*)(lng + 384 * g + c), gb = *(const f32x4*)(lng + 384 * g + c + 4), ba = *(const f32x4*)(lnb + 384 * g + c), bb = *(const f32x4*)(lnb + 384 * g + c + 4);
            float v[8] = {bflo(u.x), bfhi(u.x), bflo(u.y), bfhi(u.y), bflo(u.z), bfhi(u.z), bflo(u.w), bfhi(u.w)};
#pragma unroll
            for (int e = 0; e < 8; ++e) { const float gg = e < 4 ? ga[e & 3] : gb[e & 3], bq = e < 4 ? ba[e & 3] : bb[e & 3]; VTL[(c + e) * SP_LD + sv] = (bf16)f2bf((v[e] - mu) * rs * gg + bq); } }
#pragma unroll
        for (int q = 0; q < 4; ++q) { const int sb = s0 + 8 * q; float v[8] = {wa[q][0], wa[q][1], wa[q][2], wa[q][3], wb[q][0], wb[q][1], wb[q][2], wb[q][3]};
#pragma unroll
            for (int e = 0; e < 8; ++e) v[e] = (sb + e <= tw) ? v[e] : 0.f;
            v4u o; o.x = pk2(v[0], v[1]); o.y = pk2(v[2], v[3]); o.z = pk2(v[4], v[5]); o.w = pk2(v[6], v[7]);
            *(LAS v4u*)(WL + tw * SP_LD + sb) = o; }
        if (iu < 3) {
#pragma unroll
            for (int it = 0; it < 12; ++it) vr[it] = *(const v4u*)(vrow + 384 * (g + 1) + 32 * it); }
        __syncthreads();
#pragma unroll
        for (int hf = 0; hf < 2; ++hf) {
            v4u uz[2][3]; f32x4 acc[2][3][2];
#pragma unroll
            for (int i2 = 0; i2 < 2; ++i2) { const int i = 2 * hf + i2; const int tb = th ? ((i == 0) ? 1 : (i == 1) ? 2 : (i == 2) ? 5 : 6) : ((i == 0) ? 0 : (i == 1) ? 3 : (i == 2) ? 4 : 7);
#pragma unroll
                for (int dp = 0; dp < 3; ++dp) { uz[i2][dp] = *(const v4u*)(UZ + (size_t)(128 * nb + 16 * tb + fr) * BRW + 384 * g + d0w + 32 * dp + 8 * fq); acc[i2][dp][0] = (f32x4){0.f, 0.f, 0.f, 0.f}; acc[i2][dp][1] = (f32x4){0.f, 0.f, 0.f, 0.f}; } }
#pragma unroll
            for (int i2 = 0; i2 < 2; ++i2) { const int i = 2 * hf + i2; const int tb = th ? ((i == 0) ? 1 : (i == 1) ? 2 : (i == 2) ? 5 : 6) : ((i == 0) ? 0 : (i == 1) ? 3 : (i == 2) ? 4 : 7); const int kmax = tb >> 1;
#pragma unroll
                for (int ks = 0; ks < 4; ++ks) if (ks <= kmax) {
                    const bf16x8 bw = *(const LAS bf16x8*)(WL + (16 * tb + fr) * SP_LD + 32 * ks + 8 * fq);
#pragma unroll
                    for (int dp = 0; dp < 3; ++dp)
#pragma unroll
                        for (int e = 0; e < 2; ++e) { const bf16x8 av = *(const LAS bf16x8*)(VTL + (d0w + 32 * dp + 8 * (fr >> 2) + 4 * e + (fr & 3)) * SP_LD + 32 * ks + 8 * fq);
                            acc[i2][dp][e] = __builtin_amdgcn_mfma_f32_16x16x32_bf16(av, bw, acc[i2][dp][e], 0, 0, 0); } } }
#pragma unroll
            for (int i2 = 0; i2 < 2; ++i2) { const int i = 2 * hf + i2; const int tb = th ? ((i == 0) ? 1 : (i == 1) ? 2 : (i == 2) ? 5 : 6) : ((i == 0) ? 0 : (i == 1) ? 3 : (i == 2) ? 4 : 7);
                const int tl = 16 * tb + fr; const float bs = bsg[tl]; const size_t row = (size_t)(128 * nb + tl);
#pragma unroll
                for (int dp = 0; dp < 3; ++dp) { const int d = 384 * g + d0w + 32 * dp + 8 * fq; const v4u u = uz[i2][dp];
                    const f32x4 f0 = acc[i2][dp][0] + bs, f1 = acc[i2][dp][1] + bs;
                    v4u w; w.x = pk2(bflo(u.x) * f0[0], bfhi(u.x) * f0[1]); w.y = pk2(bflo(u.y) * f0[2], bfhi(u.y) * f0[3]); w.z = pk2(bflo(u.z) * f1[0], bfhi(u.z) * f1[1]); w.w = pk2(bflo(u.w) * f1[2], bfhi(u.w) * f1[3]);
                    *(v4u*)(Y + row * DM + d) = w; } } }
        __syncthreads(); }
}

__device__ __forceinline__ void p4_rows(const bf16* YO, const float* yss, const float* gpost, bf16* HN, float* rmsv, bf16* HNw, float* rmsw, float* out, bool last, int m0, int nrows, int lane) {
    for (int m = m0; m < m0 + nrows; ++m) {
        const float tot = wave_sum(yss[(size_t)m * 64 + lane]); const float rsy = 1.0f / sqrtf(tot * (1.0f / DM) + RMS_EPS); const float rmo = rmsv[m];
        float ss = 0.f; float xn[8][8];
#pragma unroll
        for (int i = 0; i < 8; ++i) { const int col = 512 * i + 8 * lane;
            const v4u yo = *(const v4u*)(YO + (size_t)m * DM + col), hb = *(const v4u*)(HN + (size_t)m * DM + col); const f32x4 g0 = *(const f32x4*)(gpost + col) * rsy, g1 = *(const f32x4*)(gpost + col + 4) * rsy;
            xn[i][0] = bflo(hb.x) * rmo + bflo(yo.x) * g0[0]; xn[i][1] = bfhi(hb.x) * rmo + bfhi(yo.x) * g0[1]; xn[i][2] = bflo(hb.y) * rmo + bflo(yo.y) * g0[2]; xn[i][3] = bfhi(hb.y) * rmo + bfhi(yo.y) * g0[3];
            xn[i][4] = bflo(hb.z) * rmo + bflo(yo.z) * g1[0]; xn[i][5] = bfhi(hb.z) * rmo + bfhi(yo.z) * g1[1]; xn[i][6] = bflo(hb.w) * rmo + bflo(yo.w) * g1[2]; xn[i][7] = bfhi(hb.w) * rmo + bfhi(yo.w) * g1[3];
#pragma unroll
            for (int e = 0; e < 8; ++e) ss += xn[i][e] * xn[i][e];
            if (last) { *(f32x4*)(out + (size_t)m * DM + col) = (f32x4){xn[i][0], xn[i][1], xn[i][2], xn[i][3]}; *(f32x4*)(out + (size_t)m * DM + col + 4) = (f32x4){xn[i][4], xn[i][5], xn[i][6], xn[i][7]}; } }
        if (!last) { ss = wave_sum(ss); const float rmn = sqrtf(ss * (1.0f / DM) + RMS_EPS), rs = 1.0f / rmn;
            if (lane == 0) rmsw[m] = rmn;
#pragma unroll
            for (int i = 0; i < 8; ++i) { const int col = 512 * i + 8 * lane;
                v4u w; w.x = pk2(xn[i][0] * rs, xn[i][1] * rs); w.y = pk2(xn[i][2] * rs, xn[i][3] * rs); w.z = pk2(xn[i][4] * rs, xn[i][5] * rs); w.w = pk2(xn[i][6] * rs, xn[i][7] * rs); *(v4u*)(HNw + (size_t)m * DM + col) = w; } }
    }
}

constexpr int CW_TEAM = 8192;
constexpr int CW_TMO = 64;
__device__ __forceinline__ void team_barrier(unsigned* ctl, int tm, unsigned gen, int nbr) {
    asm volatile("s_waitcnt vmcnt(0)" ::: "memory");
    __syncthreads();
    if (threadIdx.x == 0) {
        __builtin_amdgcn_fence(__ATOMIC_RELEASE, "agent");
        asm volatile("s_waitcnt vmcnt(0)" ::: "memory");
        unsigned* mine = ctl + CW_TEAM + 64 * tm; unsigned* other = ctl + CW_TEAM + 64 * (nbr >= 0 ? nbr : tm);
        (void)xb_add(mine, 1u);
        const unsigned want = 4u * gen; unsigned sp = 0u;
        while (xb_ld(mine) < want || xb_ld(other) < want) { __builtin_amdgcn_s_sleep(1);
            if ((++sp & 255u) == 0u) { if (xb_ld(ctl + CW_TMO)) break; if (sp > XB_SPIN_CAP) { atomicAdd(ctl + CW_TMO, 1u); break; } } }
        __builtin_amdgcn_fence(__ATOMIC_ACQUIRE, "agent");
        asm volatile("s_waitcnt vmcnt(0)" ::: "memory");
    }
    __syncthreads();
}

__global__ void __launch_bounds__(NWAVES * 64, 2) mk_fwd(Args args) {
    extern __shared__ __attribute__((aligned(16))) unsigned char lds_raw[];
    LAS unsigned char* lds = (LAS unsigned char*)lds_raw;
    const int G = gridDim.x, NGW = G * NWAVES;
    unsigned char* ws = args.ws;
    const int lo = args.ph_lo, hi = args.ph_hi;
    if (threadIdx.x < 32) ((LAS unsigned*)(lds + MISC_OFF))[threadIdx.x] = 0u;
    __syncthreads();
    XcdBarrier bar; bar.bar = (unsigned*)(ws + WS_CTL) + CW_BAR; bar.x = 0; bar.st = (volatile LAS unsigned*)(lds + MISC_OFF);
    if (hi - lo > 1) bar = xcd_barrier_post((unsigned*)(ws + WS_CTL) + CW_BAR, (volatile LAS unsigned*)(lds + MISC_OFF));
#define IN(k) (lo <= (k) && (k) < hi)
#define OPAQUE_IDS() int tid_ = threadIdx.x; asm volatile("" : "+v"(tid_)); const int tid = tid_, lane = tid & 63, wave = __builtin_amdgcn_readfirstlane(tid >> 6); int bx_ = blockIdx.x; asm volatile("" : "+s"(bx_)); const int gw = bx_ * NWAVES + wave; (void)gw; (void)lane
#define SEAM(k) do { if (IN(k) && IN((k) + 1)) for (int rb_ = 0; rb_ < REP_BAR; ++rb_) xcd_barrier(bar); } while (0)

    bf16* const A1 = (bf16*)(ws + WS_A1); bf16* const A2 = (bf16*)(ws + WS_A2); bf16* const QB = (bf16*)(ws + WS_Q); bf16* const SZ = (bf16*)(ws + WS_SZ);
    bf16* const YB = (bf16*)(ws + WS_Y); bf16* const YO = (bf16*)(ws + WS_YO); bf16* const KVB = (bf16*)(ws + WS_KV);
    float* const VST = (float*)(ws + WS_VST); float* const YSS = (float*)(ws + WS_YSS); bf16* const HN = (bf16*)(ws + WS_HN);

    if (TLB_WARM) {
        const size_t idx = (size_t)blockIdx.x * (NWAVES * 64) + threadIdx.x, nthr = (size_t)G * (NWAVES * 64); unsigned acc = 0u;
        const size_t szs[8] = {(size_t)SEQ * DM * 4, (size_t)DEPTH * DM * NKV * 4, (size_t)DEPTH * DM * DM * 4, (size_t)2 * DM * NIN_CONV * 4, (size_t)2 * DM * NIN_GMLP * 4, (size_t)WS_END, (size_t)SEQ * DM * 4, (size_t)NMEM * DM * 4};
        const unsigned char* ptrs[8] = {(const unsigned char*)args.in[0], (const unsigned char*)args.in[5], (const unsigned char*)args.in[6], (const unsigned char*)args.in[7], (const unsigned char*)args.in[9], (const unsigned char*)ws, (const unsigned char*)args.out, (const unsigned char*)args.in[1]};
        for (int r = 0; r < 8; ++r) for (size_t pg = idx; pg < (szs[r] >> 4); pg += nthr) { const v4u q = __builtin_nontemporal_load((const v4u*)ptrs[r] + pg); acc += q.x ^ q.y ^ q.z ^ q.w; }
        asm volatile("" :: "v"(acc));
        __syncthreads();
    }
    for (int ra = 0; ra < REP_ALL; ++ra) {
    if (ra) xcd_barrier(bar);
    if (IN(0)) { for (int rep = 0; rep < REP_P0; ++rep) { OPAQUE_IDS(); p0a_convert(args, ws, lds, gw, NGW, wave, lane); } }
    SEAM(0);
    if (IN(1)) {
        for (int rep = 0; rep < REP_KV; ++rep) {
        pg8::Gemm g{(const bf16*)(ws + WS_MEMB), (const bf16*)(ws + WS_WKV), NMEM, DEPTH * NKV, DM}; pg8::StaticOrder S; S.init(NMEM, DEPTH * NKV, G, (int)blockIdx.x);
        pg8::EpiKV E{KVB};
        pg8::gemm_phase<pg8::EpiKV, pg8::StaticOrder, GP_ALIGN, GP_SP2>(lds, g, S, E); }
        { OPAQUE_IDS(); p0b_convert(args, ws, lds, gw, NGW, wave, lane); }
    }
    SEAM(1);
    unsigned* const ctl = (unsigned*)(ws + WS_CTL);
    for (int L = 0; L < DEPTH; ++L) {
        const int k0 = 2 + 4 * L, gm = L & 1, jj = L >> 1;
        if (IN(k0)) for (int rep = 0; rep < (gm ? REP_P1G : REP_P1); ++rep) {
            const size_t woff = (L == 0) ? WIN_OFF0 : (L == 1) ? WIN_OFF1 : (L == 2) ? WIN_OFF2 : WIN_OFF3; const int nin = gm ? NIN_GMLP : NIN_CONV;
            pg8::Gemm g{HN, (const bf16*)(ws + WS_WIN + woff), SEQ, nin, DM}; pg8::StaticOrder S; S.init(SEQ, nin, G, (int)blockIdx.x);
            pg8::EpiProj E{A1, VST, gm, YB, args.in[8] + (size_t)jj * 3 * BRW, (float*)(ws + WS_CHT) + (size_t)jj * 256 * 2 * BRW, (float*)(ws + WS_GZH) + (size_t)jj * 256 * 2 * BRW};
            pg8::gemm_phase<pg8::EpiProj, pg8::StaticOrder, GP_ALIGN, GP_SP2>(lds, g, S, E);
            if (REP_SYNC && rep + 1 < REP_P1) xcd_barrier(bar);
        }
        { OPAQUE_IDS(); const int tm = 8 * (bx_ & 7) + ((bx_ >> 3) & 7); team_barrier(ctl, tm, 15 * ra + 4 * L + 1, (gm == 0 && tm > 0) ? tm - 1 : -1); }
        if (IN(k0 + 1)) for (int rep = 0; rep < (gm ? REP_P2G : REP_P2); ++rep) { OPAQUE_IDS(); const int tm = 8 * (bx_ & 7) + ((bx_ >> 3) & 7), km = bx_ >> 6;
            const bf16* Kl = KVB + (size_t)L * (2 * 256 * 1024); const bf16* VTl = Kl + 256 * 1024;
            if (gm) {
                const float* ws_w = args.in[12] + (size_t)jj * 8 * 128 * 128; const float* bs = args.in[13] + (size_t)jj * 8 * 128; const float* lng = args.in[10] + (size_t)jj * BRW; const float* lnb = args.in[11] + (size_t)jj * BRW;
                spatial_member(A2, A1, VST, ws_w, bs, lng, lnb, YB, 2 * tm + (km >> 1), 4 * (km & 1), lds, tid);
            } else {
                const float* cw = args.in[8] + (size_t)jj * 3 * BRW; const int gr = 4 * tm + km;
                if (gr > 0) { const float* cht = (const float*)(ws + WS_CHT) + ((size_t)jj * 256 + (gr - 1)) * 2 * BRW; const float* gzh = (const float*)(ws + WS_GZH) + ((size_t)jj * 256 + gr) * 2 * BRW;
                    for (int c = 4 * tid; c < BRW; c += 4 * NWAVES * 64) {
                        const f32x4 w0 = *(const f32x4*)(cw + c), w1 = *(const f32x4*)(cw + BRW + c), a0 = *(const f32x4*)(cht + c), a1 = *(const f32x4*)(cht + BRW + c), g0 = *(const f32x4*)(gzh + c), g1 = *(const f32x4*)(gzh + BRW + c);
                        bf16* y0 = YB + (size_t)(64 * gr) * DM + c; bf16* y1 = y0 + DM; const v2u u0 = *(const v2u*)y0, u1 = *(const v2u*)y1;
                        const f32x4 f0 = g0 * (w0 * a0 + w1 * a1), f1 = g1 * (w0 * a1);
                        v2u o0, o1; o0.x = pk2(bflo(u0.x) + f0[0], bfhi(u0.x) + f0[1]); o0.y = pk2(bflo(u0.y) + f0[2], bfhi(u0.y) + f0[3]); o1.x = pk2(bflo(u1.x) + f1[0], bfhi(u1.x) + f1[1]); o1.y = pk2(bflo(u1.y) + f1[2], bfhi(u1.y) + f1[3]);
                        *(v2u*)y0 = o0; *(v2u*)y1 = o1; } }
            }
            for (int ra2 = 0; ra2 < REP_ATT; ++ra2) attn_wg(QB, SZ, Kl, VTl, YB, tm, km, lds, tid);
        }
        { OPAQUE_IDS(); const int tm = 8 * (bx_ & 7) + ((bx_ >> 3) & 7); team_barrier(ctl, tm, 15 * ra + 4 * L + 2, -1); }
        if (IN(k0 + 2)) for (int rep = 0; rep < REP_P3; ++rep) {
            pg8::Gemm g{YB, (const bf16*)(ws + WS_WOUT) + (size_t)L * DM * DM, SEQ, DM, DM}; pg8::StaticOrder S; S.init(SEQ, DM, G, (int)blockIdx.x);
            pg8::EpiOut E{YO, YSS};
            if (FAKE_P3) { pg8::FakeOrder SF; SF.init(SEQ, DM, G, (int)blockIdx.x); pg8::gemm_phase<pg8::EpiOut, pg8::FakeOrder, GP_ALIGN, GP_SP2>(lds, g, SF, E); }
            pg8::gemm_phase<pg8::EpiOut, pg8::StaticOrder, GP_ALIGN, GP_SP2>(lds, g, S, E);
            if (REP_SYNC && rep + 1 < REP_P3) xcd_barrier(bar);
        }
        { OPAQUE_IDS(); const int tm = 8 * (bx_ & 7) + ((bx_ >> 3) & 7); team_barrier(ctl, tm, 15 * ra + 4 * L + 3, -1); }
        if (IN(k0 + 3)) { OPAQUE_IDS(); const int tm = 8 * (bx_ & 7) + ((bx_ >> 3) & 7), km = bx_ >> 6;
            for (int rep = 1; rep < REP_P4; ++rep) p4_rows(YO, YSS, args.in[3] + (size_t)L * DM, HN, (float*)(ws + WS_RSTD), YB, (float*)(ws + WS_RSTDM), args.out, L == DEPTH - 1, 256 * tm + 64 * km + 8 * wave, 8, lane);
            p4_rows(YO, YSS, args.in[3] + (size_t)L * DM, HN, (float*)(ws + WS_RSTD), HN, (float*)(ws + WS_RSTD), args.out, L == DEPTH - 1, 256 * tm + 64 * km + 8 * wave, 8, lane); }
        if (L < DEPTH - 1) { OPAQUE_IDS(); const int tm = 8 * (bx_ & 7) + ((bx_ >> 3) & 7); team_barrier(ctl, tm, 15 * ra + 4 * L + 4, -1); if (GRID_PER_LAYER) xcd_barrier(bar); }
    }
    }
#undef IN
#undef SEAM
}

extern "C" void kernel_launch(void* const* d_in, const int* in_sizes, int n_in, void* d_out, int out_size, void* d_ws, size_t ws_size, hipStream_t stream) {
    static int grid = 0;
    if (grid == 0) {
        if (n_in != 14 || in_sizes[0] != SEQ * DM || out_size != SEQ * DM || ws_size < WS_END) { fprintf(stderr, "kernel_launch: unexpected shapes / workspace (n_in %d, in0 %d, out %d, ws %zu, need %zu); nothing launched\n", n_in, n_in > 0 ? in_sizes[0] : -1, out_size, ws_size, (size_t)WS_END); grid = -1; return; }
        int dev = 0, cus = 0, per_cu = 0;
        if (hipGetDevice(&dev) != hipSuccess || hipDeviceGetAttribute(&cus, hipDeviceAttributeMultiprocessorCount, dev) != hipSuccess) { grid = -1; return; }
        if (hipFuncSetAttribute((const void*)mk_fwd, hipFuncAttributeMaxDynamicSharedMemorySize, LDS_BYTES) != hipSuccess) { fprintf(stderr, "kernel_launch: hipFuncSetAttribute failed\n"); grid = -1; return; }
        if (hipOccupancyMaxActiveBlocksPerMultiprocessor(&per_cu, (const void*)mk_fwd, NWAVES * 64, LDS_BYTES) != hipSuccess || per_cu < 1) { fprintf(stderr, "kernel_launch: occupancy query says %d\n", per_cu); }
        (void)hipGetLastError();
        grid = cus;
    }
    if (grid < 0) return;
    if (hipMemsetAsync((char*)d_ws + WS_CTL, 0, CTL_ZERO_BYTES, stream) != hipSuccess) return;
    Args a{};
    for (int i = 0; i < 14; ++i) a.in[i] = (const float*)d_in[i];
    a.out = (float*)d_out; a.ws = (unsigned char*)d_ws;
#if MK_ONE_LAUNCH
    a.ph_lo = 0; a.ph_hi = NPHASE;
    hipLaunchKernelGGL(mk_fwd, dim3(grid), dim3(NWAVES * 64), LDS_BYTES, stream, a);
#else
    for (int k = 0; k < NPHASE; ++k) { a.ph_lo = k; a.ph_hi = k + 1; hipLaunchKernelGGL(mk_fwd, dim3(grid), dim3(NWAVES * 64), LDS_BYTES, stream, a); }
#endif
}
```
